# Optimizing an MI355X kernel written in HIP

```python
import jax, jax.numpy as jnp
from jax import lax
import numpy as np

D_MODEL = 2048
BATCH = 4
SEQ = 2048
DEPTH = 4
DEC_BATCH = 128
DEC_SEQ = 8
PAST_LEN = 16384
PAGE_SIZE = 128

HEAD = 64
D_R = D_MODEL // 2
H_R = D_R // HEAD
R_W = 64
R_A = 64
D_SHIFT = 3 * D_R + R_W + R_A
CHUNK = 128
D_G = D_MODEL // 2
N_GROUPS = 8
GW = D_G // N_GROUPS
N_IN = D_SHIFT + D_R + 3 * D_G + 2 * D_MODEL
RMS_EPS = 1e-6
LN_EPS = 1e-5
GN_EPS = 64e-5

kernel_name = "rwkv7_chunk_sgu_gated_hybrid_step"


def rms_norm(x, g):
    xf = x.astype(jnp.float32)
    y = xf * lax.rsqrt(jnp.mean(xf * xf, axis=-1, keepdims=True) + RMS_EPS)
    return (y * g).astype(x.dtype)


def layer_norm(x, g, b):
    xf = x.astype(jnp.float32)
    mu = jnp.mean(xf, axis=-1, keepdims=True)
    var = jnp.mean(jnp.square(xf - mu), axis=-1, keepdims=True)
    return ((xf - mu) * lax.rsqrt(var + LN_EPS) * g + b).astype(x.dtype)


def wkv7_scan(S0, r, w, k, v, a, b):
    def step(S, inp):
        r_t, w_t, k_t, v_t, a_t, b_t = inp
        Sa = jnp.einsum('bhvk,bhk->bhv', S, a_t)
        S = S * w_t[:, :, None, :] + Sa[..., None] * b_t[:, :, None, :] + v_t[..., None] * k_t[:, :, None, :]
        y = jnp.einsum('bhvk,bhk->bhv', S, r_t)
        return S, y
    xs = tuple(jnp.swapaxes(t, 0, 1) for t in (r, w, k, v, a, b))
    S, ys = lax.scan(step, S0, xs)
    return S, jnp.swapaxes(ys, 0, 1)


def chunk_spatial_mix(vn, sgu_w, sgu_b):
    Bn, T, _ = vn.shape
    L = CHUNK if T % CHUNK == 0 else T
    C = T // L
    vr = vn.reshape(Bn, C, L, N_GROUPS, GW)
    mask = jnp.tril(jnp.ones((L, L), vn.dtype))
    Wm = sgu_w[:, :L, :L] * mask
    s = jnp.einsum('gts,bcsgd->bctgd', Wm, vr) + jnp.transpose(sgu_b[:, :L])[None, None, :, :, None]
    return s.reshape(Bn, T, D_G)


def mixer_layer(h, shift_prev, S0, norm_g, w_in, shift_mu, w0, w2, a0, a2, k_k, k_a, r_k,
                lnx_g, lnx_b, sgu_ln_g, sgu_ln_b, sgu_w, sgu_b, w_proj_a, w_proj_b, w_out):
    Bn, T, _ = h.shape
    xn = rms_norm(h, norm_g)
    z = xn @ w_in
    zs = z[..., :D_SHIFT]
    zs_prev = jnp.concatenate([shift_prev.astype(z.dtype), zs[:, :-1]], axis=1)
    zs_mix = zs + (zs_prev - zs) * shift_mu
    new_shift = zs[:, -1:]
    r, k, v, wd, ad = jnp.split(zs_mix, [D_R, 2 * D_R, 3 * D_R, 3 * D_R + R_W], axis=-1)
    g_r, u, vg, g_g, gate_a, gate_b = jnp.split(
        z[..., D_SHIFT:], [D_R, D_R + D_G, D_R + 2 * D_G, D_R + 3 * D_G, D_R + 3 * D_G + D_MODEL], axis=-1)

    f32 = jnp.float32
    r, k, v, wd, ad = (t.astype(f32) for t in (r, k, v, wd, ad))
    w_log = -jax.nn.softplus(-(w0 + jnp.tanh(wd) @ w2)) - 0.5
    decay = jnp.exp(-jnp.exp(w_log))
    a_gate = jax.nn.sigmoid(a0 + ad @ a2)
    kk = (k * k_k).reshape(Bn, T, H_R, HEAD)
    kk = kk / jnp.maximum(jnp.linalg.norm(kk, axis=-1, keepdims=True), 1e-12)
    k = k * (1.0 + (a_gate - 1.0) * k_a)
    hs = lambda t: t.reshape(Bn, T, H_R, HEAD)
    rh, kh, vh, ah = hs(r), hs(k), hs(v), hs(a_gate)
    S, y = wkv7_scan(S0.astype(f32), rh, hs(decay), kh, vh, -kk, kk * ah)
    mu = jnp.mean(y, axis=-1, keepdims=True)
    var = jnp.mean(jnp.square(y - mu), axis=-1, keepdims=True)
    y = (y - mu) * lax.rsqrt(var + GN_EPS) * lnx_g.reshape(H_R, HEAD) + lnx_b.reshape(H_R, HEAD)
    y = y + jnp.sum(rh * kh * r_k, axis=-1, keepdims=True) * vh
    y = y.reshape(Bn, T, D_R).astype(h.dtype)
    ya = (y * jax.nn.silu(g_r)) @ w_proj_a

    vn = layer_norm(vg, sgu_ln_g, sgu_ln_b)
    s = chunk_spatial_mix(vn, sgu_w, sgu_b)
    yb = (u * s * jax.nn.silu(g_g)) @ w_proj_b

    m = jax.nn.sigmoid(gate_a) * ya + jax.nn.sigmoid(gate_b) * yb
    return h + m @ w_out, new_shift, S, vn


def setup_inputs(seed: int = 0) -> dict:
    key = jax.random.key(seed)
    ks = jax.random.split(key, 32)
    nrm = lambda k, shape, s: jax.random.normal(k, shape, jnp.float32) * s
    return {
        "x_prompt": nrm(ks[0], (BATCH, SEQ, D_MODEL), 1.0),
        "x_sample": nrm(ks[1], (DEC_BATCH, DEC_SEQ, D_MODEL), 1.0),
        "state_wkv": nrm(ks[2], (DEPTH, DEC_BATCH, H_R, HEAD, HEAD), 0.3),
        "state_shift": nrm(ks[3], (DEPTH, DEC_BATCH, 1, D_SHIFT), 1.0),
        "norm_g": 1.0 + nrm(ks[4], (DEPTH, D_MODEL), 0.05),
        "w_in": nrm(ks[5], (DEPTH, D_MODEL, N_IN), D_MODEL ** -0.5),
        "shift_mu": jax.random.uniform(ks[6], (DEPTH, D_SHIFT), jnp.float32, 0.1, 0.9),
        "w0": nrm(ks[7], (DEPTH, D_R), 0.5),
        "w2": nrm(ks[8], (DEPTH, R_W, D_R), 0.5 * R_W ** -0.5),
        "a0": nrm(ks[9], (DEPTH, D_R), 0.1),
        "a2": nrm(ks[10], (DEPTH, R_A, D_R), R_A ** -0.5),
        "k_k": 0.85 + nrm(ks[11], (DEPTH, D_R), 0.05),
        "k_a": 1.0 + nrm(ks[12], (DEPTH, D_R), 0.05),
        "r_k": nrm(ks[13], (DEPTH, H_R, HEAD), 0.1),
        "lnx_g": 1.0 + nrm(ks[14], (DEPTH, D_R), 0.05),
        "lnx_b": nrm(ks[15], (DEPTH, D_R), 0.02),
        "sgu_ln_g": 1.0 + nrm(ks[16], (DEPTH, D_G), 0.05),
        "sgu_ln_b": nrm(ks[17], (DEPTH, D_G), 0.02),
        "sgu_w": nrm(ks[18], (DEPTH, N_GROUPS, CHUNK, CHUNK), CHUNK ** -0.5),
        "sgu_b": 1.0 + nrm(ks[19], (DEPTH, N_GROUPS, CHUNK), 0.1),
        "w_proj_a": nrm(ks[20], (DEPTH, D_R, D_MODEL), D_R ** -0.5),
        "w_proj_b": nrm(ks[21], (DEPTH, D_G, D_MODEL), D_G ** -0.5),
        "w_out": nrm(ks[22], (DEPTH, D_MODEL, D_MODEL), D_MODEL ** -0.5),
        "final_norm_g": 1.0 + nrm(ks[23], (D_MODEL,), 0.05),
    }


def reference(x_prompt, x_sample, state_wkv, state_shift, norm_g, w_in, shift_mu, w0, w2, a0, a2,
              k_k, k_a, r_k, lnx_g, lnx_b, sgu_ln_g, sgu_ln_b, sgu_w, sgu_b, w_proj_a, w_proj_b,
              w_out, final_norm_g):
    hp, hs = x_prompt, x_sample
    wkv_p, shift_p, wkv_s, shift_s, chunk_v_s = [], [], [], [], []
    shift0 = jnp.zeros((BATCH, 1, D_SHIFT), x_prompt.dtype)
    S0 = jnp.zeros((BATCH, H_R, HEAD, HEAD), jnp.float32)
    for l in range(DEPTH):
        lp = (norm_g[l], w_in[l], shift_mu[l], w0[l], w2[l], a0[l], a2[l], k_k[l], k_a[l], r_k[l],
              lnx_g[l], lnx_b[l], sgu_ln_g[l], sgu_ln_b[l], sgu_w[l], sgu_b[l],
              w_proj_a[l], w_proj_b[l], w_out[l])
        hp, sh_p, S_p, _ = mixer_layer(hp, shift0, S0, *lp)
        hs, sh_s, S_s, vn_s = mixer_layer(hs, state_shift[l], state_wkv[l], *lp)
        wkv_p.append(S_p)
        shift_p.append(sh_p)
        wkv_s.append(S_s.astype(state_wkv.dtype))
        shift_s.append(sh_s.astype(state_shift.dtype))
        chunk_v_s.append(vn_s)
    y_prompt = rms_norm(hp, final_norm_g)
    y_sample = rms_norm(hs, final_norm_g)
    return (y_prompt, y_sample, jnp.stack(wkv_p), jnp.stack(shift_p), jnp.stack(wkv_s),
            jnp.stack(shift_s), jnp.stack(chunk_v_s))
```

```cpp
#include <hip/hip_runtime.h>
#include <hip/hip_cooperative_groups.h>
#include <cstdio>
namespace cg = cooperative_groups;

#ifndef MK_SINGLE
#define MK_SINGLE 1
#endif

#define LAS __attribute__((address_space(3)))
typedef unsigned short bf16_t;
typedef short bf16x8 __attribute__((ext_vector_type(8)));
typedef float f32x4 __attribute__((ext_vector_type(4)));
typedef float f32x2 __attribute__((ext_vector_type(2)));
typedef unsigned u32x4 __attribute__((ext_vector_type(4)));
typedef unsigned u32x2 __attribute__((ext_vector_type(2)));

constexpr int DM = 2048, DEPTH = 4;
constexpr int MP = 8192, MS = 1024, MT = 9216;
constexpr int DSH = 3200;
constexpr int NP = 11520;
constexpr int NIN = 11392;
constexpr int C_R = 0, C_K = 1024, C_V = 2048, C_WD = 3072, C_AD = 3136, C_GR = 3200, C_U = 4224, C_VG = 5248, C_GG = 6272, C_GA = 7296, C_GB = 9344;
constexpr size_t O_YP = 0, O_WKVP = 18874368, O_SHP = 19922944, O_WKVS = 19974144, O_SHS = 53528576, O_CV = 55166976;
constexpr int NPHASE = 1 + 7 * DEPTH;

constexpr int XCD_BAR_WORDS_C = 3456;
struct Params { const float* in[24]; float* out; char* ws; };
constexpr size_t al256(size_t x) { return (x + 255) & ~(size_t)255; }
constexpr size_t WS_WINT = 0;
constexpr size_t WS_PABT = WS_WINT + al256((size_t)DEPTH * NP * DM * 2);
constexpr size_t WS_WOT = WS_PABT + al256((size_t)DEPTH * DM * DM * 2);
constexpr size_t WS_XN = WS_WOT + al256((size_t)DEPTH * DM * DM * 2);
constexpr size_t WS_Z = WS_XN + al256((size_t)MT * DM * 2);
constexpr size_t WS_VNT = WS_Z + al256((size_t)MT * NP * 2);
constexpr size_t WS_VNTS = WS_VNT + al256((size_t)64 * 1024 * 128 * 2);
constexpr size_t WS_YAB = WS_VNTS + al256((size_t)128 * 1024 * 8 * 2);
constexpr size_t WS_M = WS_YAB + al256((size_t)MT * DM * 2);
constexpr size_t WS_H = WS_M + al256((size_t)MT * DM * 2);
constexpr size_t WS_REC = WS_H + al256((size_t)MT * DM * 4);
constexpr size_t WS_YBUF = WS_REC + al256((size_t)MT * 16 * 384 * 4);
constexpr size_t WS_W2T = WS_YBUF + al256((size_t)MT * 1024 * 4);
constexpr size_t WS_A2T = WS_W2T + al256((size_t)DEPTH * 1024 * 64 * 2);
constexpr size_t WS_BAR = WS_A2T + al256((size_t)DEPTH * 1024 * 64 * 2);
constexpr size_t WS_END = WS_BAR + al256((size_t)XCD_BAR_WORDS_C * 4);
#define P_X_PROMPT (p.in[0])
#define P_X_SAMPLE (p.in[1])
#define P_STATE_WKV (p.in[2])
#define P_STATE_SHIFT (p.in[3])
#define P_NORM_G (p.in[4])
#define P_W_IN (p.in[5])
#define P_SHIFT_MU (p.in[6])
#define P_W0 (p.in[7])
#define P_W2 (p.in[8])
#define P_A0 (p.in[9])
#define P_A2 (p.in[10])
#define P_K_K (p.in[11])
#define P_K_A (p.in[12])
#define P_R_K (p.in[13])
#define P_LNX_G (p.in[14])
#define P_LNX_B (p.in[15])
#define P_SGU_LN_G (p.in[16])
#define P_SGU_LN_B (p.in[17])
#define P_SGU_W (p.in[18])
#define P_SGU_B (p.in[19])
#define P_W_PROJ_A (p.in[20])
#define P_W_PROJ_B (p.in[21])
#define P_W_OUT (p.in[22])
#define P_FINAL_G (p.in[23])
#define P_WINT ((bf16_t*)(p.ws + WS_WINT))
#define P_PABT ((bf16_t*)(p.ws + WS_PABT))
#define P_WOT ((bf16_t*)(p.ws + WS_WOT))
#define P_XN ((bf16_t*)(p.ws + WS_XN))
#define P_Z ((bf16_t*)(p.ws + WS_Z))
#define P_VNT ((bf16_t*)(p.ws + WS_VNT))
#define P_VNTS ((bf16_t*)(p.ws + WS_VNTS))
#define P_YAB ((bf16_t*)(p.ws + WS_YAB))
#define P_M ((bf16_t*)(p.ws + WS_M))
#define P_H ((float*)(p.ws + WS_H))
#define P_REC ((float*)(p.ws + WS_REC))
#define P_YBUF ((float*)(p.ws + WS_YBUF))
#define P_W2T ((bf16_t*)(p.ws + WS_W2T))
#define P_A2T ((bf16_t*)(p.ws + WS_A2T))

extern __shared__ __attribute__((aligned(16))) unsigned char smem_raw[];

__device__ __forceinline__ int otid() { int t = threadIdx.x; asm volatile("" : "+v"(t)); return t; }
__device__ __forceinline__ float bf2f(bf16_t v) { return __uint_as_float(((unsigned)v) << 16); }
__device__ __forceinline__ float bflo(unsigned v) { return __uint_as_float(v << 16); }
__device__ __forceinline__ float bfhi(unsigned v) { return __uint_as_float(v & 0xffff0000u); }
__device__ __forceinline__ unsigned pk_bf16(float lo, float hi) { unsigned r; asm("v_cvt_pk_bf16_f32 %0, %1, %2" : "=v"(r) : "v"(lo), "v"(hi)); return r; }
template <int CTRL> __device__ __forceinline__ float dppf(float x) { return __int_as_float(__builtin_amdgcn_update_dpp(0, __float_as_int(x), CTRL, 0xF, 0xF, true)); }
__device__ __forceinline__ float red16(float x) { x += dppf<0xB1>(x); x += dppf<0x4E>(x); x += dppf<0x141>(x); x += dppf<0x140>(x); return x; }
__device__ __forceinline__ void red16x2(float& x, float& y) { x += dppf<0xB1>(x); y += dppf<0xB1>(y); x += dppf<0x4E>(x); y += dppf<0x4E>(y); x += dppf<0x141>(x); y += dppf<0x141>(y); x += dppf<0x140>(x); y += dppf<0x140>(y); }
__device__ __forceinline__ float red32(float x) { x = red16(x); x += __shfl_xor(x, 16); return x; }
__device__ __forceinline__ float red64(float x) { x = red16(x); x += __shfl_xor(x, 16); x += __shfl_xor(x, 32); return x; }
__device__ __forceinline__ float sigmoidf_(float x) { return __builtin_amdgcn_rcpf(1.f + __expf(-x)); }
__device__ __forceinline__ float tanhf_(float x) { const float e = __expf(2.f * fminf(fmaxf(x, -15.f), 15.f)); return 1.f - 2.f * __builtin_amdgcn_rcpf(1.f + e); }
__device__ __forceinline__ float siluf_(float x) { return x * __builtin_amdgcn_rcpf(1.f + __expf(-x)); }

namespace pg8 {
constexpr int BM = 256, BK = 64, HALF = 128, HTB = HALF * BK * 2, STAGE_BYTES = 8 * HTB, NXCD = 8, WGM = 8;
__device__ __forceinline__ int lds_byte(int r, int c) { const int st = (r >> 4) * 2 + (c >> 5), rr = r & 15, cc = c & 31, ob = rr * 64 + cc * 2; return st * 1024 + (ob ^ (((ob >> 9) & 1) << 5)); }
__device__ __forceinline__ void stage_rc(int b, int& R, int& C) { const int st = b / 1024, sb = b % 1024, swz = sb ^ (((sb >> 9) & 1) << 5); R = (st >> 1) * 16 + swz / 64; C = (st & 1) * 32 + (swz % 64) / 2; }
__device__ __forceinline__ int perm32(int rho) { const int n = rho >> 4, i = rho & 15; return 8 * (i >> 2) + 4 * n + (i & 3); }
struct Unit { int pm, pn, seg; };
struct Gemm { const bf16_t* A; const bf16_t* Bt; int M, N, K; };
struct StaticOrder {
    int nM, nN, nwg, G, c;
    __device__ void init(int M, int N, int G_, int c_, int split_ = 0) { nM = M / BM; nN = N / BM; nwg = nM * nN; G = G_; c = c_; split = split_; }
    int split;
    __device__ bool next(int i, Unit& u) const {
        u.seg = split ? (i & 1) : 0; if (split) i >>= 1;
        const long L = (long)i * G + c; if (L >= nwg) return false;
        int wgid = (int)L; { const int q = nwg / NXCD, r = nwg % NXCD, xcd = wgid % NXCD, off = wgid / NXCD; wgid = (xcd < r ? xcd * (q + 1) : r * (q + 1) + (xcd - r) * q) + off; }
        const int nig = WGM * nN, gid = wgid / nig, fm = gid * WGM, gsz = (nM - fm) < WGM ? (nM - fm) : WGM;
        u.pm = fm + ((wgid % nig) % gsz); u.pn = (wgid % nig) / gsz; return true;
    }
};

template <class Epi, class Sched>
__device__ __forceinline__ void gemm_phase(LAS unsigned char* lds, const Gemm g, const Sched& S, const Epi& E) {
    const int tid = otid(), wid = __builtin_amdgcn_readfirstlane(tid >> 6), lane = tid & 63, wr = wid >> 2, wc = wid & 3, fr = lane & 15, fq = lane >> 4;
    const int ld = g.K, nt = Epi::SPLIT2 ? g.K / BK / 2 : g.K / BK;
    const size_t segstep = (size_t)nt * BK * 2;
    unsigned voffA[2], voffB[2];
#pragma unroll
    for (int i = 0; i < 2; ++i) { int R, C; stage_rc(tid * 16 + i * 8192, R, C); const int Rb = Epi::PERM ? ((R & ~31) + perm32(R & 31)) : R;
        voffA[i] = (unsigned)(R * ld + C) * 2u; voffB[i] = (unsigned)(Rb * ld + C) * 2u; }
    const size_t kstep = (size_t)(BK * 2);
    const size_t hstep = (size_t)HALF * ld * 2;
    const size_t tstep = 2 * hstep;
    const unsigned ldsw = (unsigned)wid * 1024u;
    const int aoff = lds_byte(wr * 64 + fr, fq * 8), boff = lds_byte(wc * 32 + fr, fq * 8);
#define PG8_SA(b, h) (((b) * 2 + (h)) * HTB)
#define PG8_SB(b, h) ((4 + (b) * 2 + (h)) * HTB)
#define PG8_STAGE(bufoff, gbase, voff) do { _Pragma("unroll") for (int _i = 0; _i < 2; ++_i) \
        __builtin_amdgcn_global_load_lds((const unsigned*)((const char*)(gbase) + (voff)[_i]), (LAS unsigned*)(lds + (bufoff) + ldsw + _i * 8192), 16, 0, 0); } while (0)
#define PG8_LDA(dst, b, h) do { _Pragma("unroll") for (int m = 0; m < 4; ++m) _Pragma("unroll") for (int k = 0; k < 2; ++k) dst[m][k] = *(const LAS bf16x8*)(lds + PG8_SA(b, h) + aoff + m * 2048 + k * 1024); } while (0)
#define PG8_LDB(dst, b, h) do { _Pragma("unroll") for (int n = 0; n < 2; ++n) _Pragma("unroll") for (int k = 0; k < 2; ++k) dst[n][k] = *(const LAS bf16x8*)(lds + PG8_SB(b, h) + boff + n * 2048 + k * 1024); } while (0)
#define PG8_MMA(ai, bj, At, Bt) do { __builtin_amdgcn_s_setprio(1); _Pragma("unroll") for (int m = 0; m < 4; ++m) _Pragma("unroll") for (int n = 0; n < 2; ++n) _Pragma("unroll") for (int k = 0; k < 2; ++k) \
        acc[ai][bj][m][n] = __builtin_amdgcn_mfma_f32_16x16x32_bf16(Bt[n][k], At[m][k], acc[ai][bj][m][n], 0, 0, 0); __builtin_amdgcn_s_setprio(0); } while (0)
#define PG8_WAIT_V(n) asm volatile("s_waitcnt vmcnt(" #n ")" ::: "memory")
#define PG8_WAIT_L(n) asm volatile("s_waitcnt lgkmcnt(" #n ")" ::: "memory")
#define PG8_BAR __builtin_amdgcn_s_barrier()
#define PG8_SCHED __builtin_amdgcn_sched_barrier(0)
    Unit cur, nxt; int ui = 0;
    if (!S.next(0, cur)) return;
    f32x4 acc[2][2][4][2];
#pragma unroll
    for (int a = 0; a < 2; ++a)
#pragma unroll
        for (int b = 0; b < 2; ++b)
#pragma unroll
            for (int m = 0; m < 4; ++m)
#pragma unroll
                for (int n = 0; n < 2; ++n) acc[a][b][m][n] = (f32x4){0.f, 0.f, 0.f, 0.f};
    bf16x8 At[4][2], B0[2][2], B1[2][2];
    const char* cA = (const char*)g.A + (size_t)cur.pm * tstep + (Epi::SPLIT2 ? cur.seg * segstep : 0); const char* cB = (const char*)g.Bt + (size_t)cur.pn * tstep + (Epi::SPLIT2 ? cur.seg * segstep : 0);
    PG8_STAGE(PG8_SB(0, 0), cB, voffB); PG8_STAGE(PG8_SA(0, 0), cA, voffA); PG8_STAGE(PG8_SB(0, 1), cB + hstep, voffB); PG8_STAGE(PG8_SA(0, 1), cA + hstep, voffA);
    if (wr == 1) PG8_BAR;
    PG8_WAIT_V(4); PG8_BAR;
    PG8_STAGE(PG8_SB(1, 0), cB + kstep, voffB); PG8_STAGE(PG8_SA(1, 0), cA + kstep, voffA); PG8_STAGE(PG8_SB(1, 1), cB + hstep + kstep, voffB);
    PG8_WAIT_V(6); PG8_BAR;
    for (;;) {
        const bool has_next = S.next(ui + 1, nxt);
        const char* nA = has_next ? (const char*)g.A + (size_t)nxt.pm * tstep + (Epi::SPLIT2 ? nxt.seg * segstep : 0) : cA; const char* nB = has_next ? (const char*)g.Bt + (size_t)nxt.pn * tstep + (Epi::SPLIT2 ? nxt.seg * segstep : 0) : cB;
        for (int t = 0; t < nt; t += 2) {
            const bool last = (t == nt - 2);
            const char* a1 = cA + (size_t)(t + 1) * kstep;
            const char* a2 = last ? nA : cA + (size_t)(t + 2) * kstep; const char* b2 = last ? nB : cB + (size_t)(t + 2) * kstep;
            const char* a3 = a2 + kstep; const char* b3 = b2 + kstep;
            PG8_LDB(B0, 0, 0); PG8_SCHED; PG8_LDA(At, 0, 0); PG8_STAGE(PG8_SA(1, 1), a1 + hstep, voffA);
            PG8_WAIT_L(8); PG8_BAR; PG8_WAIT_L(0); PG8_MMA(0, 0, At, B0); PG8_BAR; PG8_SCHED;
            PG8_LDB(B1, 0, 1); PG8_STAGE(PG8_SB(0, 0), b2, voffB);
            PG8_BAR; PG8_WAIT_L(0); PG8_MMA(0, 1, At, B1); PG8_BAR;
            PG8_LDA(At, 0, 1); PG8_STAGE(PG8_SA(0, 0), a2, voffA);
            PG8_BAR; PG8_WAIT_L(0); PG8_MMA(1, 0, At, B0); PG8_BAR; PG8_SCHED;
            PG8_STAGE(PG8_SB(0, 1), b2 + hstep, voffB);
            PG8_WAIT_V(6); PG8_BAR; PG8_MMA(1, 1, At, B1); PG8_BAR;
            PG8_LDB(B0, 1, 0); PG8_SCHED; PG8_LDA(At, 1, 0); PG8_STAGE(PG8_SA(0, 1), a2 + hstep, voffA);
            PG8_WAIT_L(8); PG8_BAR; PG8_WAIT_L(0); PG8_MMA(0, 0, At, B0); PG8_BAR; PG8_SCHED;
            PG8_LDB(B1, 1, 1); PG8_STAGE(PG8_SB(1, 0), b3, voffB);
            PG8_BAR; PG8_WAIT_L(0); PG8_MMA(0, 1, At, B1); PG8_BAR;
            PG8_LDA(At, 1, 1); PG8_STAGE(PG8_SA(1, 0), a3, voffA);
            PG8_BAR; PG8_WAIT_L(0); PG8_MMA(1, 0, At, B0); PG8_BAR; PG8_SCHED;
            PG8_STAGE(PG8_SB(1, 1), b3 + hstep, voffB);
            PG8_WAIT_V(6); PG8_BAR; PG8_MMA(1, 1, At, B1); PG8_BAR;
        }
        E(acc, cur, wr, wc, fr, fq);
        if (!has_next) break;
        if (!(Epi::SPLIT2 && cur.seg == 0))
#pragma unroll
        for (int a = 0; a < 2; ++a)
#pragma unroll
            for (int b = 0; b < 2; ++b)
#pragma unroll
                for (int m = 0; m < 4; ++m)
#pragma unroll
                    for (int n = 0; n < 2; ++n) acc[a][b][m][n] = (f32x4){0.f, 0.f, 0.f, 0.f};
        cur = nxt; cA = nA; cB = nB; ++ui;
    }
    PG8_WAIT_V(0);
    if (wr == 0) PG8_BAR;
    PG8_BAR;
#undef PG8_SA
#undef PG8_SB
#undef PG8_STAGE
#undef PG8_LDA
#undef PG8_LDB
#undef PG8_MMA
#undef PG8_WAIT_V
#undef PG8_WAIT_L
#undef PG8_BAR
#undef PG8_SCHED
}
}

struct EpiZ {
    static constexpr bool PERM = true, SPLIT2 = false;
    bf16_t* Z;
    __device__ __forceinline__ void operator()(f32x4 (&acc)[2][2][4][2], const pg8::Unit& u, int wr, int wc, int fr, int fq) const {
        const int row0 = u.pm * 256 + wr * 64 + fr, col0 = u.pn * 256 + wc * 32 + 8 * fq;
#pragma unroll
        for (int ai = 0; ai < 2; ++ai)
#pragma unroll
            for (int m = 0; m < 4; ++m) { bf16_t* rowp = Z + (size_t)(row0 + ai * 128 + m * 16) * NP + col0;
#pragma unroll
                for (int bj = 0; bj < 2; ++bj) { const f32x4 v0 = acc[ai][bj][m][0], v1 = acc[ai][bj][m][1];
                    u32x4 o; o[0] = pk_bf16(v0[0], v0[1]); o[1] = pk_bf16(v0[2], v0[3]); o[2] = pk_bf16(v1[0], v1[1]); o[3] = pk_bf16(v1[2], v1[3]);
                    *(u32x4*)(rowp + bj * 128) = o; } }
    }
};
struct EpiMerge {
    static constexpr bool PERM = true, SPLIT2 = true;
    const bf16_t* Z; bf16_t* Mo;
    __device__ __forceinline__ void mid(f32x4 (&acc)[2][2][4][2], const pg8::Unit& u, int wr, int wc, int fr, int fq) const {
        const int row0 = u.pm * 256 + wr * 64 + fr, col0 = u.pn * 256 + wc * 32 + 8 * fq;
#pragma unroll
        for (int ai = 0; ai < 2; ++ai)
#pragma unroll
            for (int m = 0; m < 4; ++m) { const bf16_t* zr = Z + (size_t)(row0 + ai * 128 + m * 16) * NP + col0;
#pragma unroll
                for (int bj = 0; bj < 2; ++bj) { const u32x4 ga = *(const u32x4*)(zr + C_GA + bj * 128), gb = *(const u32x4*)(zr + C_GB + bj * 128);
#pragma unroll
                    for (int q = 0; q < 4; ++q) { const float a0 = bflo(ga[q]), a1 = bfhi(ga[q]), b0 = bflo(gb[q]), b1 = bfhi(gb[q]);
                        const float r0 = (1.f + __expf(-b0)) * __builtin_amdgcn_rcpf(1.f + __expf(-a0)), r1 = (1.f + __expf(-b1)) * __builtin_amdgcn_rcpf(1.f + __expf(-a1));
                        acc[ai][bj][m][q >> 1][(q & 1) * 2] *= r0; acc[ai][bj][m][q >> 1][(q & 1) * 2 + 1] *= r1; } } }
    }
    __device__ __forceinline__ void fin(f32x4 (&acc)[2][2][4][2], const pg8::Unit& u, int wr, int wc, int fr, int fq) const {
        const int row0 = u.pm * 256 + wr * 64 + fr, col0 = u.pn * 256 + wc * 32 + 8 * fq;
#pragma unroll
        for (int ai = 0; ai < 2; ++ai)
#pragma unroll
            for (int m = 0; m < 4; ++m) { const size_t r = (size_t)(row0 + ai * 128 + m * 16); const bf16_t* zr = Z + r * NP + col0; bf16_t* mo = Mo + r * DM + col0;
#pragma unroll
                for (int bj = 0; bj < 2; ++bj) { const u32x4 gb = *(const u32x4*)(zr + C_GB + bj * 128); u32x4 o;
#pragma unroll
                    for (int q = 0; q < 4; ++q) { const float s0 = sigmoidf_(bflo(gb[q])), s1 = sigmoidf_(bfhi(gb[q]));
                        o[q] = pk_bf16(acc[ai][bj][m][q >> 1][(q & 1) * 2] * s0, acc[ai][bj][m][q >> 1][(q & 1) * 2 + 1] * s1); }
                    *(u32x4*)(mo + bj * 128) = o; } }
    }
    __device__ __forceinline__ void operator()(f32x4 (&acc)[2][2][4][2], const pg8::Unit& u, int wr, int wc, int fr, int fq) const {
        if (u.seg == 0) mid(acc, u, wr, wc, fr, fq); else fin(acc, u, wr, wc, fr, fq);
    }
};
struct EpiOut {
    static constexpr bool PERM = false, SPLIT2 = false;
    const float* hp; const float* hs; float* Ho;
    __device__ __forceinline__ void operator()(f32x4 (&acc)[2][2][4][2], const pg8::Unit& u, int wr, int wc, int fr, int fq) const {
        const int row0 = u.pm * 256 + wr * 64 + fr, col0 = u.pn * 256 + wc * 32 + 4 * fq;
        const float* src = (u.pm < 32) ? hp + (size_t)row0 * DM : hs + (size_t)(row0 - MP) * DM;
#pragma unroll
        for (int ai = 0; ai < 2; ++ai)
#pragma unroll
            for (int m = 0; m < 4; ++m) { const size_t ro = (size_t)(ai * 128 + m * 16) * DM + col0; float* dst = Ho + (size_t)row0 * DM + ro;
#pragma unroll
                for (int bj = 0; bj < 2; ++bj)
#pragma unroll
                    for (int n = 0; n < 2; ++n) { const f32x4 o = *(const f32x4*)(src + ro + bj * 128 + n * 16) + acc[ai][bj][m][n]; *(f32x4*)(dst + bj * 128 + n * 16) = o; } }
    }
};

__device__ __forceinline__ void conv_unit(const float* __restrict__ W, int K, int N, int Npad, bf16_t* __restrict__ Wt, int ldt, int unit, int lane) {
    const int nnb = Npad >> 6; const int kb = unit / nnb, nb = unit - kb * nnb;
    const int n = nb * 64 + lane, k0 = kb * 64;
    bf16_t* dst = Wt + (size_t)n * ldt + k0;
    if (n < N) {
        const float* src = W + (size_t)k0 * N + n;
        float v[64];
#pragma unroll
        for (int j = 0; j < 64; ++j) v[j] = src[(size_t)j * N];
#pragma unroll
        for (int kk = 0; kk < 64; kk += 8) { u32x4 o; o[0] = pk_bf16(v[kk], v[kk + 1]); o[1] = pk_bf16(v[kk + 2], v[kk + 3]); o[2] = pk_bf16(v[kk + 4], v[kk + 5]); o[3] = pk_bf16(v[kk + 6], v[kk + 7]);
            *(u32x4*)(dst + kk) = o; }
    } else {
#pragma unroll
        for (int kk = 0; kk < 64; kk += 8) *(u32x4*)(dst + kk) = (u32x4){0u, 0u, 0u, 0u};
    }
}
__device__ void phase_convert(const Params& p, int l, int gw, int nw) {
    const int lane = otid() & 63;
    constexpr int U_IN = (NP / 64) * 32, U_P = 32 * 16, U_O = 32 * 32, U_L = U_IN + 2 * U_P + U_O;
    for (int u = gw; u < U_L; u += nw) {
        int r = u;
        if (r < U_IN) conv_unit(P_W_IN + (size_t)l * DM * NIN, DM, NIN, NP, P_WINT + (size_t)l * NP * DM, DM, r, lane);
        else if ((r -= U_IN) < U_P) conv_unit(P_W_PROJ_A + (size_t)l * 1024 * DM, 1024, DM, DM, P_PABT + (size_t)l * DM * DM, DM, r, lane);
        else if ((r -= U_P) < U_P) conv_unit(P_W_PROJ_B + (size_t)l * 1024 * DM, 1024, DM, DM, P_PABT + (size_t)l * DM * DM + 1024, DM, r, lane);
        else { r -= U_P; conv_unit(P_W_OUT + (size_t)l * DM * DM, DM, DM, DM, P_WOT + (size_t)l * DM * DM, DM, r, lane); }
    }
}

__device__ void phase_rmsnorm(const float* hp, const float* hs, const float* g, bf16_t* obf, float* of32) {
    const int lane = otid() & 63, gw = blockIdx.x * 8 + (otid() >> 6), nw = gridDim.x * 8;
    constexpr int U = 2;
    for (int row0 = gw; row0 < MT; row0 += nw * U) {
        f32x4 v[U][8]; float ss[U]; int row[U]; bool ok[U];
#pragma unroll
        for (int u = 0; u < U; ++u) { const int r = row0 + u * nw; ok[u] = r < MT; row[u] = ok[u] ? r : gw;
            const f32x4* x = (const f32x4*)(row[u] < MP ? hp + (size_t)row[u] * DM : hs + (size_t)(row[u] - MP) * DM);
#pragma unroll
            for (int i = 0; i < 8; ++i) v[u][i] = x[lane + 64 * i]; }
#pragma unroll
        for (int u = 0; u < U; ++u) { ss[u] = 0.f;
#pragma unroll
            for (int i = 0; i < 8; ++i) ss[u] += v[u][i][0] * v[u][i][0] + v[u][i][1] * v[u][i][1] + v[u][i][2] * v[u][i][2] + v[u][i][3] * v[u][i][3];
            ss[u] = red64(ss[u]); }
#pragma unroll
        for (int u = 0; u < U; ++u) {
            const float rstd = rsqrtf(ss[u] * (1.f / DM) + 1e-6f);
            if (ok[u]) {
#pragma unroll
                for (int i = 0; i < 8; ++i) { const f32x4 gg = ((const f32x4*)g)[lane + 64 * i]; const f32x4 o = v[u][i] * rstd * gg;
                    if (obf) { u32x2 w; w[0] = pk_bf16(o[0], o[1]); w[1] = pk_bf16(o[2], o[3]); *(u32x2*)(obf + (size_t)row[u] * DM + (lane + 64 * i) * 4) = w; }
                    else *(f32x4*)(of32 + (size_t)row[u] * DM + (lane + 64 * i) * 4) = o; }
            }
        }
    }
}

__device__ void phase_prep(const Params& p, int l) {
    LAS float* sm = (LAS float*)smem_raw;
    LAS bf16_t* twb = (LAS bf16_t*)sm;
    LAS bf16_t* adb = twb + 16 * 72;
    LAS float* red = sm + 1152;
    LAS float* lwla = sm + 2048;
    const int tid = otid(), lane = tid & 63, wv = tid >> 6;
    const int c = tid * 2;
    const float* mu = P_SHIFT_MU + l * DSH;
    for (int i = tid; i < 2 * 8 * 72 / 2; i += 512) { const int m_ = i / 288, r_ = i % 288; ((LAS unsigned*)(twb + m_ * 16 * 72 + 8 * 72))[r_] = 0u; }
    for (int item = blockIdx.x; item < MT / 8; item += gridDim.x) {
        const int row0 = item * 8;
        const bool samp = row0 >= MP;
        const int sb = (row0 - MP) >> 3, pb = row0 >> 11, t0 = row0 & 2047;
        const bf16_t* zr = P_Z + (size_t)row0 * NP;
        const float* sprev = P_STATE_SHIFT + (size_t)(l * 128 + (samp ? sb : 0)) * DSH;
        const bool zprev = (!samp) && (t0 == 0);
        {
            const int j = tid & 127, col = C_WD + j, tp = tid >> 7;
            const float m_ = mu[col];
#pragma unroll
            for (int tt = 0; tt < 2; ++tt) { const int t = tp * 2 + tt;
                const float cur = bf2f(zr[(size_t)t * NP + col]);
                float prv;
                if (t == 0) prv = samp ? sprev[col] : (zprev ? 0.f : bf2f(*(zr + col - NP))); else prv = bf2f(zr[(size_t)(t - 1) * NP + col]);
                const float mix = cur + (prv - cur) * m_;
                if (j < 64) twb[t * 72 + j] = (bf16_t)(pk_bf16(tanhf_(mix), 0.f) & 0xffffu); else adb[t * 72 + j - 64] = (bf16_t)(pk_bf16(mix, 0.f) & 0xffffu); }
        }
        float rm[8][2], km[8][2], vm[8][2];
#pragma unroll
        for (int sec = 0; sec < 3; ++sec) { const int col = sec * 1024 + c;
            float p0, p1;
            if (samp) { const f32x2 s2 = *(const f32x2*)(sprev + col); p0 = s2[0]; p1 = s2[1]; }
            else if (zprev) { p0 = 0.f; p1 = 0.f; }
            else { const unsigned w = *(const unsigned*)(zr + col - NP); p0 = bflo(w); p1 = bfhi(w); }
            const f32x2 m2 = *(const f32x2*)(mu + col);
#pragma unroll
            for (int t = 0; t < 8; ++t) { const unsigned w = *(const unsigned*)(zr + (size_t)t * NP + col); const float c0 = bflo(w), c1 = bfhi(w);
                const float x0 = c0 + (p0 - c0) * m2[0], x1 = c1 + (p1 - c1) * m2[1];
                if (sec == 0) { rm[t][0] = x0; rm[t][1] = x1; } else if (sec == 1) { km[t][0] = x0; km[t][1] = x1; } else { vm[t][0] = x0; vm[t][1] = x1; }
                p0 = c0; p1 = c1; } }
        __syncthreads();
        {
            const int fr = lane & 15, fq = lane >> 4;
            bf16x8 aw[2], aa[2];
#pragma unroll
            for (int ks = 0; ks < 2; ++ks) { aw[ks] = *(const LAS bf16x8*)(twb + fr * 72 + ks * 32 + fq * 8); aa[ks] = *(const LAS bf16x8*)(adb + fr * 72 + ks * 32 + fq * 8); }
            const bf16_t* w2t = P_W2T + ((size_t)l * 1024 + wv * 128 + fr) * 64 + fq * 8;
            const bf16_t* a2t = P_A2T + ((size_t)l * 1024 + wv * 128 + fr) * 64 + fq * 8;
#pragma unroll
            for (int nt = 0; nt < 8; ++nt) {
                f32x4 dw = (f32x4){0.f, 0.f, 0.f, 0.f}, da = (f32x4){0.f, 0.f, 0.f, 0.f};
#pragma unroll
                for (int ks = 0; ks < 2; ++ks) { const bf16x8 bw = *(const bf16x8*)(w2t + nt * 16 * 64 + ks * 32), ba = *(const bf16x8*)(a2t + nt * 16 * 64 + ks * 32);
                    dw = __builtin_amdgcn_mfma_f32_16x16x32_bf16(aw[ks], bw, dw, 0, 0, 0); da = __builtin_amdgcn_mfma_f32_16x16x32_bf16(aa[ks], ba, da, 0, 0, 0); }
                if (fq < 2) { const int ch = wv * 128 + nt * 16 + fr;
#pragma unroll
                    for (int r = 0; r < 4; ++r) *(LAS f32x2*)(lwla + ((fq * 4 + r) * 1024 + ch) * 2) = (f32x2){dw[r], da[r]}; }
            }
        }
        __syncthreads();
        float lw[8][2], la[8][2];
        { const f32x2 w0v = *(const f32x2*)(P_W0 + l * 1024 + c), a0v = *(const f32x2*)(P_A0 + l * 1024 + c);
#pragma unroll
          for (int t = 0; t < 8; ++t) { const f32x4 v = *(const LAS f32x4*)(lwla + (t * 1024 + c) * 2);
              lw[t][0] = w0v[0] + v[0]; la[t][0] = a0v[0] + v[1]; lw[t][1] = w0v[1] + v[2]; la[t][1] = a0v[1] + v[3]; } }
        {
            const f32x2 kkv = *(const f32x2*)(P_K_K + l * 1024 + c), kav = *(const f32x2*)(P_K_A + l * 1024 + c);
            const int hh = c >> 6, cc = c & 63;
#pragma unroll
            for (int t = 0; t < 8; ++t) {
                float dec[2], ag[2], kk[2], kp[2];
#pragma unroll
                for (int e = 0; e < 2; ++e) { const float y = -lw[t][e]; const float sp = fmaxf(y, 0.f) + __logf(1.f + __expf(-fabsf(y)));
                    const float wl = -sp - 0.5f; dec[e] = __expf(-__expf(wl)); ag[e] = sigmoidf_(la[t][e]); kk[e] = km[t][e] * kkv[e]; kp[e] = km[t][e] * (1.f + (ag[e] - 1.f) * kav[e]); }
                const float ss = red32(kk[0] * kk[0] + kk[1] * kk[1]);
                const float inv = __builtin_amdgcn_rsqf(fmaxf(ss, 1e-24f));
                float* rc = P_REC + ((size_t)(row0 + t) * 16 + hh) * 384 + cc;
                *(f32x2*)(rc) = (f32x2){rm[t][0], rm[t][1]};
                *(f32x2*)(rc + 64) = (f32x2){dec[0], dec[1]};
                *(f32x2*)(rc + 128) = (f32x2){kp[0], kp[1]};
                *(f32x2*)(rc + 192) = (f32x2){vm[t][0], vm[t][1]};
                *(f32x2*)(rc + 256) = (f32x2){-kk[0] * inv, -kk[1] * inv};
                *(f32x2*)(rc + 320) = (f32x2){kk[0] * inv * ag[0], kk[1] * inv * ag[1]};
            }
        }
        {
            float x[8][2];
#pragma unroll
            for (int t = 0; t < 8; ++t) { const unsigned w = *(const unsigned*)(zr + (size_t)t * NP + C_VG + c); x[t][0] = bflo(w); x[t][1] = bfhi(w); }
#pragma unroll
            for (int t = 0; t < 8; ++t) { const float s1 = red64(x[t][0] + x[t][1]), s2 = red64(x[t][0] * x[t][0] + x[t][1] * x[t][1]);
                if (lane == 0) { red[wv * 16 + t] = s1; red[wv * 16 + 8 + t] = s2; } }
            __syncthreads();
            const f32x2 gv = *(const f32x2*)(P_SGU_LN_G + l * 1024 + c), bv = *(const f32x2*)(P_SGU_LN_B + l * 1024 + c);
            float vn[8][2];
#pragma unroll
            for (int t = 0; t < 8; ++t) { float s1 = 0.f, s2 = 0.f;
#pragma unroll
                for (int w = 0; w < 8; ++w) { s1 += red[w * 16 + t]; s2 += red[w * 16 + 8 + t]; }
                const float mean = s1 * (1.f / 1024.f), var = fmaxf(s2 * (1.f / 1024.f) - mean * mean, 0.f), rstd = rsqrtf(var + 1e-5f);
                vn[t][0] = (x[t][0] - mean) * rstd * gv[0] + bv[0]; vn[t][1] = (x[t][1] - mean) * rstd * gv[1] + bv[1]; }
#pragma unroll
            for (int e = 0; e < 2; ++e) { u32x4 o; o[0] = pk_bf16(vn[0][e], vn[1][e]); o[1] = pk_bf16(vn[2][e], vn[3][e]); o[2] = pk_bf16(vn[4][e], vn[5][e]); o[3] = pk_bf16(vn[6][e], vn[7][e]);
                if (samp) *(u32x4*)(P_VNTS + ((size_t)sb * 1024 + c + e) * 8) = o;
                else *(u32x4*)(P_VNT + ((size_t)(pb * 16 + (t0 >> 7)) * 1024 + c + e) * 128 + (t0 & 127)) = o; }
            if (samp) {
#pragma unroll
                for (int t = 0; t < 8; ++t) *(f32x2*)(p.out + O_CV + ((size_t)(l * 128 + sb) * 8 + t) * 1024 + c) = (f32x2){vn[t][0], vn[t][1]};
            }
        }
        if (samp) { for (int col = tid; col < DSH; col += 512) p.out[O_SHS + (size_t)(l * 128 + sb) * DSH + col] = bf2f(zr[(size_t)7 * NP + col]); }
        else if (t0 == 2040) { for (int col = tid; col < DSH; col += 512) p.out[O_SHP + (size_t)(l * 4 + pb) * DSH + col] = bf2f(zr[(size_t)7 * NP + col]); }
        __syncthreads();
    }
}

#define WAVE_SYNC() do { asm volatile("s_waitcnt lgkmcnt(0)" ::: "memory"); __builtin_amdgcn_wave_barrier(); } while (0)
__device__ __forceinline__ float dot4(const f32x4 a, const f32x4 b) { return a[0] * b[0] + a[1] * b[1] + a[2] * b[2] + a[3] * b[3]; }

__device__ void scan_prompt_unit(const Params& p, int l, int unit, int wv, int lane, LAS float* lw) {
    const int bh = unit >> 2, b = bh >> 4, h = bh & 15;
    const int rg = lane >> 4, kq = lane & 15;
    const int v0 = (unit & 3) * 16 + wv * 4 + rg;
    const float* recb = P_REC + ((size_t)(b * 2048) * 16 + h) * 384;
    float* yb = P_YBUF + (size_t)(b * 2048) * 1024 + h * 64 + v0;
    constexpr size_t TS = 16 * 384;
    LAS float* lv = lw + 16 * 5 * 64;
    LAS float* ly = lv + 64;
    f32x4 s = (f32x4){0.f, 0.f, 0.f, 0.f};
    f32x4 nxA[4][5], nxB[4][5]; float nvA, nvB;
#define SCAN_LOAD_BATCH(nx, nv, tb_) do { \
        _Pragma("unroll") for (int j = 0; j < 4; ++j) { const float* rp = recb + (size_t)((tb_) + rg + 4 * j) * TS + kq * 4; \
            nx[j][0] = *(const f32x4*)(rp); nx[j][1] = *(const f32x4*)(rp + 64); nx[j][2] = *(const f32x4*)(rp + 128); nx[j][3] = *(const f32x4*)(rp + 256); nx[j][4] = *(const f32x4*)(rp + 320); } \
        nv = recb[(size_t)((tb_) + kq) * TS + 192 + v0]; } while (0)
#define SCAN_BATCH(nx, nv, tb_) do { \
        WAVE_SYNC(); \
        _Pragma("unroll") for (int j = 0; j < 4; ++j) \
            _Pragma("unroll") for (int i = 0; i < 5; ++i) *(LAS f32x4*)(lw + ((rg + 4 * j) * 5 + i) * 64 + kq * 4) = nx[j][i]; \
        lv[kq * 4 + rg] = nv; \
        WAVE_SYNC(); \
        if ((tb_) + 32 < 2048) SCAN_LOAD_BATCH(nx, nv, (tb_) + 32); \
        f32x4 a4 = *(const LAS f32x4*)(lw + 3 * 64 + kq * 4); \
        float pa = dot4(s, a4), py = 0.f; \
        _Pragma("unroll") for (int q = 0; q < 16; ++q) { \
            const LAS float* lc = lw + q * 5 * 64 + kq * 4; \
            const f32x4 w4 = *(const LAS f32x4*)(lc + 64), k4 = *(const LAS f32x4*)(lc + 128), b4 = *(const LAS f32x4*)(lc + 256), r4 = *(const LAS f32x4*)(lc); \
            const float vv = lv[q * 4 + rg]; \
            f32x4 a4n = a4; \
            if (q < 15) a4n = *(const LAS f32x4*)(lc + 5 * 64 + 192); \
            if (q > 0) { red16x2(pa, py); ly[(q - 1) * 4 + rg] = py; } else pa = red16(pa); \
            s = s * w4 + vv * k4 + pa * b4; \
            py = dot4(s, r4); \
            if (q < 15) pa = dot4(s, a4n); \
            a4 = a4n; } \
        py = red16(py); ly[15 * 4 + rg] = py; \
        asm volatile("s_waitcnt lgkmcnt(0)" ::: "memory"); \
        yb[(size_t)((tb_) + kq) * 1024] = ly[kq * 4 + rg]; } while (0)
    SCAN_LOAD_BATCH(nxA, nvA, 0);
    SCAN_LOAD_BATCH(nxB, nvB, 16);
    for (int tb = 0; tb < 2048; tb += 32) {
        SCAN_BATCH(nxA, nvA, tb);
        SCAN_BATCH(nxB, nvB, tb + 16);
    }
#undef SCAN_BATCH
#undef SCAN_LOAD_BATCH
    *(f32x4*)(p.out + O_WKVP + ((size_t)((l * 4 + b) * 16 + h) * 64 + v0) * 64 + kq * 4) = s;
}

__device__ void scan_sample_item(const Params& p, int l, int item, int lane, LAS float* lw) {
    const int b = item >> 4, h = item & 15;
    const int rg = lane >> 4, kq = lane & 15;
    const size_t sbase = (size_t)((l * 128 + b) * 16 + h) * 4096;
    const float* S0 = P_STATE_WKV + sbase;
    f32x4 s[16];
#pragma unroll
    for (int i = 0; i < 16; ++i) s[i] = *(const f32x4*)(S0 + (rg * 16 + i) * 64 + kq * 4);
    const float* recb = P_REC + ((size_t)(MP + b * 8) * 16 + h) * 384;
    float nx[6];
#pragma unroll
    for (int j = 0; j < 6; ++j) nx[j] = recb[j * 64 + lane];
    for (int t = 0; t < 8; ++t) {
        WAVE_SYNC();
#pragma unroll
        for (int j = 0; j < 6; ++j) lw[j * 64 + lane] = nx[j];
        WAVE_SYNC();
        if (t < 7) {
#pragma unroll
            for (int j = 0; j < 6; ++j) nx[j] = recb[(size_t)(t + 1) * 16 * 384 + j * 64 + lane];
        }
        const f32x4 r4 = *(const LAS f32x4*)(lw + 0 * 64 + kq * 4), w4 = *(const LAS f32x4*)(lw + 1 * 64 + kq * 4), k4 = *(const LAS f32x4*)(lw + 2 * 64 + kq * 4),
                    a4 = *(const LAS f32x4*)(lw + 4 * 64 + kq * 4), b4 = *(const LAS f32x4*)(lw + 5 * 64 + kq * 4);
        float ysel = 0.f;
#pragma unroll
        for (int i4 = 0; i4 < 4; ++i4) {
            const f32x4 vv = *(const LAS f32x4*)(lw + 3 * 64 + rg * 16 + i4 * 4);
#pragma unroll
            for (int ii = 0; ii < 4; ++ii) { const int i = i4 * 4 + ii;
                const float sa = red16(dot4(s[i], a4));
                s[i] = s[i] * w4 + vv[ii] * k4 + sa * b4;
                const float y = red16(dot4(s[i], r4));
                ysel = (kq == i) ? y : ysel; }
        }
        P_YBUF[(size_t)(MP + b * 8 + t) * 1024 + h * 64 + rg * 16 + kq] = ysel;
    }
    float* So = p.out + O_WKVS + sbase;
#pragma unroll
    for (int i = 0; i < 16; ++i) *(f32x4*)(So + (rg * 16 + i) * 64 + kq * 4) = s[i];
}

__device__ void sgu_prompt_item(const Params& p, int l, int item, int lane) {
    const int slab = item & 7, g = (item >> 3) & 7, bc = item >> 6;
    const int fr = lane & 15, fq = lane >> 4;
    const bf16_t* vb = P_VNT + ((size_t)(bc * 1024 + g * 128 + slab * 16 + fr)) * 128 + fq * 8;
    bf16x8 vf[4];
#pragma unroll
    for (int ks = 0; ks < 4; ++ks) vf[ks] = *(const bf16x8*)(vb + ks * 32);
    const float* Wg = P_SGU_W + (size_t)(l * 8 + g) * 16384;
    const float* bg = P_SGU_B + (size_t)(l * 8 + g) * 128;
    const int ch = g * 128 + slab * 16 + fq * 4;
#pragma unroll
    for (int tt = 0; tt < 8; ++tt) {
        f32x4 acc = (f32x4){0.f, 0.f, 0.f, 0.f};
        const int t = tt * 16 + fr;
#pragma unroll
        for (int ks = 0; ks <= tt / 2; ++ks) {
            const int s0 = ks * 32 + fq * 8;
            const f32x4 wa = *(const f32x4*)(Wg + t * 128 + s0), wb = *(const f32x4*)(Wg + t * 128 + s0 + 4);
            float wv[8] = {wa[0], wa[1], wa[2], wa[3], wb[0], wb[1], wb[2], wb[3]};
#pragma unroll
            for (int j = 0; j < 8; ++j) wv[j] = (s0 + j <= t) ? wv[j] : 0.f;
            u32x4 pk; pk[0] = pk_bf16(wv[0], wv[1]); pk[1] = pk_bf16(wv[2], wv[3]); pk[2] = pk_bf16(wv[4], wv[5]); pk[3] = pk_bf16(wv[6], wv[7]);
            bf16x8 wf; __builtin_memcpy(&wf, &pk, 16);
            acc = __builtin_amdgcn_mfma_f32_16x16x32_bf16(vf[ks], wf, acc, 0, 0, 0);
        }
        const size_t row = (size_t)bc * 128 + t;
        const float sbv = bg[t];
        const u32x2 uu = *(const u32x2*)(P_Z + row * NP + C_U + ch), gg = *(const u32x2*)(P_Z + row * NP + C_GG + ch);
        const float o0 = bflo(uu[0]) * (acc[0] + sbv) * siluf_(bflo(gg[0])), o1 = bfhi(uu[0]) * (acc[1] + sbv) * siluf_(bfhi(gg[0]));
        const float o2 = bflo(uu[1]) * (acc[2] + sbv) * siluf_(bflo(gg[1])), o3 = bfhi(uu[1]) * (acc[3] + sbv) * siluf_(bfhi(gg[1]));
        u32x2 o; o[0] = pk_bf16(o0, o1); o[1] = pk_bf16(o2, o3);
        *(u32x2*)(P_YAB + row * DM + 1024 + ch) = o;
    }
}

__device__ void sgu_sample_item(const Params& p, int l, int item, int lane) {
    const int b = item >> 4, ch = (item & 15) * 64 + lane, g = ch >> 7;
    const u32x4 vv = *(const u32x4*)(P_VNTS + ((size_t)b * 1024 + ch) * 8);
    float vn[8] = {bflo(vv[0]), bfhi(vv[0]), bflo(vv[1]), bfhi(vv[1]), bflo(vv[2]), bfhi(vv[2]), bflo(vv[3]), bfhi(vv[3])};
    const float* Wg = P_SGU_W + (size_t)(l * 8 + g) * 16384;
    const float* bg = P_SGU_B + (size_t)(l * 8 + g) * 128;
#pragma unroll
    for (int t = 0; t < 8; ++t) {
        float sacc = bg[t];
#pragma unroll
        for (int s = 0; s <= t; ++s) sacc += Wg[t * 128 + s] * vn[s];
        const size_t row = (size_t)MP + b * 8 + t;
        const float u = bf2f(P_Z[row * NP + C_U + ch]), gg = bf2f(P_Z[row * NP + C_GG + ch]);
        const float o = u * sacc * siluf_(gg);
        P_YAB[row * DM + 1024 + ch] = (bf16_t)(pk_bf16(o, 0.f) & 0xffffu);
    }
}

__device__ void phase_scan(const Params& p, int l) {
    const int tid = otid(), lane = tid & 63, wv = __builtin_amdgcn_readfirstlane(tid >> 6);
    LAS float* lw = (wv < 4) ? (LAS float*)smem_raw + wv * 6144 : (LAS float*)smem_raw + 24576 + (wv - 4) * 2048;
#ifndef REP_PR
#define REP_PR 1
#endif
#ifndef REP_IT
#define REP_IT 1
#endif
    if (wv < 4) {
      for (int rr = 0; rr < REP_PR; ++rr)
        for (int u0 = blockIdx.x; u0 < 256; u0 += gridDim.x) { const int unit = (gridDim.x == 256) ? ((u0 & 7) * 32 + (u0 >> 3)) : u0; scan_prompt_unit(p, l, unit, wv, lane, lw); }
    } else {
        const int nw = gridDim.x * 4;
      for (int rr = 0; rr < REP_IT; ++rr)
        for (int it = blockIdx.x * 4 + (wv - 4); it < 2048 + 4096 + 2048; it += nw) {
            if (it < 2048) scan_sample_item(p, l, it, lane, lw);
            else if (it < 6144) sgu_prompt_item(p, l, it - 2048, lane);
            else sgu_sample_item(p, l, it - 6144, lane);
        }
        if (l + 1 < DEPTH) phase_convert(p, l + 1, blockIdx.x * 4 + (wv - 4), nw);
    }
}

__device__ void phase_post(const Params& p, int l) {
    const int lane = otid() & 63, gw = blockIdx.x * 8 + (otid() >> 6), nw = gridDim.x * 8;
    const int hg = lane >> 4, kq = lane & 15;
    constexpr int U = 4;
    for (int it0 = gw; it0 < MT * 4; it0 += nw * U) {
        f32x4 y[U], r4[U], k4[U], v4[U], rk[U], lg[U], lb[U]; u32x2 gr[U]; int row[U], ch[U]; bool ok[U];
#pragma unroll
        for (int u = 0; u < U; ++u) { const int it = it0 + u * nw; ok[u] = it < MT * 4; const int itc = ok[u] ? it : gw;
            row[u] = itc >> 2; const int h = (itc & 3) * 4 + hg; ch[u] = h * 64 + kq * 4;
            y[u] = *(const f32x4*)(P_YBUF + (size_t)row[u] * 1024 + ch[u]);
            const float* rc = P_REC + ((size_t)row[u] * 16 + h) * 384 + kq * 4;
            r4[u] = *(const f32x4*)(rc); k4[u] = *(const f32x4*)(rc + 128); v4[u] = *(const f32x4*)(rc + 192);
            rk[u] = *(const f32x4*)(P_R_K + (size_t)l * 1024 + ch[u]);
            lg[u] = *(const f32x4*)(P_LNX_G + (size_t)l * 1024 + ch[u]); lb[u] = *(const f32x4*)(P_LNX_B + (size_t)l * 1024 + ch[u]);
            gr[u] = *(const u32x2*)(P_Z + (size_t)row[u] * NP + C_GR + ch[u]); }
#pragma unroll
        for (int u = 0; u < U; ++u) {
            const float mean = red16(y[u][0] + y[u][1] + y[u][2] + y[u][3]) * (1.f / 64.f);
            const f32x4 d = y[u] - mean;
            const float var = red16(dot4(d, d)) * (1.f / 64.f);
            const float rs = rsqrtf(var + 64e-5f);
            const float srk = red16(r4[u][0] * k4[u][0] * rk[u][0] + r4[u][1] * k4[u][1] * rk[u][1] + r4[u][2] * k4[u][2] * rk[u][2] + r4[u][3] * k4[u][3] * rk[u][3]);
            const f32x4 yo = d * rs * lg[u] + lb[u] + srk * v4[u];
            u32x2 o; o[0] = pk_bf16(yo[0] * siluf_(bflo(gr[u][0])), yo[1] * siluf_(bfhi(gr[u][0]))); o[1] = pk_bf16(yo[2] * siluf_(bflo(gr[u][1])), yo[3] * siluf_(bfhi(gr[u][1])));
            if (ok[u]) *(u32x2*)(P_YAB + (size_t)row[u] * DM + ch[u]) = o;
        }
    }
}

#define XB_TMO      128
#define XB_XCNT(j)  (256  + 64 * (j))
#define XB_XSUB(j)  (1280 + 64 * (j))
#define XB_XGEN(j)  (2304 + 64 * (j))
#define XB_TOP      3328
#define XB_TOPGEN   3392
#define XCD_BAR_WORDS 3456
#define XB_SPIN_CAP (1u << 20)
__device__ __forceinline__ unsigned xb_ld(unsigned* p)              { return __hip_atomic_load(p, __ATOMIC_RELAXED, __HIP_MEMORY_SCOPE_AGENT); }
__device__ __forceinline__ unsigned xb_add(unsigned* p, unsigned v) { return __hip_atomic_fetch_add(p, v, __ATOMIC_RELAXED, __HIP_MEMORY_SCOPE_AGENT); }
__device__ __forceinline__ unsigned xb_xcc_id() { return (unsigned)__builtin_amdgcn_s_getreg((3 << 11) | 20) & 0xFu; }
#define XB_SPIN(cond, bar) do { unsigned _sp = 0; while (cond) { __builtin_amdgcn_s_sleep(1); \
    if ((++_sp & 255u) == 0u) { if (xb_ld(&(bar)[XB_TMO])) break; if (_sp > XB_SPIN_CAP) { atomicAdd(&(bar)[XB_TMO], 1u); break; } } } } while (0)
struct XcdBarrier { unsigned* bar; unsigned x; volatile LAS unsigned* st; };
__device__ __forceinline__ XcdBarrier xcd_barrier_post(unsigned* bar, volatile LAS unsigned* st) {
    XcdBarrier b; b.bar = bar; b.x = xb_xcc_id(); b.st = st;
    if (threadIdx.x == 0) (void)xb_add(&bar[XB_XCNT(b.x)], 1u);
    return b;
}
__device__ __forceinline__ void xcd_barrier_complete(unsigned* bar, unsigned x, unsigned& nloc, unsigned& nx) {
    const unsigned G = gridDim.x * gridDim.y * gridDim.z;
    unsigned sum, cnt, mine, sp = 0u;
    for (;;) {
        sum = 0u; cnt = 0u; mine = 0u;
#pragma unroll
        for (unsigned j = 0; j < 16; ++j) { const unsigned c = xb_ld(&bar[XB_XCNT(j)]); sum += c; cnt += (c > 0u) ? 1u : 0u; mine = (j == x) ? c : mine; }
        if (sum == G) break;
        __builtin_amdgcn_s_sleep(1);
        if ((++sp & 255u) == 0u) { if (xb_ld(&bar[XB_TMO])) break; if (sp > XB_SPIN_CAP) { atomicAdd(&bar[XB_TMO], 1u); break; } }
    }
    nloc = mine > 0u ? mine : 1u; nx = cnt > 0u ? cnt : 1u;
}
__device__ __forceinline__ void xcd_barrier(const XcdBarrier& b) {
    asm volatile("s_waitcnt vmcnt(0)" ::: "memory");
    __syncthreads();
    if (threadIdx.x == 0) {
        unsigned* bar = b.bar;
        __builtin_amdgcn_s_waitcnt(0);
        unsigned nloc = b.st[0], nx = b.st[1];
        if (nloc == 0u) { xcd_barrier_complete(bar, b.x, nloc, nx); b.st[0] = nloc; b.st[1] = nx; }
        const unsigned old = xb_add(&bar[XB_XSUB(b.x)], 1u);
        const unsigned gen = old / nloc;
        if (old + 1u == (gen + 1u) * nloc) {
            __builtin_amdgcn_fence(__ATOMIC_RELEASE, "agent");
            asm volatile("s_waitcnt vmcnt(0)" ::: "memory");
            const unsigned og = xb_add(&bar[XB_TOP], 1u);
            const unsigned tg = og / nx;
            if (og + 1u == (tg + 1u) * nx) xb_add(&bar[XB_TOPGEN], 1u);
            else XB_SPIN(xb_ld(&bar[XB_TOPGEN]) == tg, bar);
            __builtin_amdgcn_fence(__ATOMIC_ACQUIRE, "agent");
            xb_add(&bar[XB_XGEN(b.x)], 1u);
            asm volatile("s_waitcnt vmcnt(0)" ::: "memory");
        } else {
            XB_SPIN(xb_ld(&bar[XB_XGEN(b.x)]) == gen, bar);
            __builtin_amdgcn_fence(__ATOMIC_ACQUIRE, "agent");
            asm volatile("s_waitcnt vmcnt(0)" ::: "memory");
        }
    }
    __syncthreads();
}

template <int ST> __device__ __forceinline__ void run_stage(const Params& p, int l) {
    LAS unsigned char* lds = (LAS unsigned char*)smem_raw;
    pg8::StaticOrder S;
    if (ST == 7) { { const int gw = blockIdx.x * 8 + (otid() >> 6), lane = otid() & 63;
                     if (gw < 128) { const int l2 = gw >> 5, m2 = (gw >> 4) & 1, u2 = gw & 15;
                         conv_unit((m2 ? P_A2 : P_W2) + (size_t)l2 * 64 * 1024, 64, 1024, 1024, (m2 ? P_A2T : P_W2T) + (size_t)l2 * 1024 * 64, 64, u2, lane); } }
                   phase_convert(p, 0, blockIdx.x * 8 + (otid() >> 6), gridDim.x * 8); phase_rmsnorm(P_X_PROMPT, P_X_SAMPLE, P_NORM_G, P_XN, nullptr); }
    if (ST == 0) { pg8::Gemm g{P_XN, P_WINT + (size_t)l * NP * DM, MT, NP, DM}; S.init(MT, NP, gridDim.x, blockIdx.x); EpiZ e{P_Z}; pg8::gemm_phase(lds, g, S, e); }
    if (ST == 1) phase_prep(p, l);
    if (ST == 2) phase_scan(p, l);
    if (ST == 3) phase_post(p, l);
    if (ST == 4) { pg8::Gemm g{P_YAB, P_PABT + (size_t)l * DM * DM, MT, DM, DM}; S.init(MT, DM, gridDim.x, blockIdx.x, 1); EpiMerge e{P_Z, P_M}; pg8::gemm_phase(lds, g, S, e); }
    if (ST == 5) { pg8::Gemm g{P_M, P_WOT + (size_t)l * DM * DM, MT, DM, DM}; S.init(MT, DM, gridDim.x, blockIdx.x);
                   EpiOut e{l == 0 ? P_X_PROMPT : P_H, l == 0 ? P_X_SAMPLE : P_H + (size_t)MP * DM, P_H}; pg8::gemm_phase(lds, g, S, e); }
    if (ST == 6) { if (l < DEPTH - 1) phase_rmsnorm(P_H, P_H + (size_t)MP * DM, P_NORM_G + (size_t)(l + 1) * DM, P_XN, nullptr);
                   else phase_rmsnorm(P_H, P_H + (size_t)MP * DM, P_FINAL_G, nullptr, p.out + O_YP); }
}

#if MK_SINGLE
#ifndef REP0
#define REP0 1
#endif
#ifndef REP1
#define REP1 1
#endif
#ifndef REP2
#define REP2 1
#endif
#ifndef REP3
#define REP3 1
#endif
#ifndef REP4
#define REP4 1
#endif
#ifndef REP6
#define REP6 1
#endif
#ifndef REP7
#define REP7 1
#endif
__global__ void __launch_bounds__(512, 2) mega(Params p) {
    cg::grid_group grid = cg::this_grid();
    __shared__ uint4 xb_words;
    if (threadIdx.x == 0) xb_words = make_uint4(0u, 0u, 0u, 0u);
    __syncthreads();
    const XcdBarrier xb = xcd_barrier_post((unsigned*)(p.ws + WS_BAR), (volatile LAS unsigned*)&xb_words);
#define GSYNC() xcd_barrier(xb)
    for (int r = 0; r < REP7; ++r) { run_stage<7>(p, 0); grid.sync(); }
    for (int l = 0; l < DEPTH; ++l) {
        for (int r = 0; r < REP0; ++r) { run_stage<0>(p, l); GSYNC(); }
        for (int r = 0; r < REP1; ++r) { run_stage<1>(p, l); GSYNC(); }
        for (int r = 0; r < REP2; ++r) { run_stage<2>(p, l); GSYNC(); }
        for (int r = 0; r < REP3; ++r) { run_stage<3>(p, l); GSYNC(); }
        for (int r = 0; r < REP4; ++r) { run_stage<4>(p, l); GSYNC(); }
        run_stage<5>(p, l); GSYNC();
        for (int r = 0; r < REP6; ++r) { run_stage<6>(p, l); if (l + 1 < DEPTH || r + 1 < REP6) GSYNC(); }
    }
}
#else
template <int ST> __global__ void __launch_bounds__(512, 2) stage_k(Params p, int l) { run_stage<ST>(p, l); }
#endif

template <class K> static void set_lds(K k, size_t bytes) { (void)hipFuncSetAttribute((const void*)k, hipFuncAttributeMaxDynamicSharedMemorySize, (int)bytes); }

extern "C" void kernel_launch(void* const* d_in, const int* in_sizes, int n_in, void* d_out, int out_size, void* d_ws, size_t ws_size, hipStream_t stream) {
    constexpr size_t kDynLds = 131072;
    static int grid_blocks = 0;
    if (!grid_blocks) {
        int dev = 0, cus = 0;
        (void)hipGetDevice(&dev);
        (void)hipDeviceGetAttribute(&cus, hipDeviceAttributeMultiprocessorCount, dev);
#if MK_SINGLE
        int per_cu = 0;
        set_lds(mega, kDynLds);
        (void)hipOccupancyMaxActiveBlocksPerMultiprocessor(&per_cu, mega, 512, kDynLds);
        if (per_cu < 1) fprintf(stderr, "occupancy query returned %d\n", per_cu);
#else
        set_lds(stage_k<0>, kDynLds); set_lds(stage_k<1>, kDynLds); set_lds(stage_k<2>, kDynLds); set_lds(stage_k<3>, kDynLds);
        set_lds(stage_k<4>, kDynLds); set_lds(stage_k<5>, kDynLds); set_lds(stage_k<6>, kDynLds); set_lds(stage_k<7>, kDynLds);
#endif
        grid_blocks = cus > 0 ? cus : 256;
    }
    Params p{};
    for (int i = 0; i < 24; ++i) p.in[i] = (const float*)d_in[i];
    p.out = (float*)d_out; p.ws = (char*)d_ws;
    if (ws_size < WS_END) fprintf(stderr, "workspace too small: %zu < %zu\n", ws_size, (size_t)WS_END);
#if MK_SINGLE
    (void)hipMemsetAsync(p.ws + WS_BAR, 0, (size_t)XCD_BAR_WORDS_C * 4, stream);
    void* args[] = {&p};
    hipError_t e = hipLaunchCooperativeKernel((void*)mega, dim3(grid_blocks), dim3(512), args, kDynLds, stream);
    if (e != hipSuccess) fprintf(stderr, "cooperative launch failed: %s (grid %d)\n", hipGetErrorString(e), grid_blocks);
#else
    const dim3 G(grid_blocks), B(512);
    hipLaunchKernelGGL(stage_k<7>, G, B, kDynLds, stream, p, 0);
    for (int l = 0; l < DEPTH; ++l) {
        hipLaunchKernelGGL(stage_k<0>, G, B, kDynLds, stream, p, l);
        hipLaunchKernelGGL(stage_k<1>, G, B, kDynLds, stream, p, l);
        hipLaunchKernelGGL(stage_k<2>, G, B, kDynLds, stream, p, l);
        hipLaunchKernelGGL(stage_k<3>, G, B, kDynLds, stream, p, l);
        hipLaunchKernelGGL(stage_k<4>, G, B, kDynLds, stream, p, l);
        hipLaunchKernelGGL(stage_k<5>, G, B, kDynLds, stream, p, l);
        hipLaunchKernelGGL(stage_k<6>, G, B, kDynLds, stream, p, l);
    }
#endif
}
```

```cpp
#include <hip/hip_runtime.h>
#include <hip/hip_cooperative_groups.h>
#include <cstdio>
namespace cg = cooperative_groups;

#ifndef MK_SINGLE
#define MK_SINGLE 1
#endif

#define LAS __attribute__((address_space(3)))
typedef unsigned short bf16_t;
typedef short bf16x8 __attribute__((ext_vector_type(8)));
typedef float f32x4 __attribute__((ext_vector_type(4)));
typedef float f32x2 __attribute__((ext_vector_type(2)));
typedef unsigned u32x4 __attribute__((ext_vector_type(4)));
typedef unsigned u32x2 __attribute__((ext_vector_type(2)));

constexpr int DM = 2048, DEPTH = 4;
constexpr int MP = 8192, MS = 1024, MT = 9216;
constexpr int DSH = 3200;
constexpr int NP = 11520;
constexpr int NIN = 11392;
constexpr int C_R = 0, C_K = 1024, C_V = 2048, C_WD = 3072, C_AD = 3136, C_GR = 3200, C_U = 4224, C_VG = 5248, C_GG = 6272, C_GA = 7296, C_GB = 9344;
constexpr size_t O_YP = 0, O_WKVP = 18874368, O_SHP = 19922944, O_WKVS = 19974144, O_SHS = 53528576, O_CV = 55166976;
constexpr int NPHASE = 1 + 7 * DEPTH;

constexpr int XCD_BAR_WORDS_C = 3456;
struct Params { const float* in[24]; float* out; char* ws; };
constexpr size_t al256(size_t x) { return (x + 255) & ~(size_t)255; }
constexpr size_t WS_WINT = 0;
constexpr size_t WS_PABT = WS_WINT + al256((size_t)DEPTH * NP * DM * 2);
constexpr size_t WS_WOT = WS_PABT + al256((size_t)DEPTH * DM * DM * 2);
constexpr size_t WS_XN = WS_WOT + al256((size_t)DEPTH * DM * DM * 2);
constexpr size_t WS_Z = WS_XN + al256((size_t)MT * DM * 2);
constexpr size_t WS_VNT = WS_Z + al256((size_t)MT * NP * 2);
constexpr size_t WS_VNTS = WS_VNT + al256((size_t)64 * 1024 * 128 * 2);
constexpr size_t WS_YAB = WS_VNTS + al256((size_t)128 * 1024 * 8 * 2);
constexpr size_t WS_M = WS_YAB + al256((size_t)MT * DM * 2);
constexpr size_t WS_H = WS_M + al256((size_t)MT * DM * 2);
constexpr size_t WS_REC = WS_H + al256((size_t)MT * DM * 4);
constexpr size_t WS_YBUF = WS_REC + al256((size_t)MT * 16 * 384 * 4);
constexpr size_t WS_W2T = WS_YBUF + al256((size_t)MT * 1024 * 4);
constexpr size_t WS_A2T = WS_W2T + al256((size_t)DEPTH * 1024 * 64 * 2);
constexpr size_t WS_BAR = WS_A2T + al256((size_t)DEPTH * 1024 * 64 * 2);
constexpr size_t WS_END = WS_BAR + al256((size_t)XCD_BAR_WORDS_C * 4);
#define P_X_PROMPT (p.in[0])
#define P_X_SAMPLE (p.in[1])
#define P_STATE_WKV (p.in[2])
#define P_STATE_SHIFT (p.in[3])
#define P_NORM_G (p.in[4])
#define P_W_IN (p.in[5])
#define P_SHIFT_MU (p.in[6])
#define P_W0 (p.in[7])
#define P_W2 (p.in[8])
#define P_A0 (p.in[9])
#define P_A2 (p.in[10])
#define P_K_K (p.in[11])
#define P_K_A (p.in[12])
#define P_R_K (p.in[13])
#define P_LNX_G (p.in[14])
#define P_LNX_B (p.in[15])
#define P_SGU_LN_G (p.in[16])
#define P_SGU_LN_B (p.in[17])
#define P_SGU_W (p.in[18])
#define P_SGU_B (p.in[19])
#define P_W_PROJ_A (p.in[20])
#define P_W_PROJ_B (p.in[21])
#define P_W_OUT (p.in[22])
#define P_FINAL_G (p.in[23])
#define P_WINT ((bf16_t*)(p.ws + WS_WINT))
#define P_PABT ((bf16_t*)(p.ws + WS_PABT))
#define P_WOT ((bf16_t*)(p.ws + WS_WOT))
#define P_XN ((bf16_t*)(p.ws + WS_XN))
#define P_Z ((bf16_t*)(p.ws + WS_Z))
#define P_VNT ((bf16_t*)(p.ws + WS_VNT))
#define P_VNTS ((bf16_t*)(p.ws + WS_VNTS))
#define P_YAB ((bf16_t*)(p.ws + WS_YAB))
#define P_M ((bf16_t*)(p.ws + WS_M))
#define P_H ((float*)(p.ws + WS_H))
#define P_REC ((float*)(p.ws + WS_REC))
#define P_YBUF ((float*)(p.ws + WS_YBUF))
#define P_W2T ((bf16_t*)(p.ws + WS_W2T))
#define P_A2T ((bf16_t*)(p.ws + WS_A2T))

extern __shared__ __attribute__((aligned(16))) unsigned char smem_raw[];

__device__ __forceinline__ int otid() { int t = threadIdx.x; asm volatile("" : "+v"(t)); return t; }
__device__ __forceinline__ float bf2f(bf16_t v) { return __uint_as_float(((unsigned)v) << 16); }
__device__ __forceinline__ float bflo(unsigned v) { return __uint_as_float(v << 16); }
__device__ __forceinline__ float bfhi(unsigned v) { return __uint_as_float(v & 0xffff0000u); }
__device__ __forceinline__ unsigned pk_bf16(float lo, float hi) { unsigned r; asm("v_cvt_pk_bf16_f32 %0, %1, %2" : "=v"(r) : "v"(lo), "v"(hi)); return r; }
template <int CTRL> __device__ __forceinline__ float dppf(float x) { return __int_as_float(__builtin_amdgcn_update_dpp(0, __float_as_int(x), CTRL, 0xF, 0xF, true)); }
__device__ __forceinline__ float red16(float x) { x += dppf<0xB1>(x); x += dppf<0x4E>(x); x += dppf<0x141>(x); x += dppf<0x140>(x); return x; }
__device__ __forceinline__ void red16x2(float& x, float& y) { x += dppf<0xB1>(x); y += dppf<0xB1>(y); x += dppf<0x4E>(x); y += dppf<0x4E>(y); x += dppf<0x141>(x); y += dppf<0x141>(y); x += dppf<0x140>(x); y += dppf<0x140>(y); }
__device__ __forceinline__ float red32(float x) { x = red16(x); x += __shfl_xor(x, 16); return x; }
__device__ __forceinline__ float red64(float x) { x = red16(x); x += __shfl_xor(x, 16); x += __shfl_xor(x, 32); return x; }
__device__ __forceinline__ float sigmoidf_(float x) { return __builtin_amdgcn_rcpf(1.f + __expf(-x)); }
__device__ __forceinline__ float tanhf_(float x) { const float e = __expf(2.f * fminf(fmaxf(x, -15.f), 15.f)); return 1.f - 2.f * __builtin_amdgcn_rcpf(1.f + e); }
__device__ __forceinline__ float siluf_(float x) { return x * __builtin_amdgcn_rcpf(1.f + __expf(-x)); }

namespace pg8 {
constexpr int BM = 256, BK = 64, HALF = 128, HTB = HALF * BK * 2, STAGE_BYTES = 8 * HTB, NXCD = 8, WGM = 8;
__device__ __forceinline__ int lds_byte(int r, int c) { const int st = (r >> 4) * 2 + (c >> 5), rr = r & 15, cc = c & 31, ob = rr * 64 + cc * 2; return st * 1024 + (ob ^ (((ob >> 9) & 1) << 5)); }
__device__ __forceinline__ void stage_rc(int b, int& R, int& C) { const int st = b / 1024, sb = b % 1024, swz = sb ^ (((sb >> 9) & 1) << 5); R = (st >> 1) * 16 + swz / 64; C = (st & 1) * 32 + (swz % 64) / 2; }
__device__ __forceinline__ int perm32(int rho) { const int n = rho >> 4, i = rho & 15; return 8 * (i >> 2) + 4 * n + (i & 3); }
struct Unit { int pm, pn, seg; };
struct Gemm { const bf16_t* A; const bf16_t* Bt; int M, N, K; };
struct StaticOrder {
    int nM, nN, nwg, G, c;
    __device__ void init(int M, int N, int G_, int c_, int split_ = 0) { nM = M / BM; nN = N / BM; nwg = nM * nN; G = G_; c = c_; split = split_; }
    int split;
    __device__ bool next(int i, Unit& u) const {
        u.seg = split ? (i & 1) : 0; if (split) i >>= 1;
        const long L = (long)i * G + c; if (L >= nwg) return false;
        int wgid = (int)L; { const int q = nwg / NXCD, r = nwg % NXCD, xcd = wgid % NXCD, off = wgid / NXCD; wgid = (xcd < r ? xcd * (q + 1) : r * (q + 1) + (xcd - r) * q) + off; }
        const int nig = WGM * nN, gid = wgid / nig, fm = gid * WGM, gsz = (nM - fm) < WGM ? (nM - fm) : WGM;
        u.pm = fm + ((wgid % nig) % gsz); u.pn = (wgid % nig) / gsz; return true;
    }
};

template <class Epi, class Sched>
__device__ __forceinline__ void gemm_phase(LAS unsigned char* lds, const Gemm g, const Sched& S, const Epi& E) {
    const int tid = otid(), wid = __builtin_amdgcn_readfirstlane(tid >> 6), lane = tid & 63, wr = wid >> 2, wc = wid & 3, fr = lane & 15, fq = lane >> 4;
    const int ld = g.K, nt = Epi::SPLIT2 ? g.K / BK / 2 : g.K / BK;
    const size_t segstep = (size_t)nt * BK * 2;
    unsigned voffA[2], voffB[2];
#pragma unroll
    for (int i = 0; i < 2; ++i) { int R, C; stage_rc(tid * 16 + i * 8192, R, C); const int Rb = Epi::PERM ? ((R & ~31) + perm32(R & 31)) : R;
        voffA[i] = (unsigned)(R * ld + C) * 2u; voffB[i] = (unsigned)(Rb * ld + C) * 2u; }
    const size_t kstep = (size_t)(BK * 2);
    const size_t hstep = (size_t)HALF * ld * 2;
    const size_t tstep = 2 * hstep;
    const unsigned ldsw = (unsigned)wid * 1024u;
    const int aoff = lds_byte(wr * 64 + fr, fq * 8), boff = lds_byte(wc * 32 + fr, fq * 8);
#define PG8_SA(b, h) (((b) * 2 + (h)) * HTB)
#define PG8_SB(b, h) ((4 + (b) * 2 + (h)) * HTB)
#define PG8_STAGE(bufoff, gbase, voff) do { _Pragma("unroll") for (int _i = 0; _i < 2; ++_i) \
        __builtin_amdgcn_global_load_lds((const unsigned*)((const char*)(gbase) + (voff)[_i]), (LAS unsigned*)(lds + (bufoff) + ldsw + _i * 8192), 16, 0, 0); } while (0)
#define PG8_LDA(dst, b, h) do { _Pragma("unroll") for (int m = 0; m < 4; ++m) _Pragma("unroll") for (int k = 0; k < 2; ++k) dst[m][k] = *(const LAS bf16x8*)(lds + PG8_SA(b, h) + aoff + m * 2048 + k * 1024); } while (0)
#define PG8_LDB(dst, b, h) do { _Pragma("unroll") for (int n = 0; n < 2; ++n) _Pragma("unroll") for (int k = 0; k < 2; ++k) dst[n][k] = *(const LAS bf16x8*)(lds + PG8_SB(b, h) + boff + n * 2048 + k * 1024); } while (0)
#define PG8_MMA(ai, bj, At, Bt) do { __builtin_amdgcn_s_setprio(1); _Pragma("unroll") for (int m = 0; m < 4; ++m) _Pragma("unroll") for (int n = 0; n < 2; ++n) _Pragma("unroll") for (int k = 0; k < 2; ++k) \
        acc[ai][bj][m][n] = __builtin_amdgcn_mfma_f32_16x16x32_bf16(Bt[n][k], At[m][k], acc[ai][bj][m][n], 0, 0, 0); __builtin_amdgcn_s_setprio(0); } while (0)
#define PG8_WAIT_V(n) asm volatile("s_waitcnt vmcnt(" #n ")" ::: "memory")
#define PG8_WAIT_L(n) asm volatile("s_waitcnt lgkmcnt(" #n ")" ::: "memory")
#define PG8_BAR __builtin_amdgcn_s_barrier()
#define PG8_SCHED __builtin_amdgcn_sched_barrier(0)
    Unit cur, nxt; int ui = 0;
    if (!S.next(0, cur)) return;
    f32x4 acc[2][2][4][2];
#pragma unroll
    for (int a = 0; a < 2; ++a)
#pragma unroll
        for (int b = 0; b < 2; ++b)
#pragma unroll
            for (int m = 0; m < 4; ++m)
#pragma unroll
                for (int n = 0; n < 2; ++n) acc[a][b][m][n] = (f32x4){0.f, 0.f, 0.f, 0.f};
    bf16x8 At[4][2], B0[2][2], B1[2][2];
    const char* cA = (const char*)g.A + (size_t)cur.pm * tstep + (Epi::SPLIT2 ? cur.seg * segstep : 0); const char* cB = (const char*)g.Bt + (size_t)cur.pn * tstep + (Epi::SPLIT2 ? cur.seg * segstep : 0);
    PG8_STAGE(PG8_SB(0, 0), cB, voffB); PG8_STAGE(PG8_SA(0, 0), cA, voffA); PG8_STAGE(PG8_SB(0, 1), cB + hstep, voffB); PG8_STAGE(PG8_SA(0, 1), cA + hstep, voffA);
    if (wr == 1) PG8_BAR;
    PG8_WAIT_V(4); PG8_BAR;
    PG8_STAGE(PG8_SB(1, 0), cB + kstep, voffB); PG8_STAGE(PG8_SA(1, 0), cA + kstep, voffA); PG8_STAGE(PG8_SB(1, 1), cB + hstep + kstep, voffB);
    PG8_WAIT_V(6); PG8_BAR;
    for (;;) {
        const bool has_next = S.next(ui + 1, nxt);
        const char* nA = has_next ? (const char*)g.A + (size_t)nxt.pm * tstep + (Epi::SPLIT2 ? nxt.seg * segstep : 0) : cA; const char* nB = has_next ? (const char*)g.Bt + (size_t)nxt.pn * tstep + (Epi::SPLIT2 ? nxt.seg * segstep : 0) : cB;
        for (int t = 0; t < nt; t += 2) {
            const bool last = (t == nt - 2);
            const char* a1 = cA + (size_t)(t + 1) * kstep;
            const char* a2 = last ? nA : cA + (size_t)(t + 2) * kstep; const char* b2 = last ? nB : cB + (size_t)(t + 2) * kstep;
            const char* a3 = a2 + kstep; const char* b3 = b2 + kstep;
            PG8_LDB(B0, 0, 0); PG8_SCHED; PG8_LDA(At, 0, 0); PG8_STAGE(PG8_SA(1, 1), a1 + hstep, voffA);
            PG8_WAIT_L(8); PG8_BAR; PG8_WAIT_L(0); PG8_MMA(0, 0, At, B0); PG8_BAR; PG8_SCHED;
            PG8_LDB(B1, 0, 1); PG8_STAGE(PG8_SB(0, 0), b2, voffB);
            PG8_BAR; PG8_WAIT_L(0); PG8_MMA(0, 1, At, B1); PG8_BAR;
            PG8_LDA(At, 0, 1); PG8_STAGE(PG8_SA(0, 0), a2, voffA);
            PG8_BAR; PG8_WAIT_L(0); PG8_MMA(1, 0, At, B0); PG8_BAR; PG8_SCHED;
            PG8_STAGE(PG8_SB(0, 1), b2 + hstep, voffB);
            PG8_WAIT_V(6); PG8_BAR; PG8_MMA(1, 1, At, B1); PG8_BAR;
            PG8_LDB(B0, 1, 0); PG8_SCHED; PG8_LDA(At, 1, 0); PG8_STAGE(PG8_SA(0, 1), a2 + hstep, voffA);
            PG8_WAIT_L(8); PG8_BAR; PG8_WAIT_L(0); PG8_MMA(0, 0, At, B0); PG8_BAR; PG8_SCHED;
            PG8_LDB(B1, 1, 1); PG8_STAGE(PG8_SB(1, 0), b3, voffB);
            PG8_BAR; PG8_WAIT_L(0); PG8_MMA(0, 1, At, B1); PG8_BAR;
            PG8_LDA(At, 1, 1); PG8_STAGE(PG8_SA(1, 0), a3, voffA);
            PG8_BAR; PG8_WAIT_L(0); PG8_MMA(1, 0, At, B0); PG8_BAR; PG8_SCHED;
            PG8_STAGE(PG8_SB(1, 1), b3 + hstep, voffB);
            PG8_WAIT_V(6); PG8_BAR; PG8_MMA(1, 1, At, B1); PG8_BAR;
        }
        E(acc, cur, wr, wc, fr, fq);
        if (!has_next) break;
        if (!(Epi::SPLIT2 && cur.seg == 0))
#pragma unroll
        for (int a = 0; a < 2; ++a)
#pragma unroll
            for (int b = 0; b < 2; ++b)
#pragma unroll
                for (int m = 0; m < 4; ++m)
#pragma unroll
                    for (int n = 0; n < 2; ++n) acc[a][b][m][n] = (f32x4){0.f, 0.f, 0.f, 0.f};
        cur = nxt; cA = nA; cB = nB; ++ui;
    }
    PG8_WAIT_V(0);
    if (wr == 0) PG8_BAR;
    PG8_BAR;
#undef PG8_SA
#undef PG8_SB
#undef PG8_STAGE
#undef PG8_LDA
#undef PG8_LDB
#undef PG8_MMA
#undef PG8_WAIT_V
#undef PG8_WAIT_L
#undef PG8_BAR
#undef PG8_SCHED
}
}

struct EpiZ {
    static constexpr bool PERM = true, SPLIT2 = false;
    bf16_t* Z;
    __device__ __forceinline__ void operator()(f32x4 (&acc)[2][2][4][2], const pg8::Unit& u, int wr, int wc, int fr, int fq) const {
        const int row0 = u.pm * 256 + wr * 64 + fr, col0 = u.pn * 256 + wc * 32 + 8 * fq;
#pragma unroll
        for (int ai = 0; ai < 2; ++ai)
#pragma unroll
            for (int m = 0; m < 4; ++m) { bf16_t* rowp = Z + (size_t)(row0 + ai * 128 + m * 16) * NP + col0;
#pragma unroll
                for (int bj = 0; bj < 2; ++bj) { const f32x4 v0 = acc[ai][bj][m][0], v1 = acc[ai][bj][m][1];
                    u32x4 o; o[0] = pk_bf16(v0[0], v0[1]); o[1] = pk_bf16(v0[2], v0[3]); o[2] = pk_bf16(v1[0], v1[1]); o[3] = pk_bf16(v1[2], v1[3]);
                    *(u32x4*)(rowp + bj * 128) = o; } }
    }
};
struct EpiMerge {
    static constexpr bool PERM = true, SPLIT2 = true;
    const bf16_t* Z; bf16_t* Mo;
    __device__ __forceinline__ void mid(f32x4 (&acc)[2][2][4][2], const pg8::Unit& u, int wr, int wc, int fr, int fq) const {
        const int row0 = u.pm * 256 + wr * 64 + fr, col0 = u.pn * 256 + wc * 32 + 8 * fq;
#pragma unroll
        for (int ai = 0; ai < 2; ++ai)
#pragma unroll
            for (int m = 0; m < 4; ++m) { const bf16_t* zr = Z + (size_t)(row0 + ai * 128 + m * 16) * NP + col0;
#pragma unroll
                for (int bj = 0; bj < 2; ++bj) { const u32x4 ga = *(const u32x4*)(zr + C_GA + bj * 128), gb = *(const u32x4*)(zr + C_GB + bj * 128);
#pragma unroll
                    for (int q = 0; q < 4; ++q) { const float a0 = bflo(ga[q]), a1 = bfhi(ga[q]), b0 = bflo(gb[q]), b1 = bfhi(gb[q]);
                        const float r0 = (1.f + __expf(-b0)) * __builtin_amdgcn_rcpf(1.f + __expf(-a0)), r1 = (1.f + __expf(-b1)) * __builtin_amdgcn_rcpf(1.f + __expf(-a1));
                        acc[ai][bj][m][q >> 1][(q & 1) * 2] *= r0; acc[ai][bj][m][q >> 1][(q & 1) * 2 + 1] *= r1; } } }
    }
    __device__ __forceinline__ void fin(f32x4 (&acc)[2][2][4][2], const pg8::Unit& u, int wr, int wc, int fr, int fq) const {
        const int row0 = u.pm * 256 + wr * 64 + fr, col0 = u.pn * 256 + wc * 32 + 8 * fq;
#pragma unroll
        for (int ai = 0; ai < 2; ++ai)
#pragma unroll
            for (int m = 0; m < 4; ++m) { const size_t r = (size_t)(row0 + ai * 128 + m * 16); const bf16_t* zr = Z + r * NP + col0; bf16_t* mo = Mo + r * DM + col0;
#pragma unroll
                for (int bj = 0; bj < 2; ++bj) { const u32x4 gb = *(const u32x4*)(zr + C_GB + bj * 128); u32x4 o;
#pragma unroll
                    for (int q = 0; q < 4; ++q) { const float s0 = sigmoidf_(bflo(gb[q])), s1 = sigmoidf_(bfhi(gb[q]));
                        o[q] = pk_bf16(acc[ai][bj][m][q >> 1][(q & 1) * 2] * s0, acc[ai][bj][m][q >> 1][(q & 1) * 2 + 1] * s1); }
                    *(u32x4*)(mo + bj * 128) = o; } }
    }
    __device__ __forceinline__ void operator()(f32x4 (&acc)[2][2][4][2], const pg8::Unit& u, int wr, int wc, int fr, int fq) const {
        if (u.seg == 0) mid(acc, u, wr, wc, fr, fq); else fin(acc, u, wr, wc, fr, fq);
    }
};
struct EpiOut {
    static constexpr bool PERM = false, SPLIT2 = false;
    const float* hp; const float* hs; float* Ho;
    __device__ __forceinline__ void operator()(f32x4 (&acc)[2][2][4][2], const pg8::Unit& u, int wr, int wc, int fr, int fq) const {
        const int row0 = u.pm * 256 + wr * 64 + fr, col0 = u.pn * 256 + wc * 32 + 4 * fq;
        const float* src = (u.pm < 32) ? hp + (size_t)row0 * DM : hs + (size_t)(row0 - MP) * DM;
#pragma unroll
        for (int ai = 0; ai < 2; ++ai)
#pragma unroll
            for (int m = 0; m < 4; ++m) { const size_t ro = (size_t)(ai * 128 + m * 16) * DM + col0; float* dst = Ho + (size_t)row0 * DM + ro;
#pragma unroll
                for (int bj = 0; bj < 2; ++bj)
#pragma unroll
                    for (int n = 0; n < 2; ++n) { const f32x4 o = *(const f32x4*)(src + ro + bj * 128 + n * 16) + acc[ai][bj][m][n]; *(f32x4*)(dst + bj * 128 + n * 16) = o; } }
    }
};

__device__ __forceinline__ void conv_unit(const float* __restrict__ W, int K, int N, int Npad, bf16_t* __restrict__ Wt, int ldt, int unit, int lane) {
    const int nnb = Npad >> 6; const int kb = unit / nnb, nb = unit - kb * nnb;
    const int n = nb * 64 + lane, k0 = kb * 64;
    bf16_t* dst = Wt + (size_t)n * ldt + k0;
    if (n < N) {
        const float* src = W + (size_t)k0 * N + n;
        float v[64];
#pragma unroll
        for (int j = 0; j < 64; ++j) v[j] = src[(size_t)j * N];
#pragma unroll
        for (int kk = 0; kk < 64; kk += 8) { u32x4 o; o[0] = pk_bf16(v[kk], v[kk + 1]); o[1] = pk_bf16(v[kk + 2], v[kk + 3]); o[2] = pk_bf16(v[kk + 4], v[kk + 5]); o[3] = pk_bf16(v[kk + 6], v[kk + 7]);
            *(u32x4*)(dst + kk) = o; }
    } else {
#pragma unroll
        for (int kk = 0; kk < 64; kk += 8) *(u32x4*)(dst + kk) = (u32x4){0u, 0u, 0u, 0u};
    }
}
__device__ void phase_convert(const Params& p, int l, int gw, int nw) {
    const int lane = otid() & 63;
    constexpr int U_IN = (NP / 64) * 32, U_P = 32 * 16, U_O = 32 * 32, U_L = U_IN + 2 * U_P + U_O;
    for (int u = gw; u < U_L; u += nw) {
        int r = u;
        if (r < U_IN) conv_unit(P_W_IN + (size_t)l * DM * NIN, DM, NIN, NP, P_WINT + (size_t)l * NP * DM, DM, r, lane);
        else if ((r -= U_IN) < U_P) conv_unit(P_W_PROJ_A + (size_t)l * 1024 * DM, 1024, DM, DM, P_PABT + (size_t)l * DM * DM, DM, r, lane);
        else if ((r -= U_P) < U_P) conv_unit(P_W_PROJ_B + (size_t)l * 1024 * DM, 1024, DM, DM, P_PABT + (size_t)l * DM * DM + 1024, DM, r, lane);
        else { r -= U_P; conv_unit(P_W_OUT + (size_t)l * DM * DM, DM, DM, DM, P_WOT + (size_t)l * DM * DM, DM, r, lane); }
    }
}

__device__ void phase_rmsnorm(const float* hp, const float* hs, const float* g, bf16_t* obf, float* of32) {
    const int lane = otid() & 63, gw = blockIdx.x * 8 + (otid() >> 6), nw = gridDim.x * 8;
    for (int row = gw; row < MT; row += nw) {
        const f32x4* x = (const f32x4*)(row < MP ? hp + (size_t)row * DM : hs + (size_t)(row - MP) * DM);
        f32x4 v[8]; float ss = 0.f;
#pragma unroll
        for (int i = 0; i < 8; ++i) { v[i] = x[lane + 64 * i]; ss += v[i][0] * v[i][0] + v[i][1] * v[i][1] + v[i][2] * v[i][2] + v[i][3] * v[i][3]; }
        ss = red64(ss);
        const float rstd = rsqrtf(ss * (1.f / DM) + 1e-6f);
#pragma unroll
        for (int i = 0; i < 8; ++i) { const f32x4 gg = ((const f32x4*)g)[lane + 64 * i]; const f32x4 o = v[i] * rstd * gg;
            if (obf) { u32x2 w; w[0] = pk_bf16(o[0], o[1]); w[1] = pk_bf16(o[2], o[3]); *(u32x2*)(obf + (size_t)row * DM + (lane + 64 * i) * 4) = w; }
            else *(f32x4*)(of32 + (size_t)row * DM + (lane + 64 * i) * 4) = o; }
    }
}

__device__ void phase_prep(const Params& p, int l) {
    LAS float* sm = (LAS float*)smem_raw;
    LAS bf16_t* twb = (LAS bf16_t*)sm;
    LAS bf16_t* adb = twb + 16 * 72;
    LAS float* red = sm + 1152;
    LAS float* lwla = sm + 2048;
    const int tid = otid(), lane = tid & 63, wv = tid >> 6;
    const int c = tid * 2;
    const float* mu = P_SHIFT_MU + l * DSH;
    for (int i = tid; i < 2 * 8 * 72 / 2; i += 512) { const int m_ = i / 288, r_ = i % 288; ((LAS unsigned*)(twb + m_ * 16 * 72 + 8 * 72))[r_] = 0u; }
    for (int item = blockIdx.x; item < MT / 8; item += gridDim.x) {
        const int row0 = item * 8;
        const bool samp = row0 >= MP;
        const int sb = (row0 - MP) >> 3, pb = row0 >> 11, t0 = row0 & 2047;
        const bf16_t* zr = P_Z + (size_t)row0 * NP;
        const float* sprev = P_STATE_SHIFT + (size_t)(l * 128 + (samp ? sb : 0)) * DSH;
        const bool zprev = (!samp) && (t0 == 0);
        {
            const int j = tid & 127, col = C_WD + j, tp = tid >> 7;
            const float m_ = mu[col];
#pragma unroll
            for (int tt = 0; tt < 2; ++tt) { const int t = tp * 2 + tt;
                const float cur = bf2f(zr[(size_t)t * NP + col]);
                float prv;
                if (t == 0) prv = samp ? sprev[col] : (zprev ? 0.f : bf2f(*(zr + col - NP))); else prv = bf2f(zr[(size_t)(t - 1) * NP + col]);
                const float mix = cur + (prv - cur) * m_;
                if (j < 64) twb[t * 72 + j] = (bf16_t)(pk_bf16(tanhf_(mix), 0.f) & 0xffffu); else adb[t * 72 + j - 64] = (bf16_t)(pk_bf16(mix, 0.f) & 0xffffu); }
        }
        unsigned vgw[8];
#pragma unroll
        for (int t = 0; t < 8; ++t) vgw[t] = *(const unsigned*)(zr + (size_t)t * NP + C_VG + c);
        float rm[8][2], km[8][2], vm[8][2];
#pragma unroll
        for (int sec = 0; sec < 3; ++sec) { const int col = sec * 1024 + c;
            float p0, p1;
            if (samp) { const f32x2 s2 = *(const f32x2*)(sprev + col); p0 = s2[0]; p1 = s2[1]; }
            else if (zprev) { p0 = 0.f; p1 = 0.f; }
            else { const unsigned w = *(const unsigned*)(zr + col - NP); p0 = bflo(w); p1 = bfhi(w); }
            const f32x2 m2 = *(const f32x2*)(mu + col);
#pragma unroll
            for (int t = 0; t < 8; ++t) { const unsigned w = *(const unsigned*)(zr + (size_t)t * NP + col); const float c0 = bflo(w), c1 = bfhi(w);
                const float x0 = c0 + (p0 - c0) * m2[0], x1 = c1 + (p1 - c1) * m2[1];
                if (sec == 0) { rm[t][0] = x0; rm[t][1] = x1; } else if (sec == 1) { km[t][0] = x0; km[t][1] = x1; } else { vm[t][0] = x0; vm[t][1] = x1; }
                p0 = c0; p1 = c1; } }
        __syncthreads();
        {
            const int fr = lane & 15, fq = lane >> 4;
            bf16x8 aw[2], aa[2];
#pragma unroll
            for (int ks = 0; ks < 2; ++ks) { aw[ks] = *(const LAS bf16x8*)(twb + fr * 72 + ks * 32 + fq * 8); aa[ks] = *(const LAS bf16x8*)(adb + fr * 72 + ks * 32 + fq * 8); }
            const bf16_t* w2t = P_W2T + ((size_t)l * 1024 + wv * 128 + fr) * 64 + fq * 8;
            const bf16_t* a2t = P_A2T + ((size_t)l * 1024 + wv * 128 + fr) * 64 + fq * 8;
#pragma unroll
            for (int nt = 0; nt < 8; ++nt) {
                f32x4 dw = (f32x4){0.f, 0.f, 0.f, 0.f}, da = (f32x4){0.f, 0.f, 0.f, 0.f};
#pragma unroll
                for (int ks = 0; ks < 2; ++ks) { const bf16x8 bw = *(const bf16x8*)(w2t + nt * 16 * 64 + ks * 32), ba = *(const bf16x8*)(a2t + nt * 16 * 64 + ks * 32);
                    dw = __builtin_amdgcn_mfma_f32_16x16x32_bf16(aw[ks], bw, dw, 0, 0, 0); da = __builtin_amdgcn_mfma_f32_16x16x32_bf16(aa[ks], ba, da, 0, 0, 0); }
                if (fq < 2) { const int ch = wv * 128 + nt * 16 + fr;
#pragma unroll
                    for (int r = 0; r < 4; ++r) *(LAS f32x2*)(lwla + ((fq * 4 + r) * 1024 + ch) * 2) = (f32x2){dw[r], da[r]}; }
            }
        }
        __syncthreads();
        float lw[8][2], la[8][2];
        { const f32x2 w0v = *(const f32x2*)(P_W0 + l * 1024 + c), a0v = *(const f32x2*)(P_A0 + l * 1024 + c);
#pragma unroll
          for (int t = 0; t < 8; ++t) { const f32x4 v = *(const LAS f32x4*)(lwla + (t * 1024 + c) * 2);
              lw[t][0] = w0v[0] + v[0]; la[t][0] = a0v[0] + v[1]; lw[t][1] = w0v[1] + v[2]; la[t][1] = a0v[1] + v[3]; } }
        {
            const f32x2 kkv = *(const f32x2*)(P_K_K + l * 1024 + c), kav = *(const f32x2*)(P_K_A + l * 1024 + c);
            const int hh = c >> 6, cc = c & 63;
#pragma unroll
            for (int t = 0; t < 8; ++t) {
                float dec[2], ag[2], kk[2], kp[2];
#pragma unroll
                for (int e = 0; e < 2; ++e) { const float y = -lw[t][e]; const float sp = fmaxf(y, 0.f) + __logf(1.f + __expf(-fabsf(y)));
                    const float wl = -sp - 0.5f; dec[e] = __expf(-__expf(wl)); ag[e] = sigmoidf_(la[t][e]); kk[e] = km[t][e] * kkv[e]; kp[e] = km[t][e] * (1.f + (ag[e] - 1.f) * kav[e]); }
                const float ss = red32(kk[0] * kk[0] + kk[1] * kk[1]);
                const float inv = __builtin_amdgcn_rsqf(fmaxf(ss, 1e-24f));
                float* rc = P_REC + ((size_t)(row0 + t) * 16 + hh) * 384 + cc;
                *(f32x2*)(rc) = (f32x2){rm[t][0], rm[t][1]};
                *(f32x2*)(rc + 64) = (f32x2){dec[0], dec[1]};
                *(f32x2*)(rc + 128) = (f32x2){kp[0], kp[1]};
                *(f32x2*)(rc + 192) = (f32x2){vm[t][0], vm[t][1]};
                *(f32x2*)(rc + 256) = (f32x2){-kk[0] * inv, -kk[1] * inv};
                *(f32x2*)(rc + 320) = (f32x2){kk[0] * inv * ag[0], kk[1] * inv * ag[1]};
            }
        }
        {
            float x[8][2];
#pragma unroll
            for (int t = 0; t < 8; ++t) { x[t][0] = bflo(vgw[t]); x[t][1] = bfhi(vgw[t]); }
#pragma unroll
            for (int t = 0; t < 8; ++t) { const float s1 = red64(x[t][0] + x[t][1]), s2 = red64(x[t][0] * x[t][0] + x[t][1] * x[t][1]);
                if (lane == 0) { red[wv * 16 + t] = s1; red[wv * 16 + 8 + t] = s2; } }
            __syncthreads();
            const f32x2 gv = *(const f32x2*)(P_SGU_LN_G + l * 1024 + c), bv = *(const f32x2*)(P_SGU_LN_B + l * 1024 + c);
            float vn[8][2];
#pragma unroll
            for (int t = 0; t < 8; ++t) { float s1 = 0.f, s2 = 0.f;
#pragma unroll
                for (int w = 0; w < 8; ++w) { s1 += red[w * 16 + t]; s2 += red[w * 16 + 8 + t]; }
                const float mean = s1 * (1.f / 1024.f), var = fmaxf(s2 * (1.f / 1024.f) - mean * mean, 0.f), rstd = rsqrtf(var + 1e-5f);
                vn[t][0] = (x[t][0] - mean) * rstd * gv[0] + bv[0]; vn[t][1] = (x[t][1] - mean) * rstd * gv[1] + bv[1]; }
#pragma unroll
            for (int e = 0; e < 2; ++e) { u32x4 o; o[0] = pk_bf16(vn[0][e], vn[1][e]); o[1] = pk_bf16(vn[2][e], vn[3][e]); o[2] = pk_bf16(vn[4][e], vn[5][e]); o[3] = pk_bf16(vn[6][e], vn[7][e]);
                if (samp) *(u32x4*)(P_VNTS + ((size_t)sb * 1024 + c + e) * 8) = o;
                else *(u32x4*)(P_VNT + ((size_t)(pb * 16 + (t0 >> 7)) * 1024 + c + e) * 128 + (t0 & 127)) = o; }
            if (samp) {
#pragma unroll
                for (int t = 0; t < 8; ++t) *(f32x2*)(p.out + O_CV + ((size_t)(l * 128 + sb) * 8 + t) * 1024 + c) = (f32x2){vn[t][0], vn[t][1]};
            }
        }
        if (samp) { for (int col = tid; col < DSH; col += 512) p.out[O_SHS + (size_t)(l * 128 + sb) * DSH + col] = bf2f(zr[(size_t)7 * NP + col]); }
        else if (t0 == 2040) { for (int col = tid; col < DSH; col += 512) p.out[O_SHP + (size_t)(l * 4 + pb) * DSH + col] = bf2f(zr[(size_t)7 * NP + col]); }
        __syncthreads();
    }
}

#define WAVE_SYNC() do { asm volatile("s_waitcnt lgkmcnt(0)" ::: "memory"); __builtin_amdgcn_wave_barrier(); } while (0)
__device__ __forceinline__ float dot4(const f32x4 a, const f32x4 b) { return a[0] * b[0] + a[1] * b[1] + a[2] * b[2] + a[3] * b[3]; }

__device__ void scan_prompt_unit(const Params& p, int l, int unit, int wv, int lane, LAS float* lw) {
    const int bh = unit >> 2, b = bh >> 4, h = bh & 15;
    const int rg = lane >> 4, kq = lane & 15;
    const int v0 = (unit & 3) * 16 + wv * 4 + rg;
    const float* recb = P_REC + ((size_t)(b * 2048) * 16 + h) * 384;
    float* yb = P_YBUF + (size_t)(b * 2048) * 1024 + h * 64 + v0;
    constexpr size_t TS = 16 * 384;
    LAS float* lv = lw + 16 * 5 * 64;
    LAS float* ly = lv + 64;
    f32x4 s = (f32x4){0.f, 0.f, 0.f, 0.f};
    f32x4 nxA[4][5], nxB[4][5]; float nvA, nvB;
#define SCAN_LOAD_BATCH(nx, nv, tb_) do { \
        _Pragma("unroll") for (int j = 0; j < 4; ++j) { const float* rp = recb + (size_t)((tb_) + rg + 4 * j) * TS + kq * 4; \
            nx[j][0] = *(const f32x4*)(rp); nx[j][1] = *(const f32x4*)(rp + 64); nx[j][2] = *(const f32x4*)(rp + 128); nx[j][3] = *(const f32x4*)(rp + 256); nx[j][4] = *(const f32x4*)(rp + 320); } \
        nv = recb[(size_t)((tb_) + kq) * TS + 192 + v0]; } while (0)
#define SCAN_BATCH(nx, nv, tb_) do { \
        WAVE_SYNC(); \
        _Pragma("unroll") for (int j = 0; j < 4; ++j) \
            _Pragma("unroll") for (int i = 0; i < 5; ++i) *(LAS f32x4*)(lw + ((rg + 4 * j) * 5 + i) * 64 + kq * 4) = nx[j][i]; \
        lv[kq * 4 + rg] = nv; \
        WAVE_SYNC(); \
        if ((tb_) + 32 < 2048) SCAN_LOAD_BATCH(nx, nv, (tb_) + 32); \
        f32x4 a4 = *(const LAS f32x4*)(lw + 3 * 64 + kq * 4); \
        float pa = dot4(s, a4), py = 0.f; \
        _Pragma("unroll") for (int q = 0; q < 16; ++q) { \
            const LAS float* lc = lw + q * 5 * 64 + kq * 4; \
            const f32x4 w4 = *(const LAS f32x4*)(lc + 64), k4 = *(const LAS f32x4*)(lc + 128), b4 = *(const LAS f32x4*)(lc + 256), r4 = *(const LAS f32x4*)(lc); \
            const float vv = lv[q * 4 + rg]; \
            f32x4 a4n = a4; \
            if (q < 15) a4n = *(const LAS f32x4*)(lc + 5 * 64 + 192); \
            if (q > 0) { red16x2(pa, py); ly[(q - 1) * 4 + rg] = py; } else pa = red16(pa); \
            s = s * w4 + vv * k4 + pa * b4; \
            py = dot4(s, r4); \
            if (q < 15) pa = dot4(s, a4n); \
            a4 = a4n; } \
        py = red16(py); ly[15 * 4 + rg] = py; \
        asm volatile("s_waitcnt lgkmcnt(0)" ::: "memory"); \
        yb[(size_t)((tb_) + kq) * 1024] = ly[kq * 4 + rg]; } while (0)
    SCAN_LOAD_BATCH(nxA, nvA, 0);
    SCAN_LOAD_BATCH(nxB, nvB, 16);
    for (int tb = 0; tb < 2048; tb += 32) {
        SCAN_BATCH(nxA, nvA, tb);
        SCAN_BATCH(nxB, nvB, tb + 16);
    }
#undef SCAN_BATCH
#undef SCAN_LOAD_BATCH
    *(f32x4*)(p.out + O_WKVP + ((size_t)((l * 4 + b) * 16 + h) * 64 + v0) * 64 + kq * 4) = s;
}

__device__ void scan_sample_item(const Params& p, int l, int item, int lane, LAS float* lw) {
    const int b = item >> 4, h = item & 15;
    const int rg = lane >> 4, kq = lane & 15;
    const size_t sbase = (size_t)((l * 128 + b) * 16 + h) * 4096;
    const float* S0 = P_STATE_WKV + sbase;
    f32x4 s[16];
#pragma unroll
    for (int i = 0; i < 16; ++i) s[i] = *(const f32x4*)(S0 + (rg * 16 + i) * 64 + kq * 4);
    const float* recb = P_REC + ((size_t)(MP + b * 8) * 16 + h) * 384;
    float nx[6];
#pragma unroll
    for (int j = 0; j < 6; ++j) nx[j] = recb[j * 64 + lane];
    for (int t = 0; t < 8; ++t) {
        WAVE_SYNC();
#pragma unroll
        for (int j = 0; j < 6; ++j) lw[j * 64 + lane] = nx[j];
        WAVE_SYNC();
        if (t < 7) {
#pragma unroll
            for (int j = 0; j < 6; ++j) nx[j] = recb[(size_t)(t + 1) * 16 * 384 + j * 64 + lane];
        }
        const f32x4 r4 = *(const LAS f32x4*)(lw + 0 * 64 + kq * 4), w4 = *(const LAS f32x4*)(lw + 1 * 64 + kq * 4), k4 = *(const LAS f32x4*)(lw + 2 * 64 + kq * 4),
                    a4 = *(const LAS f32x4*)(lw + 4 * 64 + kq * 4), b4 = *(const LAS f32x4*)(lw + 5 * 64 + kq * 4);
        float ysel = 0.f;
#pragma unroll
        for (int i4 = 0; i4 < 4; ++i4) {
            const f32x4 vv = *(const LAS f32x4*)(lw + 3 * 64 + rg * 16 + i4 * 4);
#pragma unroll
            for (int ii = 0; ii < 4; ++ii) { const int i = i4 * 4 + ii;
                const float sa = red16(dot4(s[i], a4));
                s[i] = s[i] * w4 + vv[ii] * k4 + sa * b4;
                const float y = red16(dot4(s[i], r4));
                ysel = (kq == i) ? y : ysel; }
        }
        P_YBUF[(size_t)(MP + b * 8 + t) * 1024 + h * 64 + rg * 16 + kq] = ysel;
    }
    float* So = p.out + O_WKVS + sbase;
#pragma unroll
    for (int i = 0; i < 16; ++i) *(f32x4*)(So + (rg * 16 + i) * 64 + kq * 4) = s[i];
}

__device__ void sgu_prompt_item(const Params& p, int l, int item, int lane) {
    const int slab = item & 7, g = (item >> 3) & 7, bc = item >> 6;
    const int fr = lane & 15, fq = lane >> 4;
    const bf16_t* vb = P_VNT + ((size_t)(bc * 1024 + g * 128 + slab * 16 + fr)) * 128 + fq * 8;
    bf16x8 vf[4];
#pragma unroll
    for (int ks = 0; ks < 4; ++ks) vf[ks] = *(const bf16x8*)(vb + ks * 32);
    const float* Wg = P_SGU_W + (size_t)(l * 8 + g) * 16384;
    const float* bg = P_SGU_B + (size_t)(l * 8 + g) * 128;
    const int ch = g * 128 + slab * 16 + fq * 4;
#pragma unroll
    for (int tt = 0; tt < 8; ++tt) {
        f32x4 acc = (f32x4){0.f, 0.f, 0.f, 0.f};
        const int t = tt * 16 + fr;
#pragma unroll
        for (int ks = 0; ks <= tt / 2; ++ks) {
            const int s0 = ks * 32 + fq * 8;
            const f32x4 wa = *(const f32x4*)(Wg + t * 128 + s0), wb = *(const f32x4*)(Wg + t * 128 + s0 + 4);
            float wv[8] = {wa[0], wa[1], wa[2], wa[3], wb[0], wb[1], wb[2], wb[3]};
#pragma unroll
            for (int j = 0; j < 8; ++j) wv[j] = (s0 + j <= t) ? wv[j] : 0.f;
            u32x4 pk; pk[0] = pk_bf16(wv[0], wv[1]); pk[1] = pk_bf16(wv[2], wv[3]); pk[2] = pk_bf16(wv[4], wv[5]); pk[3] = pk_bf16(wv[6], wv[7]);
            bf16x8 wf; __builtin_memcpy(&wf, &pk, 16);
            acc = __builtin_amdgcn_mfma_f32_16x16x32_bf16(vf[ks], wf, acc, 0, 0, 0);
        }
        const size_t row = (size_t)bc * 128 + t;
        const float sbv = bg[t];
        const u32x2 uu = *(const u32x2*)(P_Z + row * NP + C_U + ch), gg = *(const u32x2*)(P_Z + row * NP + C_GG + ch);
        const float o0 = bflo(uu[0]) * (acc[0] + sbv) * siluf_(bflo(gg[0])), o1 = bfhi(uu[0]) * (acc[1] + sbv) * siluf_(bfhi(gg[0]));
        const float o2 = bflo(uu[1]) * (acc[2] + sbv) * siluf_(bflo(gg[1])), o3 = bfhi(uu[1]) * (acc[3] + sbv) * siluf_(bfhi(gg[1]));
        u32x2 o; o[0] = pk_bf16(o0, o1); o[1] = pk_bf16(o2, o3);
        *(u32x2*)(P_YAB + row * DM + 1024 + ch) = o;
    }
}

__device__ void sgu_sample_item(const Params& p, int l, int item, int lane) {
    const int b = item >> 4, ch = (item & 15) * 64 + lane, g = ch >> 7;
    const u32x4 vv = *(const u32x4*)(P_VNTS + ((size_t)b * 1024 + ch) * 8);
    float vn[8] = {bflo(vv[0]), bfhi(vv[0]), bflo(vv[1]), bfhi(vv[1]), bflo(vv[2]), bfhi(vv[2]), bflo(vv[3]), bfhi(vv[3])};
    const float* Wg = P_SGU_W + (size_t)(l * 8 + g) * 16384;
    const float* bg = P_SGU_B + (size_t)(l * 8 + g) * 128;
#pragma unroll
    for (int t = 0; t < 8; ++t) {
        float sacc = bg[t];
#pragma unroll
        for (int s = 0; s <= t; ++s) sacc += Wg[t * 128 + s] * vn[s];
        const size_t row = (size_t)MP + b * 8 + t;
        const float u = bf2f(P_Z[row * NP + C_U + ch]), gg = bf2f(P_Z[row * NP + C_GG + ch]);
        const float o = u * sacc * siluf_(gg);
        P_YAB[row * DM + 1024 + ch] = (bf16_t)(pk_bf16(o, 0.f) & 0xffffu);
    }
}

__device__ void phase_scan(const Params& p, int l) {
    const int tid = otid(), lane = tid & 63, wv = __builtin_amdgcn_readfirstlane(tid >> 6);
    LAS float* lw = (wv < 4) ? (LAS float*)smem_raw + wv * 6144 : (LAS float*)smem_raw + 24576 + (wv - 4) * 2048;
#ifndef REP_PR
#define REP_PR 1
#endif
#ifndef REP_IT
#define REP_IT 1
#endif
    if (wv < 4) {
      for (int rr = 0; rr < REP_PR; ++rr)
        for (int u0 = blockIdx.x; u0 < 256; u0 += gridDim.x) { const int unit = (gridDim.x == 256) ? ((u0 & 7) * 32 + (u0 >> 3)) : u0; scan_prompt_unit(p, l, unit, wv, lane, lw); }
    } else {
        const int nw = gridDim.x * 4;
      for (int rr = 0; rr < REP_IT; ++rr)
        for (int it = blockIdx.x * 4 + (wv - 4); it < 2048 + 4096 + 2048; it += nw) {
            if (it < 2048) scan_sample_item(p, l, it, lane, lw);
            else if (it < 6144) sgu_prompt_item(p, l, it - 2048, lane);
            else sgu_sample_item(p, l, it - 6144, lane);
        }
        if (l + 1 < DEPTH) phase_convert(p, l + 1, blockIdx.x * 4 + (wv - 4), nw);
    }
}

__device__ void phase_post(const Params& p, int l) {
    const int lane = otid() & 63, gw = blockIdx.x * 8 + (otid() >> 6), nw = gridDim.x * 8;
    const int hg = lane >> 4, kq = lane & 15;
    for (int it = gw; it < MT * 4; it += nw) {
        const int row = it >> 2, h = (it & 3) * 4 + hg, ch = h * 64 + kq * 4;
        const f32x4 y = *(const f32x4*)(P_YBUF + (size_t)row * 1024 + ch);
        const float* rc = P_REC + ((size_t)row * 16 + h) * 384 + kq * 4;
        const f32x4 r4 = *(const f32x4*)(rc), k4 = *(const f32x4*)(rc + 128), v4 = *(const f32x4*)(rc + 192);
        const f32x4 rk = *(const f32x4*)(P_R_K + (size_t)l * 1024 + ch);
        const float mean = red16(y[0] + y[1] + y[2] + y[3]) * (1.f / 64.f);
        const f32x4 d = y - mean;
        const float var = red16(dot4(d, d)) * (1.f / 64.f);
        const float rs = rsqrtf(var + 64e-5f);
        const float srk = red16(r4[0] * k4[0] * rk[0] + r4[1] * k4[1] * rk[1] + r4[2] * k4[2] * rk[2] + r4[3] * k4[3] * rk[3]);
        const f32x4 lg = *(const f32x4*)(P_LNX_G + (size_t)l * 1024 + ch), lb = *(const f32x4*)(P_LNX_B + (size_t)l * 1024 + ch);
        const u32x2 gr = *(const u32x2*)(P_Z + (size_t)row * NP + C_GR + ch);
        const f32x4 yo = d * rs * lg + lb + srk * v4;
        u32x2 o; o[0] = pk_bf16(yo[0] * siluf_(bflo(gr[0])), yo[1] * siluf_(bfhi(gr[0]))); o[1] = pk_bf16(yo[2] * siluf_(bflo(gr[1])), yo[3] * siluf_(bfhi(gr[1])));
        *(u32x2*)(P_YAB + (size_t)row * DM + ch) = o;
    }
}


#define XB_TMO      128
#define XB_XCNT(j)  (256  + 64 * (j))
#define XB_XSUB(j)  (1280 + 64 * (j))
#define XB_XGEN(j)  (2304 + 64 * (j))
#define XB_TOP      3328
#define XB_TOPGEN   3392
#define XCD_BAR_WORDS 3456
#define XB_SPIN_CAP (1u << 20)
__device__ __forceinline__ unsigned xb_ld(unsigned* p)              { return __hip_atomic_load(p, __ATOMIC_RELAXED, __HIP_MEMORY_SCOPE_AGENT); }
__device__ __forceinline__ unsigned xb_add(unsigned* p, unsigned v) { return __hip_atomic_fetch_add(p, v, __ATOMIC_RELAXED, __HIP_MEMORY_SCOPE_AGENT); }
__device__ __forceinline__ unsigned xb_xcc_id() { return (unsigned)__builtin_amdgcn_s_getreg((3 << 11) | 20) & 0xFu; }
#define XB_SPIN(cond, bar) do { unsigned _sp = 0; while (cond) { __builtin_amdgcn_s_sleep(1); \
    if ((++_sp & 255u) == 0u) { if (xb_ld(&(bar)[XB_TMO])) break; if (_sp > XB_SPIN_CAP) { atomicAdd(&(bar)[XB_TMO], 1u); break; } } } } while (0)
struct XcdBarrier { unsigned* bar; unsigned x; volatile LAS unsigned* st; };
__device__ __forceinline__ XcdBarrier xcd_barrier_post(unsigned* bar, volatile LAS unsigned* st) {
    XcdBarrier b; b.bar = bar; b.x = xb_xcc_id(); b.st = st;
    if (threadIdx.x == 0) (void)xb_add(&bar[XB_XCNT(b.x)], 1u);
    return b;
}
__device__ __forceinline__ void xcd_barrier_complete(unsigned* bar, unsigned x, unsigned& nloc, unsigned& nx) {
    const unsigned G = gridDim.x * gridDim.y * gridDim.z;
    unsigned sum, cnt, mine, sp = 0u;
    for (;;) {
        sum = 0u; cnt = 0u; mine = 0u;
#pragma unroll
        for (unsigned j = 0; j < 16; ++j) { const unsigned c = xb_ld(&bar[XB_XCNT(j)]); sum += c; cnt += (c > 0u) ? 1u : 0u; mine = (j == x) ? c : mine; }
        if (sum == G) break;
        __builtin_amdgcn_s_sleep(1);
        if ((++sp & 255u) == 0u) { if (xb_ld(&bar[XB_TMO])) break; if (sp > XB_SPIN_CAP) { atomicAdd(&bar[XB_TMO], 1u); break; } }
    }
    nloc = mine > 0u ? mine : 1u; nx = cnt > 0u ? cnt : 1u;
}
__device__ __forceinline__ void xcd_barrier(const XcdBarrier& b) {
    asm volatile("s_waitcnt vmcnt(0)" ::: "memory");
    __syncthreads();
    if (threadIdx.x == 0) {
        unsigned* bar = b.bar;
        __builtin_amdgcn_s_waitcnt(0);
        unsigned nloc = b.st[0], nx = b.st[1];
        if (nloc == 0u) { xcd_barrier_complete(bar, b.x, nloc, nx); b.st[0] = nloc; b.st[1] = nx; }
        const unsigned old = xb_add(&bar[XB_XSUB(b.x)], 1u);
        const unsigned gen = old / nloc;
        if (old + 1u == (gen + 1u) * nloc) {
            __builtin_amdgcn_fence(__ATOMIC_RELEASE, "agent");
            asm volatile("s_waitcnt vmcnt(0)" ::: "memory");
            const unsigned og = xb_add(&bar[XB_TOP], 1u);
            const unsigned tg = og / nx;
            if (og + 1u == (tg + 1u) * nx) xb_add(&bar[XB_TOPGEN], 1u);
            else XB_SPIN(xb_ld(&bar[XB_TOPGEN]) == tg, bar);
            __builtin_amdgcn_fence(__ATOMIC_ACQUIRE, "agent");
            xb_add(&bar[XB_XGEN(b.x)], 1u);
            asm volatile("s_waitcnt vmcnt(0)" ::: "memory");
        } else {
            XB_SPIN(xb_ld(&bar[XB_XGEN(b.x)]) == gen, bar);
            __builtin_amdgcn_fence(__ATOMIC_ACQUIRE, "agent");
            asm volatile("s_waitcnt vmcnt(0)" ::: "memory");
        }
    }
    __syncthreads();
}

template <int ST> __device__ __forceinline__ void run_stage(const Params& p, int l) {
    LAS unsigned char* lds = (LAS unsigned char*)smem_raw;
    pg8::StaticOrder S;
    if (ST == 7) { { const int gw = blockIdx.x * 8 + (otid() >> 6), lane = otid() & 63;
                     if (gw < 128) { const int l2 = gw >> 5, m2 = (gw >> 4) & 1, u2 = gw & 15;
                         conv_unit((m2 ? P_A2 : P_W2) + (size_t)l2 * 64 * 1024, 64, 1024, 1024, (m2 ? P_A2T : P_W2T) + (size_t)l2 * 1024 * 64, 64, u2, lane); } }
                   phase_convert(p, 0, blockIdx.x * 8 + (otid() >> 6), gridDim.x * 8); phase_rmsnorm(P_X_PROMPT, P_X_SAMPLE, P_NORM_G, P_XN, nullptr); }
    if (ST == 0) { pg8::Gemm g{P_XN, P_WINT + (size_t)l * NP * DM, MT, NP, DM}; S.init(MT, NP, gridDim.x, blockIdx.x); EpiZ e{P_Z}; pg8::gemm_phase(lds, g, S, e); }
    if (ST == 1) phase_prep(p, l);
    if (ST == 2) phase_scan(p, l);
    if (ST == 3) phase_post(p, l);
    if (ST == 4) { pg8::Gemm g{P_YAB, P_PABT + (size_t)l * DM * DM, MT, DM, DM}; S.init(MT, DM, gridDim.x, blockIdx.x, 1); EpiMerge e{P_Z, P_M}; pg8::gemm_phase(lds, g, S, e); }
    if (ST == 5) { pg8::Gemm g{P_M, P_WOT + (size_t)l * DM * DM, MT, DM, DM}; S.init(MT, DM, gridDim.x, blockIdx.x);
                   EpiOut e{l == 0 ? P_X_PROMPT : P_H, l == 0 ? P_X_SAMPLE : P_H + (size_t)MP * DM, P_H}; pg8::gemm_phase(lds, g, S, e); }
    if (ST == 6) { if (l < DEPTH - 1) phase_rmsnorm(P_H, P_H + (size_t)MP * DM, P_NORM_G + (size_t)(l + 1) * DM, P_XN, nullptr);
                   else phase_rmsnorm(P_H, P_H + (size_t)MP * DM, P_FINAL_G, nullptr, p.out + O_YP); }
}

#if MK_SINGLE
#ifndef REP0
#define REP0 1
#endif
#ifndef REP1
#define REP1 1
#endif
#ifndef REP2
#define REP2 1
#endif
#ifndef REP3
#define REP3 1
#endif
#ifndef REP4
#define REP4 1
#endif
#ifndef REP6
#define REP6 1
#endif
#ifndef REP7
#define REP7 1
#endif
__global__ void __launch_bounds__(512, 2) mega(Params p) {
    cg::grid_group grid = cg::this_grid();
    __shared__ uint4 xb_words;
    if (threadIdx.x == 0) xb_words = make_uint4(0u, 0u, 0u, 0u);
    __syncthreads();
    const XcdBarrier xb = xcd_barrier_post((unsigned*)(p.ws + WS_BAR), (volatile LAS unsigned*)&xb_words);
#define GSYNC() xcd_barrier(xb)
    for (int r = 0; r < REP7; ++r) { run_stage<7>(p, 0); grid.sync(); }
    for (int l = 0; l < DEPTH; ++l) {
        for (int r = 0; r < REP0; ++r) { run_stage<0>(p, l); GSYNC(); }
        for (int r = 0; r < REP1; ++r) { run_stage<1>(p, l); GSYNC(); }
        for (int r = 0; r < REP2; ++r) { run_stage<2>(p, l); GSYNC(); }
        for (int r = 0; r < REP3; ++r) { run_stage<3>(p, l); GSYNC(); }
        for (int r = 0; r < REP4; ++r) { run_stage<4>(p, l); GSYNC(); }
        run_stage<5>(p, l); GSYNC();
        for (int r = 0; r < REP6; ++r) { run_stage<6>(p, l); if (l + 1 < DEPTH || r + 1 < REP6) GSYNC(); }
    }
}
#else
template <int ST> __global__ void __launch_bounds__(512, 2) stage_k(Params p, int l) { run_stage<ST>(p, l); }
#endif

template <class K> static void set_lds(K k, size_t bytes) { (void)hipFuncSetAttribute((const void*)k, hipFuncAttributeMaxDynamicSharedMemorySize, (int)bytes); }

extern "C" void kernel_launch(void* const* d_in, const int* in_sizes, int n_in, void* d_out, int out_size, void* d_ws, size_t ws_size, hipStream_t stream) {
    constexpr size_t kDynLds = 131072;
    static int grid_blocks = 0;
    if (!grid_blocks) {
        int dev = 0, cus = 0;
        (void)hipGetDevice(&dev);
        (void)hipDeviceGetAttribute(&cus, hipDeviceAttributeMultiprocessorCount, dev);
#if MK_SINGLE
        int per_cu = 0;
        set_lds(mega, kDynLds);
        (void)hipOccupancyMaxActiveBlocksPerMultiprocessor(&per_cu, mega, 512, kDynLds);
        if (per_cu < 1) fprintf(stderr, "occupancy query returned %d\n", per_cu);
#else
        set_lds(stage_k<0>, kDynLds); set_lds(stage_k<1>, kDynLds); set_lds(stage_k<2>, kDynLds); set_lds(stage_k<3>, kDynLds);
        set_lds(stage_k<4>, kDynLds); set_lds(stage_k<5>, kDynLds); set_lds(stage_k<6>, kDynLds); set_lds(stage_k<7>, kDynLds);
#endif
        grid_blocks = cus > 0 ? cus : 256;
    }
    Params p{};
    for (int i = 0; i < 24; ++i) p.in[i] = (const float*)d_in[i];
    p.out = (float*)d_out; p.ws = (char*)d_ws;
    if (ws_size < WS_END) fprintf(stderr, "workspace too small: %zu < %zu\n", ws_size, (size_t)WS_END);
#if MK_SINGLE
    (void)hipMemsetAsync(p.ws + WS_BAR, 0, (size_t)XCD_BAR_WORDS_C * 4, stream);
    void* args[] = {&p};
    hipError_t e = hipLaunchCooperativeKernel((void*)mega, dim3(grid_blocks), dim3(512), args, kDynLds, stream);
    if (e != hipSuccess) fprintf(stderr, "cooperative launch failed: %s (grid %d)\n", hipGetErrorString(e), grid_blocks);
#else
    const dim3 G(grid_blocks), B(512);
    hipLaunchKernelGGL(stage_k<7>, G, B, kDynLds, stream, p, 0);
    for (int l = 0; l < DEPTH; ++l) {
        hipLaunchKernelGGL(stage_k<0>, G, B, kDynLds, stream, p, l);
        hipLaunchKernelGGL(stage_k<1>, G, B, kDynLds, stream, p, l);
        hipLaunchKernelGGL(stage_k<2>, G, B, kDynLds, stream, p, l);
        hipLaunchKernelGGL(stage_k<3>, G, B, kDynLds, stream, p, l);
        hipLaunchKernelGGL(stage_k<4>, G, B, kDynLds, stream, p, l);
        hipLaunchKernelGGL(stage_k<5>, G, B, kDynLds, stream, p, l);
        hipLaunchKernelGGL(stage_k<6>, G, B, kDynLds, stream, p, l);
    }
#endif
}
```

```cpp
#include <hip/hip_runtime.h>
#include <hip/hip_cooperative_groups.h>
#include <cstdio>
namespace cg = cooperative_groups;

#ifndef MK_SINGLE
#define MK_SINGLE 1
#endif

#define LAS __attribute__((address_space(3)))
typedef unsigned short bf16_t;
typedef short bf16x8 __attribute__((ext_vector_type(8)));
typedef float f32x4 __attribute__((ext_vector_type(4)));
typedef float f32x2 __attribute__((ext_vector_type(2)));
typedef unsigned u32x4 __attribute__((ext_vector_type(4)));
typedef unsigned u32x2 __attribute__((ext_vector_type(2)));

constexpr int DM = 2048, DEPTH = 4;
constexpr int MP = 8192, MS = 1024, MT = 9216;
constexpr int DSH = 3200;
constexpr int NP = 11520;
constexpr int NIN = 11392;
constexpr int C_R = 0, C_K = 1024, C_V = 2048, C_WD = 3072, C_AD = 3136, C_GR = 3200, C_U = 4224, C_VG = 5248, C_GG = 6272, C_GA = 7296, C_GB = 9344;
constexpr size_t O_YP = 0, O_WKVP = 18874368, O_SHP = 19922944, O_WKVS = 19974144, O_SHS = 53528576, O_CV = 55166976;
constexpr int NPHASE = 1 + 7 * DEPTH;

constexpr int XCD_BAR_WORDS_C = 3456;
struct Params { const float* in[24]; float* out; char* ws; };
constexpr size_t al256(size_t x) { return (x + 255) & ~(size_t)255; }
constexpr size_t WS_WINT = 0;
constexpr size_t WS_PABT = WS_WINT + al256((size_t)DEPTH * NP * DM * 2);
constexpr size_t WS_WOT = WS_PABT + al256((size_t)DEPTH * DM * DM * 2);
constexpr size_t WS_XN = WS_WOT + al256((size_t)DEPTH * DM * DM * 2);
constexpr size_t WS_Z = WS_XN + al256((size_t)MT * DM * 2);
constexpr size_t WS_VNT = WS_Z + al256((size_t)MT * NP * 2);
constexpr size_t WS_VNTS = WS_VNT + al256((size_t)64 * 1024 * 128 * 2);
constexpr size_t WS_YAB = WS_VNTS + al256((size_t)128 * 1024 * 8 * 2);
constexpr size_t WS_M = WS_YAB + al256((size_t)MT * DM * 2);
constexpr size_t WS_H = WS_M + al256((size_t)MT * DM * 2);
constexpr size_t WS_REC = WS_H + al256((size_t)MT * DM * 4);
constexpr int RECF = 256;
constexpr size_t WS_YBUF = WS_REC + al256((size_t)MT * 16 * RECF * 4);
constexpr size_t WS_W2T = WS_YBUF + al256((size_t)MT * 1024 * 4);
constexpr size_t WS_A2T = WS_W2T + al256((size_t)DEPTH * 1024 * 64 * 2);
constexpr size_t WS_BAR = WS_A2T + al256((size_t)DEPTH * 1024 * 64 * 2);
constexpr size_t WS_END = WS_BAR + al256((size_t)XCD_BAR_WORDS_C * 4);
#define P_X_PROMPT (p.in[0])
#define P_X_SAMPLE (p.in[1])
#define P_STATE_WKV (p.in[2])
#define P_STATE_SHIFT (p.in[3])
#define P_NORM_G (p.in[4])
#define P_W_IN (p.in[5])
#define P_SHIFT_MU (p.in[6])
#define P_W0 (p.in[7])
#define P_W2 (p.in[8])
#define P_A0 (p.in[9])
#define P_A2 (p.in[10])
#define P_K_K (p.in[11])
#define P_K_A (p.in[12])
#define P_R_K (p.in[13])
#define P_LNX_G (p.in[14])
#define P_LNX_B (p.in[15])
#define P_SGU_LN_G (p.in[16])
#define P_SGU_LN_B (p.in[17])
#define P_SGU_W (p.in[18])
#define P_SGU_B (p.in[19])
#define P_W_PROJ_A (p.in[20])
#define P_W_PROJ_B (p.in[21])
#define P_W_OUT (p.in[22])
#define P_FINAL_G (p.in[23])
#define P_WINT ((bf16_t*)(p.ws + WS_WINT))
#define P_PABT ((bf16_t*)(p.ws + WS_PABT))
#define P_WOT ((bf16_t*)(p.ws + WS_WOT))
#define P_XN ((bf16_t*)(p.ws + WS_XN))
#define P_Z ((bf16_t*)(p.ws + WS_Z))
#define P_VNT ((bf16_t*)(p.ws + WS_VNT))
#define P_VNTS ((bf16_t*)(p.ws + WS_VNTS))
#define P_YAB ((bf16_t*)(p.ws + WS_YAB))
#define P_M ((bf16_t*)(p.ws + WS_M))
#define P_H ((float*)(p.ws + WS_H))
#define P_REC ((float*)(p.ws + WS_REC))
#define P_YBUF ((float*)(p.ws + WS_YBUF))
#define P_W2T ((bf16_t*)(p.ws + WS_W2T))
#define P_A2T ((bf16_t*)(p.ws + WS_A2T))

extern __shared__ __attribute__((aligned(16))) unsigned char smem_raw[];

__device__ __forceinline__ int otid() { int t = threadIdx.x; asm volatile("" : "+v"(t)); return t; }
__device__ __forceinline__ float bf2f(bf16_t v) { return __uint_as_float(((unsigned)v) << 16); }
__device__ __forceinline__ float bflo(unsigned v) { return __uint_as_float(v << 16); }
__device__ __forceinline__ float bfhi(unsigned v) { return __uint_as_float(v & 0xffff0000u); }
__device__ __forceinline__ unsigned pk_bf16(float lo, float hi) { unsigned r; asm("v_cvt_pk_bf16_f32 %0, %1, %2" : "=v"(r) : "v"(lo), "v"(hi)); return r; }
template <int CTRL> __device__ __forceinline__ float dppf(float x) { return __int_as_float(__builtin_amdgcn_update_dpp(0, __float_as_int(x), CTRL, 0xF, 0xF, true)); }
__device__ __forceinline__ float red16(float x) { x += dppf<0xB1>(x); x += dppf<0x4E>(x); x += dppf<0x141>(x); x += dppf<0x140>(x); return x; }
__device__ __forceinline__ void red16x2(float& x, float& y) { x += dppf<0xB1>(x); y += dppf<0xB1>(y); x += dppf<0x4E>(x); y += dppf<0x4E>(y); x += dppf<0x141>(x); y += dppf<0x141>(y); x += dppf<0x140>(x); y += dppf<0x140>(y); }
__device__ __forceinline__ float red32(float x) { x = red16(x); x += __shfl_xor(x, 16); return x; }
__device__ __forceinline__ float red64(float x) { x = red16(x); x += __shfl_xor(x, 16); x += __shfl_xor(x, 32); return x; }
__device__ __forceinline__ float sigmoidf_(float x) { return __builtin_amdgcn_rcpf(1.f + __expf(-x)); }
__device__ __forceinline__ float tanhf_(float x) { const float e = __expf(2.f * fminf(fmaxf(x, -15.f), 15.f)); return 1.f - 2.f * __builtin_amdgcn_rcpf(1.f + e); }
__device__ __forceinline__ float siluf_(float x) { return x * __builtin_amdgcn_rcpf(1.f + __expf(-x)); }

namespace pg8 {
constexpr int BM = 256, BK = 64, HALF = 128, HTB = HALF * BK * 2, STAGE_BYTES = 8 * HTB, NXCD = 8, WGM = 8;
__device__ __forceinline__ int lds_byte(int r, int c) { const int st = (r >> 4) * 2 + (c >> 5), rr = r & 15, cc = c & 31, ob = rr * 64 + cc * 2; return st * 1024 + (ob ^ (((ob >> 9) & 1) << 5)); }
__device__ __forceinline__ void stage_rc(int b, int& R, int& C) { const int st = b / 1024, sb = b % 1024, swz = sb ^ (((sb >> 9) & 1) << 5); R = (st >> 1) * 16 + swz / 64; C = (st & 1) * 32 + (swz % 64) / 2; }
__device__ __forceinline__ int perm32(int rho) { const int n = rho >> 4, i = rho & 15; return 8 * (i >> 2) + 4 * n + (i & 3); }
struct Unit { int pm, pn, seg; };
struct Gemm { const bf16_t* A; const bf16_t* Bt; int M, N, K; };
struct StaticOrder {
    int nM, nN, nwg, G, c;
    __device__ void init(int M, int N, int G_, int c_, int split_ = 0) { nM = M / BM; nN = N / BM; nwg = nM * nN; G = G_; c = c_; split = split_; }
    int split;
    __device__ bool next(int i, Unit& u) const {
        u.seg = split ? (i & 1) : 0; if (split) i >>= 1;
        const long L = (long)i * G + c; if (L >= nwg) return false;
        int wgid = (int)L; { const int q = nwg / NXCD, r = nwg % NXCD, xcd = wgid % NXCD, off = wgid / NXCD; wgid = (xcd < r ? xcd * (q + 1) : r * (q + 1) + (xcd - r) * q) + off; }
        const int nig = WGM * nN, gid = wgid / nig, fm = gid * WGM, gsz = (nM - fm) < WGM ? (nM - fm) : WGM;
        u.pm = fm + ((wgid % nig) % gsz); u.pn = (wgid % nig) / gsz; return true;
    }
};

template <class Epi, class Sched>
__device__ __forceinline__ void gemm_phase(LAS unsigned char* lds, const Gemm g, const Sched& S, const Epi& E) {
    const int tid = otid(), wid = __builtin_amdgcn_readfirstlane(tid >> 6), lane = tid & 63, wr = wid >> 2, wc = wid & 3, fr = lane & 15, fq = lane >> 4;
    const int ld = g.K, nt = Epi::SPLIT2 ? g.K / BK / 2 : g.K / BK;
    const size_t segstep = (size_t)nt * BK * 2;
    unsigned voffA[2], voffB[2];
#pragma unroll
    for (int i = 0; i < 2; ++i) { int R, C; stage_rc(tid * 16 + i * 8192, R, C); const int Rb = Epi::PERM ? ((R & ~31) + perm32(R & 31)) : R;
        voffA[i] = (unsigned)(R * ld + C) * 2u; voffB[i] = (unsigned)(Rb * ld + C) * 2u; }
    const size_t kstep = (size_t)(BK * 2);
    const size_t hstep = (size_t)HALF * ld * 2;
    const size_t tstep = 2 * hstep;
    const unsigned ldsw = (unsigned)wid * 1024u;
    const int aoff = lds_byte(wr * 64 + fr, fq * 8), boff = lds_byte(wc * 32 + fr, fq * 8);
#define PG8_SA(b, h) (((b) * 2 + (h)) * HTB)
#define PG8_SB(b, h) ((4 + (b) * 2 + (h)) * HTB)
#define PG8_STAGE(bufoff, gbase, voff) do { _Pragma("unroll") for (int _i = 0; _i < 2; ++_i) \
        __builtin_amdgcn_global_load_lds((const unsigned*)((const char*)(gbase) + (voff)[_i]), (LAS unsigned*)(lds + (bufoff) + ldsw + _i * 8192), 16, 0, 0); } while (0)
#define PG8_LDA(dst, b, h) do { _Pragma("unroll") for (int m = 0; m < 4; ++m) _Pragma("unroll") for (int k = 0; k < 2; ++k) dst[m][k] = *(const LAS bf16x8*)(lds + PG8_SA(b, h) + aoff + m * 2048 + k * 1024); } while (0)
#define PG8_LDB(dst, b, h) do { _Pragma("unroll") for (int n = 0; n < 2; ++n) _Pragma("unroll") for (int k = 0; k < 2; ++k) dst[n][k] = *(const LAS bf16x8*)(lds + PG8_SB(b, h) + boff + n * 2048 + k * 1024); } while (0)
#define PG8_MMA(ai, bj, At, Bt) do { __builtin_amdgcn_s_setprio(1); _Pragma("unroll") for (int m = 0; m < 4; ++m) _Pragma("unroll") for (int n = 0; n < 2; ++n) _Pragma("unroll") for (int k = 0; k < 2; ++k) \
        acc[ai][bj][m][n] = __builtin_amdgcn_mfma_f32_16x16x32_bf16(Bt[n][k], At[m][k], acc[ai][bj][m][n], 0, 0, 0); __builtin_amdgcn_s_setprio(0); } while (0)
#define PG8_WAIT_V(n) asm volatile("s_waitcnt vmcnt(" #n ")" ::: "memory")
#define PG8_WAIT_L(n) asm volatile("s_waitcnt lgkmcnt(" #n ")" ::: "memory")
#define PG8_BAR __builtin_amdgcn_s_barrier()
#define PG8_SCHED __builtin_amdgcn_sched_barrier(0)
    Unit cur, nxt; int ui = 0;
    if (!S.next(0, cur)) return;
    f32x4 acc[2][2][4][2];
#pragma unroll
    for (int a = 0; a < 2; ++a)
#pragma unroll
        for (int b = 0; b < 2; ++b)
#pragma unroll
            for (int m = 0; m < 4; ++m)
#pragma unroll
                for (int n = 0; n < 2; ++n) acc[a][b][m][n] = (f32x4){0.f, 0.f, 0.f, 0.f};
    bf16x8 At[4][2], B0[2][2], B1[2][2];
    const char* cA = (const char*)g.A + (size_t)cur.pm * tstep + (Epi::SPLIT2 ? cur.seg * segstep : 0); const char* cB = (const char*)g.Bt + (size_t)cur.pn * tstep + (Epi::SPLIT2 ? cur.seg * segstep : 0);
    PG8_STAGE(PG8_SB(0, 0), cB, voffB); PG8_STAGE(PG8_SA(0, 0), cA, voffA); PG8_STAGE(PG8_SB(0, 1), cB + hstep, voffB); PG8_STAGE(PG8_SA(0, 1), cA + hstep, voffA);
    if (wr == 1) PG8_BAR;
    PG8_WAIT_V(4); PG8_BAR;
    PG8_STAGE(PG8_SB(1, 0), cB + kstep, voffB); PG8_STAGE(PG8_SA(1, 0), cA + kstep, voffA); PG8_STAGE(PG8_SB(1, 1), cB + hstep + kstep, voffB);
    PG8_WAIT_V(6); PG8_BAR;
    for (;;) {
        const bool has_next = S.next(ui + 1, nxt);
        const char* nA = has_next ? (const char*)g.A + (size_t)nxt.pm * tstep + (Epi::SPLIT2 ? nxt.seg * segstep : 0) : cA; const char* nB = has_next ? (const char*)g.Bt + (size_t)nxt.pn * tstep + (Epi::SPLIT2 ? nxt.seg * segstep : 0) : cB;
        for (int t = 0; t < nt; t += 2) {
            const bool last = (t == nt - 2);
            const char* a1 = cA + (size_t)(t + 1) * kstep;
            const char* a2 = last ? nA : cA + (size_t)(t + 2) * kstep; const char* b2 = last ? nB : cB + (size_t)(t + 2) * kstep;
            const char* a3 = a2 + kstep; const char* b3 = b2 + kstep;
            PG8_LDB(B0, 0, 0); PG8_SCHED; PG8_LDA(At, 0, 0); PG8_STAGE(PG8_SA(1, 1), a1 + hstep, voffA);
            PG8_WAIT_L(8); PG8_BAR; PG8_WAIT_L(0); PG8_MMA(0, 0, At, B0); PG8_BAR; PG8_SCHED;
            PG8_LDB(B1, 0, 1); PG8_STAGE(PG8_SB(0, 0), b2, voffB);
            PG8_BAR; PG8_WAIT_L(0); PG8_MMA(0, 1, At, B1); PG8_BAR;
            PG8_LDA(At, 0, 1); PG8_STAGE(PG8_SA(0, 0), a2, voffA);
            PG8_BAR; PG8_WAIT_L(0); PG8_MMA(1, 0, At, B0); PG8_BAR; PG8_SCHED;
            PG8_STAGE(PG8_SB(0, 1), b2 + hstep, voffB);
            PG8_WAIT_V(6); PG8_BAR; PG8_MMA(1, 1, At, B1); PG8_BAR;
            PG8_LDB(B0, 1, 0); PG8_SCHED; PG8_LDA(At, 1, 0); PG8_STAGE(PG8_SA(0, 1), a2 + hstep, voffA);
            PG8_WAIT_L(8); PG8_BAR; PG8_WAIT_L(0); PG8_MMA(0, 0, At, B0); PG8_BAR; PG8_SCHED;
            PG8_LDB(B1, 1, 1); PG8_STAGE(PG8_SB(1, 0), b3, voffB);
            PG8_BAR; PG8_WAIT_L(0); PG8_MMA(0, 1, At, B1); PG8_BAR;
            PG8_LDA(At, 1, 1); PG8_STAGE(PG8_SA(1, 0), a3, voffA);
            PG8_BAR; PG8_WAIT_L(0); PG8_MMA(1, 0, At, B0); PG8_BAR; PG8_SCHED;
            PG8_STAGE(PG8_SB(1, 1), b3 + hstep, voffB);
            PG8_WAIT_V(6); PG8_BAR; PG8_MMA(1, 1, At, B1); PG8_BAR;
        }
        E(acc, cur, wr, wc, fr, fq);
        if (!has_next) break;
        if (!(Epi::SPLIT2 && cur.seg == 0))
#pragma unroll
        for (int a = 0; a < 2; ++a)
#pragma unroll
            for (int b = 0; b < 2; ++b)
#pragma unroll
                for (int m = 0; m < 4; ++m)
#pragma unroll
                    for (int n = 0; n < 2; ++n) acc[a][b][m][n] = (f32x4){0.f, 0.f, 0.f, 0.f};
        cur = nxt; cA = nA; cB = nB; ++ui;
    }
    PG8_WAIT_V(0);
    if (wr == 0) PG8_BAR;
    PG8_BAR;
#undef PG8_SA
#undef PG8_SB
#undef PG8_STAGE
#undef PG8_LDA
#undef PG8_LDB
#undef PG8_MMA
#undef PG8_WAIT_V
#undef PG8_WAIT_L
#undef PG8_BAR
#undef PG8_SCHED
}
}

struct EpiZ {
    static constexpr bool PERM = true, SPLIT2 = false;
    bf16_t* Z;
    __device__ __forceinline__ void operator()(f32x4 (&acc)[2][2][4][2], const pg8::Unit& u, int wr, int wc, int fr, int fq) const {
        const int row0 = u.pm * 256 + wr * 64 + fr, col0 = u.pn * 256 + wc * 32 + 8 * fq;
#pragma unroll
        for (int ai = 0; ai < 2; ++ai)
#pragma unroll
            for (int m = 0; m < 4; ++m) { bf16_t* rowp = Z + (size_t)(row0 + ai * 128 + m * 16) * NP + col0;
#pragma unroll
                for (int bj = 0; bj < 2; ++bj) { const f32x4 v0 = acc[ai][bj][m][0], v1 = acc[ai][bj][m][1];
                    u32x4 o; o[0] = pk_bf16(v0[0], v0[1]); o[1] = pk_bf16(v0[2], v0[3]); o[2] = pk_bf16(v1[0], v1[1]); o[3] = pk_bf16(v1[2], v1[3]);
                    *(u32x4*)(rowp + bj * 128) = o; } }
    }
};
struct EpiMerge {
    static constexpr bool PERM = true, SPLIT2 = true;
    const bf16_t* Z; bf16_t* Mo;
    __device__ __forceinline__ void mid(f32x4 (&acc)[2][2][4][2], const pg8::Unit& u, int wr, int wc, int fr, int fq) const {
        const int row0 = u.pm * 256 + wr * 64 + fr, col0 = u.pn * 256 + wc * 32 + 8 * fq;
#pragma unroll
        for (int ai = 0; ai < 2; ++ai)
#pragma unroll
            for (int m = 0; m < 4; ++m) { const bf16_t* zr = Z + (size_t)(row0 + ai * 128 + m * 16) * NP + col0;
#pragma unroll
                for (int bj = 0; bj < 2; ++bj) { const u32x4 ga = *(const u32x4*)(zr + C_GA + bj * 128), gb = *(const u32x4*)(zr + C_GB + bj * 128);
#pragma unroll
                    for (int q = 0; q < 4; ++q) { const float a0 = bflo(ga[q]), a1 = bfhi(ga[q]), b0 = bflo(gb[q]), b1 = bfhi(gb[q]);
                        const float r0 = (1.f + __expf(-b0)) * __builtin_amdgcn_rcpf(1.f + __expf(-a0)), r1 = (1.f + __expf(-b1)) * __builtin_amdgcn_rcpf(1.f + __expf(-a1));
                        acc[ai][bj][m][q >> 1][(q & 1) * 2] *= r0; acc[ai][bj][m][q >> 1][(q & 1) * 2 + 1] *= r1; } } }
    }
    __device__ __forceinline__ void fin(f32x4 (&acc)[2][2][4][2], const pg8::Unit& u, int wr, int wc, int fr, int fq) const {
        const int row0 = u.pm * 256 + wr * 64 + fr, col0 = u.pn * 256 + wc * 32 + 8 * fq;
#pragma unroll
        for (int ai = 0; ai < 2; ++ai)
#pragma unroll
            for (int m = 0; m < 4; ++m) { const size_t r = (size_t)(row0 + ai * 128 + m * 16); const bf16_t* zr = Z + r * NP + col0; bf16_t* mo = Mo + r * DM + col0;
#pragma unroll
                for (int bj = 0; bj < 2; ++bj) { const u32x4 gb = *(const u32x4*)(zr + C_GB + bj * 128); u32x4 o;
#pragma unroll
                    for (int q = 0; q < 4; ++q) { const float s0 = sigmoidf_(bflo(gb[q])), s1 = sigmoidf_(bfhi(gb[q]));
                        o[q] = pk_bf16(acc[ai][bj][m][q >> 1][(q & 1) * 2] * s0, acc[ai][bj][m][q >> 1][(q & 1) * 2 + 1] * s1); }
                    *(u32x4*)(mo + bj * 128) = o; } }
    }
    __device__ __forceinline__ void operator()(f32x4 (&acc)[2][2][4][2], const pg8::Unit& u, int wr, int wc, int fr, int fq) const {
        if (u.seg == 0) mid(acc, u, wr, wc, fr, fq); else fin(acc, u, wr, wc, fr, fq);
    }
};
struct EpiOut {
    static constexpr bool PERM = false, SPLIT2 = false;
    const float* hp; const float* hs; float* Ho;
    __device__ __forceinline__ void operator()(f32x4 (&acc)[2][2][4][2], const pg8::Unit& u, int wr, int wc, int fr, int fq) const {
        const int row0 = u.pm * 256 + wr * 64 + fr, col0 = u.pn * 256 + wc * 32 + 4 * fq;
        const float* src = (u.pm < 32) ? hp + (size_t)row0 * DM : hs + (size_t)(row0 - MP) * DM;
#pragma unroll
        for (int ai = 0; ai < 2; ++ai)
#pragma unroll
            for (int m = 0; m < 4; ++m) { const size_t ro = (size_t)(ai * 128 + m * 16) * DM + col0; float* dst = Ho + (size_t)row0 * DM + ro;
#pragma unroll
                for (int bj = 0; bj < 2; ++bj)
#pragma unroll
                    for (int n = 0; n < 2; ++n) { const f32x4 o = *(const f32x4*)(src + ro + bj * 128 + n * 16) + acc[ai][bj][m][n]; *(f32x4*)(dst + bj * 128 + n * 16) = o; } }
    }
};

__device__ __forceinline__ void conv_unit(const float* __restrict__ W, int K, int N, int Npad, bf16_t* __restrict__ Wt, int ldt, int unit, int lane) {
    const int nnb = Npad >> 6; const int kb = unit / nnb, nb = unit - kb * nnb;
    const int n = nb * 64 + lane, k0 = kb * 64;
    bf16_t* dst = Wt + (size_t)n * ldt + k0;
    if (n < N) {
        const float* src = W + (size_t)k0 * N + n;
        float v[64];
#pragma unroll
        for (int j = 0; j < 64; ++j) v[j] = src[(size_t)j * N];
#pragma unroll
        for (int kk = 0; kk < 64; kk += 8) { u32x4 o; o[0] = pk_bf16(v[kk], v[kk + 1]); o[1] = pk_bf16(v[kk + 2], v[kk + 3]); o[2] = pk_bf16(v[kk + 4], v[kk + 5]); o[3] = pk_bf16(v[kk + 6], v[kk + 7]);
            *(u32x4*)(dst + kk) = o; }
    } else {
#pragma unroll
        for (int kk = 0; kk < 64; kk += 8) *(u32x4*)(dst + kk) = (u32x4){0u, 0u, 0u, 0u};
    }
}
__device__ void phase_convert(const Params& p, int l, int gw, int nw) {
    const int lane = otid() & 63;
    constexpr int U_IN = (NP / 64) * 32, U_P = 32 * 16, U_O = 32 * 32, U_L = U_IN + 2 * U_P + U_O;
    for (int u = gw; u < U_L; u += nw) {
        int r = u;
        if (r < U_IN) conv_unit(P_W_IN + (size_t)l * DM * NIN, DM, NIN, NP, P_WINT + (size_t)l * NP * DM, DM, r, lane);
        else if ((r -= U_IN) < U_P) conv_unit(P_W_PROJ_A + (size_t)l * 1024 * DM, 1024, DM, DM, P_PABT + (size_t)l * DM * DM, DM, r, lane);
        else if ((r -= U_P) < U_P) conv_unit(P_W_PROJ_B + (size_t)l * 1024 * DM, 1024, DM, DM, P_PABT + (size_t)l * DM * DM + 1024, DM, r, lane);
        else { r -= U_P; conv_unit(P_W_OUT + (size_t)l * DM * DM, DM, DM, DM, P_WOT + (size_t)l * DM * DM, DM, r, lane); }
    }
}

__device__ void phase_rmsnorm(const float* hp, const float* hs, const float* g, bf16_t* obf, float* of32) {
    const int lane = otid() & 63, gw = blockIdx.x * 8 + (otid() >> 6), nw = gridDim.x * 8;
    for (int row = gw; row < MT; row += nw) {
        const f32x4* x = (const f32x4*)(row < MP ? hp + (size_t)row * DM : hs + (size_t)(row - MP) * DM);
        f32x4 v[8]; float ss = 0.f;
#pragma unroll
        for (int i = 0; i < 8; ++i) { v[i] = x[lane + 64 * i]; ss += v[i][0] * v[i][0] + v[i][1] * v[i][1] + v[i][2] * v[i][2] + v[i][3] * v[i][3]; }
        ss = red64(ss);
        const float rstd = rsqrtf(ss * (1.f / DM) + 1e-6f);
#pragma unroll
        for (int i = 0; i < 8; ++i) { const f32x4 gg = ((const f32x4*)g)[lane + 64 * i]; const f32x4 o = v[i] * rstd * gg;
            if (obf) { u32x2 w; w[0] = pk_bf16(o[0], o[1]); w[1] = pk_bf16(o[2], o[3]); *(u32x2*)(obf + (size_t)row * DM + (lane + 64 * i) * 4) = w; }
            else *(f32x4*)(of32 + (size_t)row * DM + (lane + 64 * i) * 4) = o; }
    }
}

__device__ void phase_prep(const Params& p, int l) {
    LAS float* sm = (LAS float*)smem_raw;
    LAS bf16_t* twb = (LAS bf16_t*)sm;
    LAS bf16_t* adb = twb + 16 * 72;
    LAS float* red = sm + 1152;
    LAS float* lwla = sm + 2048;
    const int tid = otid(), lane = tid & 63, wv = tid >> 6;
    const int c = tid * 2;
    const float* mu = P_SHIFT_MU + l * DSH;
    for (int i = tid; i < 2 * 8 * 72 / 2; i += 512) { const int m_ = i / 288, r_ = i % 288; ((LAS unsigned*)(twb + m_ * 16 * 72 + 8 * 72))[r_] = 0u; }
    for (int item = blockIdx.x; item < MT / 8; item += gridDim.x) {
        const int row0 = item * 8;
        const bool samp = row0 >= MP;
        const int sb = (row0 - MP) >> 3, pb = row0 >> 11, t0 = row0 & 2047;
        const bf16_t* zr = P_Z + (size_t)row0 * NP;
        const float* sprev = P_STATE_SHIFT + (size_t)(l * 128 + (samp ? sb : 0)) * DSH;
        const bool zprev = (!samp) && (t0 == 0);
        {
            const int j = tid & 127, col = C_WD + j, tp = tid >> 7;
            const float m_ = mu[col];
#pragma unroll
            for (int tt = 0; tt < 2; ++tt) { const int t = tp * 2 + tt;
                const float cur = bf2f(zr[(size_t)t * NP + col]);
                float prv;
                if (t == 0) prv = samp ? sprev[col] : (zprev ? 0.f : bf2f(*(zr + col - NP))); else prv = bf2f(zr[(size_t)(t - 1) * NP + col]);
                const float mix = cur + (prv - cur) * m_;
                if (j < 64) twb[t * 72 + j] = (bf16_t)(pk_bf16(tanhf_(mix), 0.f) & 0xffffu); else adb[t * 72 + j - 64] = (bf16_t)(pk_bf16(mix, 0.f) & 0xffffu); }
        }
        unsigned vgw[8];
#pragma unroll
        for (int t = 0; t < 8; ++t) vgw[t] = *(const unsigned*)(zr + (size_t)t * NP + C_VG + c);
        float rm[8][2], km[8][2], vm[8][2];
#pragma unroll
        for (int sec = 0; sec < 3; ++sec) { const int col = sec * 1024 + c;
            float p0, p1;
            if (samp) { const f32x2 s2 = *(const f32x2*)(sprev + col); p0 = s2[0]; p1 = s2[1]; }
            else if (zprev) { p0 = 0.f; p1 = 0.f; }
            else { const unsigned w = *(const unsigned*)(zr + col - NP); p0 = bflo(w); p1 = bfhi(w); }
            const f32x2 m2 = *(const f32x2*)(mu + col);
#pragma unroll
            for (int t = 0; t < 8; ++t) { const unsigned w = *(const unsigned*)(zr + (size_t)t * NP + col); const float c0 = bflo(w), c1 = bfhi(w);
                const float x0 = c0 + (p0 - c0) * m2[0], x1 = c1 + (p1 - c1) * m2[1];
                if (sec == 0) { rm[t][0] = x0; rm[t][1] = x1; } else if (sec == 1) { km[t][0] = x0; km[t][1] = x1; } else { vm[t][0] = x0; vm[t][1] = x1; }
                p0 = c0; p1 = c1; } }
        __syncthreads();
        {
            const int fr = lane & 15, fq = lane >> 4;
            bf16x8 aw[2], aa[2];
#pragma unroll
            for (int ks = 0; ks < 2; ++ks) { aw[ks] = *(const LAS bf16x8*)(twb + fr * 72 + ks * 32 + fq * 8); aa[ks] = *(const LAS bf16x8*)(adb + fr * 72 + ks * 32 + fq * 8); }
            const bf16_t* w2t = P_W2T + ((size_t)l * 1024 + wv * 128 + fr) * 64 + fq * 8;
            const bf16_t* a2t = P_A2T + ((size_t)l * 1024 + wv * 128 + fr) * 64 + fq * 8;
#pragma unroll
            for (int nt = 0; nt < 8; ++nt) {
                f32x4 dw = (f32x4){0.f, 0.f, 0.f, 0.f}, da = (f32x4){0.f, 0.f, 0.f, 0.f};
#pragma unroll
                for (int ks = 0; ks < 2; ++ks) { const bf16x8 bw = *(const bf16x8*)(w2t + nt * 16 * 64 + ks * 32), ba = *(const bf16x8*)(a2t + nt * 16 * 64 + ks * 32);
                    dw = __builtin_amdgcn_mfma_f32_16x16x32_bf16(aw[ks], bw, dw, 0, 0, 0); da = __builtin_amdgcn_mfma_f32_16x16x32_bf16(aa[ks], ba, da, 0, 0, 0); }
                if (fq < 2) { const int ch = wv * 128 + nt * 16 + fr;
#pragma unroll
                    for (int r = 0; r < 4; ++r) *(LAS f32x2*)(lwla + ((fq * 4 + r) * 1024 + ch) * 2) = (f32x2){dw[r], da[r]}; }
            }
        }
        __syncthreads();
        float lw[8][2], la[8][2];
        { const f32x2 w0v = *(const f32x2*)(P_W0 + l * 1024 + c), a0v = *(const f32x2*)(P_A0 + l * 1024 + c);
#pragma unroll
          for (int t = 0; t < 8; ++t) { const f32x4 v = *(const LAS f32x4*)(lwla + (t * 1024 + c) * 2);
              lw[t][0] = w0v[0] + v[0]; la[t][0] = a0v[0] + v[1]; lw[t][1] = w0v[1] + v[2]; la[t][1] = a0v[1] + v[3]; } }
        {
            const f32x2 kkv = *(const f32x2*)(P_K_K + l * 1024 + c), kav = *(const f32x2*)(P_K_A + l * 1024 + c);
            const int hh = c >> 6, cc = c & 63;
#pragma unroll
            for (int t = 0; t < 8; ++t) {
                float dec[2], ag[2], kk[2], kp[2];
#pragma unroll
                for (int e = 0; e < 2; ++e) { const float y = -lw[t][e]; const float sp = fmaxf(y, 0.f) + __logf(1.f + __expf(-fabsf(y)));
                    const float wl = -sp - 0.5f; dec[e] = __expf(-__expf(wl)); ag[e] = sigmoidf_(la[t][e]); kk[e] = km[t][e] * kkv[e]; kp[e] = km[t][e] * (1.f + (ag[e] - 1.f) * kav[e]); }
                const float ss = red32(kk[0] * kk[0] + kk[1] * kk[1]);
                const float inv = __builtin_amdgcn_rsqf(fmaxf(ss, 1e-24f));
                float* rc = P_REC + ((size_t)(row0 + t) * 16 + hh) * RECF;
                u32x4 pkd; pkd[0] = pk_bf16(rm[t][0], rm[t][1]); pkd[1] = pk_bf16(kp[0], kp[1]); pkd[2] = pk_bf16(-kk[0] * inv, -kk[1] * inv); pkd[3] = pk_bf16(kk[0] * inv * ag[0], kk[1] * inv * ag[1]);
                *(u32x4*)(rc + (cc >> 1) * 4) = pkd;
                *(f32x4*)(rc + 128 + (cc >> 1) * 4) = (f32x4){dec[0], dec[1], vm[t][0], vm[t][1]};
            }
        }
        {
            float x[8][2];
#pragma unroll
            for (int t = 0; t < 8; ++t) { x[t][0] = bflo(vgw[t]); x[t][1] = bfhi(vgw[t]); }
#pragma unroll
            for (int t = 0; t < 8; ++t) { const float s1 = red64(x[t][0] + x[t][1]), s2 = red64(x[t][0] * x[t][0] + x[t][1] * x[t][1]);
                if (lane == 0) { red[wv * 16 + t] = s1; red[wv * 16 + 8 + t] = s2; } }
            __syncthreads();
            const f32x2 gv = *(const f32x2*)(P_SGU_LN_G + l * 1024 + c), bv = *(const f32x2*)(P_SGU_LN_B + l * 1024 + c);
            float vn[8][2];
#pragma unroll
            for (int t = 0; t < 8; ++t) { float s1 = 0.f, s2 = 0.f;
#pragma unroll
                for (int w = 0; w < 8; ++w) { s1 += red[w * 16 + t]; s2 += red[w * 16 + 8 + t]; }
                const float mean = s1 * (1.f / 1024.f), var = fmaxf(s2 * (1.f / 1024.f) - mean * mean, 0.f), rstd = rsqrtf(var + 1e-5f);
                vn[t][0] = (x[t][0] - mean) * rstd * gv[0] + bv[0]; vn[t][1] = (x[t][1] - mean) * rstd * gv[1] + bv[1]; }
#pragma unroll
            for (int e = 0; e < 2; ++e) { u32x4 o; o[0] = pk_bf16(vn[0][e], vn[1][e]); o[1] = pk_bf16(vn[2][e], vn[3][e]); o[2] = pk_bf16(vn[4][e], vn[5][e]); o[3] = pk_bf16(vn[6][e], vn[7][e]);
                if (samp) *(u32x4*)(P_VNTS + ((size_t)sb * 1024 + c + e) * 8) = o;
                else *(u32x4*)(P_VNT + (((size_t)(pb * 16 + (t0 >> 7)) * 16 + ((t0 & 127) >> 3)) * 1024 + c + e) * 8) = o; }
            if (samp) {
#pragma unroll
                for (int t = 0; t < 8; ++t) *(f32x2*)(p.out + O_CV + ((size_t)(l * 128 + sb) * 8 + t) * 1024 + c) = (f32x2){vn[t][0], vn[t][1]};
            }
        }
        if (samp) { for (int col = tid; col < DSH; col += 512) p.out[O_SHS + (size_t)(l * 128 + sb) * DSH + col] = bf2f(zr[(size_t)7 * NP + col]); }
        else if (t0 == 2040) { for (int col = tid; col < DSH; col += 512) p.out[O_SHP + (size_t)(l * 4 + pb) * DSH + col] = bf2f(zr[(size_t)7 * NP + col]); }
        __syncthreads();
    }
}

#define WAVE_SYNC() do { asm volatile("s_waitcnt lgkmcnt(0)" ::: "memory"); __builtin_amdgcn_wave_barrier(); } while (0)
__device__ __forceinline__ float dot4(const f32x4 a, const f32x4 b) { return a[0] * b[0] + a[1] * b[1] + a[2] * b[2] + a[3] * b[3]; }

__device__ void scan_prompt_unit(const Params& p, int l, int unit, int wv, int lane, LAS float* lw) {
    const int bh = unit >> 2, b = bh >> 4, h = bh & 15;
    const int rg = lane >> 4, kq = lane & 15;
    const int v0 = (unit & 3) * 16 + wv * 4 + rg;
    const float* recb = P_REC + ((size_t)(b * 2048) * 16 + h) * RECF;
    float* yb = P_YBUF + (size_t)(b * 2048) * 1024 + h * 64 + v0;
    constexpr size_t TS = 16 * RECF;
    LAS float* lv = lw + 16 * 5 * 64;
    LAS float* ly = lv + 64;
    f32x4 s = (f32x4){0.f, 0.f, 0.f, 0.f};
    u32x2 nxA[4][4], nxB[4][4]; f32x4 nwA[4], nwB[4]; float nvA, nvB;
#define SCAN_LOAD_BATCH(nx, nw, nv, tb_) do { \
        _Pragma("unroll") for (int j = 0; j < 4; ++j) { const float* rp = recb + (size_t)((tb_) + rg + 4 * j) * TS; \
            const u32x4 q0 = *(const u32x4*)(rp + kq * 8), q1 = *(const u32x4*)(rp + kq * 8 + 4);     \
            nx[j][0] = (u32x2){q0[0], q1[0]}; nx[j][1] = (u32x2){q0[1], q1[1]}; nx[j][2] = (u32x2){q0[2], q1[2]}; nx[j][3] = (u32x2){q0[3], q1[3]}; \
            const f32x2 w0 = *(const f32x2*)(rp + 128 + kq * 8), w1 = *(const f32x2*)(rp + 128 + kq * 8 + 4); nw[j] = (f32x4){w0[0], w0[1], w1[0], w1[1]}; } \
        nv = recb[(size_t)((tb_) + kq) * TS + 128 + (v0 >> 1) * 4 + 2 + (v0 & 1)]; } while (0)
#define BF4(u) ((f32x4){bflo((u)[0]), bfhi((u)[0]), bflo((u)[1]), bfhi((u)[1])})
#define SCAN_BATCH(nx, nw, nv, tb_) do { \
        WAVE_SYNC(); \
        _Pragma("unroll") for (int j = 0; j < 4; ++j) { LAS float* ls = lw + (rg + 4 * j) * 5 * 64 + kq * 4;     \
            *(LAS f32x4*)(ls) = BF4(nx[j][0]); *(LAS f32x4*)(ls + 64) = nw[j]; *(LAS f32x4*)(ls + 128) = BF4(nx[j][1]); *(LAS f32x4*)(ls + 192) = BF4(nx[j][2]); *(LAS f32x4*)(ls + 256) = BF4(nx[j][3]); } \
        lv[kq * 4 + rg] = nv; \
        WAVE_SYNC(); \
        if ((tb_) + 32 < 2048) SCAN_LOAD_BATCH(nx, nw, nv, (tb_) + 32); \
        f32x4 a4 = *(const LAS f32x4*)(lw + 3 * 64 + kq * 4); \
        float pa = dot4(s, a4), py = 0.f; \
        _Pragma("unroll") for (int q = 0; q < 16; ++q) { \
            const LAS float* lc = lw + q * 5 * 64 + kq * 4; \
            const f32x4 w4 = *(const LAS f32x4*)(lc + 64), k4 = *(const LAS f32x4*)(lc + 128), b4 = *(const LAS f32x4*)(lc + 256), r4 = *(const LAS f32x4*)(lc); \
            const float vv = lv[q * 4 + rg]; \
            f32x4 a4n = a4; \
            if (q < 15) a4n = *(const LAS f32x4*)(lc + 5 * 64 + 192); \
            if (q > 0) { red16x2(pa, py); ly[(q - 1) * 4 + rg] = py; } else pa = red16(pa); \
            s = s * w4 + vv * k4 + pa * b4; \
            py = dot4(s, r4); \
            if (q < 15) pa = dot4(s, a4n); \
            a4 = a4n; } \
        py = red16(py); ly[15 * 4 + rg] = py; \
        asm volatile("s_waitcnt lgkmcnt(0)" ::: "memory"); \
        yb[(size_t)((tb_) + kq) * 1024] = ly[kq * 4 + rg]; } while (0)
    SCAN_LOAD_BATCH(nxA, nwA, nvA, 0);
    SCAN_LOAD_BATCH(nxB, nwB, nvB, 16);
    for (int tb = 0; tb < 2048; tb += 32) {
        SCAN_BATCH(nxA, nwA, nvA, tb);
        SCAN_BATCH(nxB, nwB, nvB, tb + 16);
    }
#undef SCAN_BATCH
#undef SCAN_LOAD_BATCH
#undef BF4
    *(f32x4*)(p.out + O_WKVP + ((size_t)((l * 4 + b) * 16 + h) * 64 + v0) * 64 + kq * 4) = s;
}

__device__ void scan_sample_item(const Params& p, int l, int item, int lane, LAS float* lw) {
    const int b = item >> 4, h = item & 15;
    const int rg = lane >> 4, kq = lane & 15;
    const size_t sbase = (size_t)((l * 128 + b) * 16 + h) * 4096;
    const float* S0 = P_STATE_WKV + sbase;
    f32x4 s[16];
#pragma unroll
    for (int i = 0; i < 16; ++i) s[i] = *(const f32x4*)(S0 + (rg * 16 + i) * 64 + kq * 4);
    const float* recb = P_REC + ((size_t)(MP + b * 8) * 16 + h) * RECF;
    float nx[6];
#define SAMPLE_LOAD(rp_) do { const bf16_t* rb = (const bf16_t*)(rp_) + (lane >> 1) * 8 + (lane & 1); const float* rf = (rp_) + 128 + (lane >> 1) * 4 + (lane & 1); \
        nx[0] = bf2f(rb[0]); nx[2] = bf2f(rb[2]); nx[4] = bf2f(rb[4]); nx[5] = bf2f(rb[6]); nx[1] = rf[0]; nx[3] = rf[2]; } while (0)
    SAMPLE_LOAD(recb);
    for (int t = 0; t < 8; ++t) {
        WAVE_SYNC();
#pragma unroll
        for (int j = 0; j < 6; ++j) lw[j * 64 + lane] = nx[j];
        WAVE_SYNC();
        if (t < 7) SAMPLE_LOAD(recb + (size_t)(t + 1) * 16 * RECF);
        const f32x4 r4 = *(const LAS f32x4*)(lw + 0 * 64 + kq * 4), w4 = *(const LAS f32x4*)(lw + 1 * 64 + kq * 4), k4 = *(const LAS f32x4*)(lw + 2 * 64 + kq * 4),
                    a4 = *(const LAS f32x4*)(lw + 4 * 64 + kq * 4), b4 = *(const LAS f32x4*)(lw + 5 * 64 + kq * 4);
        float ysel = 0.f;
#pragma unroll
        for (int i4 = 0; i4 < 4; ++i4) {
            const f32x4 vv = *(const LAS f32x4*)(lw + 3 * 64 + rg * 16 + i4 * 4);
#pragma unroll
            for (int ii = 0; ii < 4; ++ii) { const int i = i4 * 4 + ii;
                const float sa = red16(dot4(s[i], a4));
                s[i] = s[i] * w4 + vv[ii] * k4 + sa * b4;
                const float y = red16(dot4(s[i], r4));
                ysel = (kq == i) ? y : ysel; }
        }
        P_YBUF[(size_t)(MP + b * 8 + t) * 1024 + h * 64 + rg * 16 + kq] = ysel;
    }
    float* So = p.out + O_WKVS + sbase;
#pragma unroll
    for (int i = 0; i < 16; ++i) *(f32x4*)(So + (rg * 16 + i) * 64 + kq * 4) = s[i];
}

__device__ void sgu_prompt_item(const Params& p, int l, int item, int lane) {
    const int slab = item & 7, g = (item >> 3) & 7, bc = item >> 6;
    const int fr = lane & 15, fq = lane >> 4;
    bf16x8 vf[4];
#pragma unroll
    for (int ks = 0; ks < 4; ++ks) vf[ks] = *(const bf16x8*)(P_VNT + (((size_t)bc * 16 + ks * 4 + fq) * 1024 + g * 128 + slab * 16 + fr) * 8);
    const float* Wg = P_SGU_W + (size_t)(l * 8 + g) * 16384;
    const float* bg = P_SGU_B + (size_t)(l * 8 + g) * 128;
    const int ch = g * 128 + slab * 16 + fq * 4;
#pragma unroll
    for (int tt = 0; tt < 8; ++tt) {
        f32x4 acc = (f32x4){0.f, 0.f, 0.f, 0.f};
        const int t = tt * 16 + fr;
#pragma unroll
        for (int ks = 0; ks <= tt / 2; ++ks) {
            const int s0 = ks * 32 + fq * 8;
            const f32x4 wa = *(const f32x4*)(Wg + t * 128 + s0), wb = *(const f32x4*)(Wg + t * 128 + s0 + 4);
            float wv[8] = {wa[0], wa[1], wa[2], wa[3], wb[0], wb[1], wb[2], wb[3]};
#pragma unroll
            for (int j = 0; j < 8; ++j) wv[j] = (s0 + j <= t) ? wv[j] : 0.f;
            u32x4 pk; pk[0] = pk_bf16(wv[0], wv[1]); pk[1] = pk_bf16(wv[2], wv[3]); pk[2] = pk_bf16(wv[4], wv[5]); pk[3] = pk_bf16(wv[6], wv[7]);
            bf16x8 wf; __builtin_memcpy(&wf, &pk, 16);
            acc = __builtin_amdgcn_mfma_f32_16x16x32_bf16(vf[ks], wf, acc, 0, 0, 0);
        }
        const size_t row = (size_t)bc * 128 + t;
        const float sbv = bg[t];
        const u32x2 uu = *(const u32x2*)(P_Z + row * NP + C_U + ch), gg = *(const u32x2*)(P_Z + row * NP + C_GG + ch);
        const float o0 = bflo(uu[0]) * (acc[0] + sbv) * siluf_(bflo(gg[0])), o1 = bfhi(uu[0]) * (acc[1] + sbv) * siluf_(bfhi(gg[0]));
        const float o2 = bflo(uu[1]) * (acc[2] + sbv) * siluf_(bflo(gg[1])), o3 = bfhi(uu[1]) * (acc[3] + sbv) * siluf_(bfhi(gg[1]));
        u32x2 o; o[0] = pk_bf16(o0, o1); o[1] = pk_bf16(o2, o3);
        *(u32x2*)(P_YAB + row * DM + 1024 + ch) = o;
    }
}

__device__ void sgu_sample_item(const Params& p, int l, int item, int lane) {
    const int b = item >> 4, ch = (item & 15) * 64 + lane, g = ch >> 7;
    const u32x4 vv = *(const u32x4*)(P_VNTS + ((size_t)b * 1024 + ch) * 8);
    float vn[8] = {bflo(vv[0]), bfhi(vv[0]), bflo(vv[1]), bfhi(vv[1]), bflo(vv[2]), bfhi(vv[2]), bflo(vv[3]), bfhi(vv[3])};
    const float* Wg = P_SGU_W + (size_t)(l * 8 + g) * 16384;
    const float* bg = P_SGU_B + (size_t)(l * 8 + g) * 128;
#pragma unroll
    for (int t = 0; t < 8; ++t) {
        float sacc = bg[t];
#pragma unroll
        for (int s = 0; s <= t; ++s) sacc += Wg[t * 128 + s] * vn[s];
        const size_t row = (size_t)MP + b * 8 + t;
        const float u = bf2f(P_Z[row * NP + C_U + ch]), gg = bf2f(P_Z[row * NP + C_GG + ch]);
        const float o = u * sacc * siluf_(gg);
        P_YAB[row * DM + 1024 + ch] = (bf16_t)(pk_bf16(o, 0.f) & 0xffffu);
    }
}

__device__ void phase_scan(const Params& p, int l) {
    const int tid = otid(), lane = tid & 63, wv = __builtin_amdgcn_readfirstlane(tid >> 6);
    LAS float* lw = (wv < 4) ? (LAS float*)smem_raw + wv * 6144 : (LAS float*)smem_raw + 24576 + (wv - 4) * 2048;
#ifndef REP_PR
#define REP_PR 1
#endif
#ifndef REP_IT
#define REP_IT 1
#endif
    if (wv < 4) {
      for (int rr = 0; rr < REP_PR; ++rr)
        for (int u0 = blockIdx.x; u0 < 256; u0 += gridDim.x) { const int unit = (gridDim.x == 256) ? ((u0 & 7) * 32 + (u0 >> 3)) : u0; scan_prompt_unit(p, l, unit, wv, lane, lw); }
    } else {
        const int nw = gridDim.x * 4;
      for (int rr = 0; rr < REP_IT; ++rr)
        for (int it = blockIdx.x * 4 + (wv - 4); it < 2048 + 4096 + 2048; it += nw) {
            if (it < 2048) scan_sample_item(p, l, it, lane, lw);
            else if (it < 6144) sgu_prompt_item(p, l, it - 2048, lane);
            else sgu_sample_item(p, l, it - 6144, lane);
        }
        if (l + 1 < DEPTH) phase_convert(p, l + 1, blockIdx.x * 4 + (wv - 4), nw);
    }
}

__device__ void phase_post(const Params& p, int l) {
    const int lane = otid() & 63, gw = blockIdx.x * 8 + (otid() >> 6), nw = gridDim.x * 8;
    const int hg = lane >> 4, kq = lane & 15;
    for (int it = gw; it < MT * 4; it += nw) {
        const int row = it >> 2, h = (it & 3) * 4 + hg, ch = h * 64 + kq * 4;
        const f32x4 y = *(const f32x4*)(P_YBUF + (size_t)row * 1024 + ch);
        const float* rc = P_REC + ((size_t)row * 16 + h) * RECF;
        const u32x2 p0 = *(const u32x2*)(rc + kq * 8), p1 = *(const u32x2*)(rc + kq * 8 + 4);
        const f32x2 va = *(const f32x2*)(rc + 128 + kq * 8 + 2), vb = *(const f32x2*)(rc + 128 + kq * 8 + 6);
        const f32x4 r4 = (f32x4){bflo(p0[0]), bfhi(p0[0]), bflo(p1[0]), bfhi(p1[0])}, k4 = (f32x4){bflo(p0[1]), bfhi(p0[1]), bflo(p1[1]), bfhi(p1[1])}, v4 = (f32x4){va[0], va[1], vb[0], vb[1]};
        const f32x4 rk = *(const f32x4*)(P_R_K + (size_t)l * 1024 + ch);
        const float mean = red16(y[0] + y[1] + y[2] + y[3]) * (1.f / 64.f);
        const f32x4 d = y - mean;
        const float var = red16(dot4(d, d)) * (1.f / 64.f);
        const float rs = rsqrtf(var + 64e-5f);
        const float srk = red16(r4[0] * k4[0] * rk[0] + r4[1] * k4[1] * rk[1] + r4[2] * k4[2] * rk[2] + r4[3] * k4[3] * rk[3]);
        const f32x4 lg = *(const f32x4*)(P_LNX_G + (size_t)l * 1024 + ch), lb = *(const f32x4*)(P_LNX_B + (size_t)l * 1024 + ch);
        const u32x2 gr = *(const u32x2*)(P_Z + (size_t)row * NP + C_GR + ch);
        const f32x4 yo = d * rs * lg + lb + srk * v4;
        u32x2 o; o[0] = pk_bf16(yo[0] * siluf_(bflo(gr[0])), yo[1] * siluf_(bfhi(gr[0]))); o[1] = pk_bf16(yo[2] * siluf_(bflo(gr[1])), yo[3] * siluf_(bfhi(gr[1])));
        *(u32x2*)(P_YAB + (size_t)row * DM + ch) = o;
    }
}


#define XB_TMO      128
#define XB_XCNT(j)  (256  + 64 * (j))
#define XB_XSUB(j)  (1280 + 64 * (j))
#define XB_XGEN(j)  (2304 + 64 * (j))
#define XB_TOP      3328
#define XB_TOPGEN   3392
#define XCD_BAR_WORDS 3456
#define XB_SPIN_CAP (1u << 20)
__device__ __forceinline__ unsigned xb_ld(unsigned* p)              { return __hip_atomic_load(p, __ATOMIC_RELAXED, __HIP_MEMORY_SCOPE_AGENT); }
__device__ __forceinline__ unsigned xb_add(unsigned* p, unsigned v) { return __hip_atomic_fetch_add(p, v, __ATOMIC_RELAXED, __HIP_MEMORY_SCOPE_AGENT); }
__device__ __forceinline__ unsigned xb_xcc_id() { return (unsigned)__builtin_amdgcn_s_getreg((3 << 11) | 20) & 0xFu; }
#define XB_SPIN(cond, bar) do { unsigned _sp = 0; while (cond) { __builtin_amdgcn_s_sleep(1); \
    if ((++_sp & 255u) == 0u) { if (xb_ld(&(bar)[XB_TMO])) break; if (_sp > XB_SPIN_CAP) { atomicAdd(&(bar)[XB_TMO], 1u); break; } } } } while (0)
struct XcdBarrier { unsigned* bar; unsigned x; volatile LAS unsigned* st; };
__device__ __forceinline__ XcdBarrier xcd_barrier_post(unsigned* bar, volatile LAS unsigned* st) {
    XcdBarrier b; b.bar = bar; b.x = xb_xcc_id(); b.st = st;
    if (threadIdx.x == 0) (void)xb_add(&bar[XB_XCNT(b.x)], 1u);
    return b;
}
__device__ __forceinline__ void xcd_barrier_complete(unsigned* bar, unsigned x, unsigned& nloc, unsigned& nx) {
    const unsigned G = gridDim.x * gridDim.y * gridDim.z;
    unsigned sum, cnt, mine, sp = 0u;
    for (;;) {
        sum = 0u; cnt = 0u; mine = 0u;
#pragma unroll
        for (unsigned j = 0; j < 16; ++j) { const unsigned c = xb_ld(&bar[XB_XCNT(j)]); sum += c; cnt += (c > 0u) ? 1u : 0u; mine = (j == x) ? c : mine; }
        if (sum == G) break;
        __builtin_amdgcn_s_sleep(1);
        if ((++sp & 255u) == 0u) { if (xb_ld(&bar[XB_TMO])) break; if (sp > XB_SPIN_CAP) { atomicAdd(&bar[XB_TMO], 1u); break; } }
    }
    nloc = mine > 0u ? mine : 1u; nx = cnt > 0u ? cnt : 1u;
}
__device__ __forceinline__ void xcd_barrier(const XcdBarrier& b) {
    asm volatile("s_waitcnt vmcnt(0)" ::: "memory");
    __syncthreads();
    if (threadIdx.x == 0) {
        unsigned* bar = b.bar;
        __builtin_amdgcn_s_waitcnt(0);
        unsigned nloc = b.st[0], nx = b.st[1];
        if (nloc == 0u) { xcd_barrier_complete(bar, b.x, nloc, nx); b.st[0] = nloc; b.st[1] = nx; }
        const unsigned old = xb_add(&bar[XB_XSUB(b.x)], 1u);
        const unsigned gen = old / nloc;
        if (old + 1u == (gen + 1u) * nloc) {
            __builtin_amdgcn_fence(__ATOMIC_RELEASE, "agent");
            asm volatile("s_waitcnt vmcnt(0)" ::: "memory");
            const unsigned og = xb_add(&bar[XB_TOP], 1u);
            const unsigned tg = og / nx;
            if (og + 1u == (tg + 1u) * nx) xb_add(&bar[XB_TOPGEN], 1u);
            else XB_SPIN(xb_ld(&bar[XB_TOPGEN]) == tg, bar);
            __builtin_amdgcn_fence(__ATOMIC_ACQUIRE, "agent");
            xb_add(&bar[XB_XGEN(b.x)], 1u);
            asm volatile("s_waitcnt vmcnt(0)" ::: "memory");
        } else {
            XB_SPIN(xb_ld(&bar[XB_XGEN(b.x)]) == gen, bar);
            __builtin_amdgcn_fence(__ATOMIC_ACQUIRE, "agent");
            asm volatile("s_waitcnt vmcnt(0)" ::: "memory");
        }
    }
    __syncthreads();
}

template <int ST> __device__ __forceinline__ void run_stage(const Params& p, int l) {
    LAS unsigned char* lds = (LAS unsigned char*)smem_raw;
    pg8::StaticOrder S;
    if (ST == 7) { { const int gw = blockIdx.x * 8 + (otid() >> 6), lane = otid() & 63;
                     if (gw < 128) { const int l2 = gw >> 5, m2 = (gw >> 4) & 1, u2 = gw & 15;
                         conv_unit((m2 ? P_A2 : P_W2) + (size_t)l2 * 64 * 1024, 64, 1024, 1024, (m2 ? P_A2T : P_W2T) + (size_t)l2 * 1024 * 64, 64, u2, lane); } }
                   phase_convert(p, 0, blockIdx.x * 8 + (otid() >> 6), gridDim.x * 8); phase_rmsnorm(P_X_PROMPT, P_X_SAMPLE, P_NORM_G, P_XN, nullptr); }
    if (ST == 0) { pg8::Gemm g{P_XN, P_WINT + (size_t)l * NP * DM, MT, NP, DM}; S.init(MT, NP, gridDim.x, blockIdx.x); EpiZ e{P_Z}; pg8::gemm_phase(lds, g, S, e); }
    if (ST == 1) phase_prep(p, l);
    if (ST == 2) phase_scan(p, l);
    if (ST == 3) phase_post(p, l);
    if (ST == 4) { pg8::Gemm g{P_YAB, P_PABT + (size_t)l * DM * DM, MT, DM, DM}; S.init(MT, DM, gridDim.x, blockIdx.x, 1); EpiMerge e{P_Z, P_M}; pg8::gemm_phase(lds, g, S, e); }
    if (ST == 5) { pg8::Gemm g{P_M, P_WOT + (size_t)l * DM * DM, MT, DM, DM}; S.init(MT, DM, gridDim.x, blockIdx.x);
                   EpiOut e{l == 0 ? P_X_PROMPT : P_H, l == 0 ? P_X_SAMPLE : P_H + (size_t)MP * DM, P_H}; pg8::gemm_phase(lds, g, S, e); }
    if (ST == 6) { if (l < DEPTH - 1) phase_rmsnorm(P_H, P_H + (size_t)MP * DM, P_NORM_G + (size_t)(l + 1) * DM, P_XN, nullptr);
                   else phase_rmsnorm(P_H, P_H + (size_t)MP * DM, P_FINAL_G, nullptr, p.out + O_YP); }
}

#if MK_SINGLE
#ifndef REP0
#define REP0 1
#endif
#ifndef REP1
#define REP1 1
#endif
#ifndef REP2
#define REP2 1
#endif
#ifndef REP3
#define REP3 1
#endif
#ifndef REP4
#define REP4 1
#endif
#ifndef REP6
#define REP6 1
#endif
#ifndef REP7
#define REP7 1
#endif
__global__ void __launch_bounds__(512, 2) mega(Params p) {
    cg::grid_group grid = cg::this_grid();
    __shared__ uint4 xb_words;
    if (threadIdx.x == 0) xb_words = make_uint4(0u, 0u, 0u, 0u);
    __syncthreads();
    const XcdBarrier xb = xcd_barrier_post((unsigned*)(p.ws + WS_BAR), (volatile LAS unsigned*)&xb_words);
#define GSYNC() xcd_barrier(xb)
    for (int r = 0; r < REP7; ++r) { run_stage<7>(p, 0); grid.sync(); }
    for (int l = 0; l < DEPTH; ++l) {
        for (int r = 0; r < REP0; ++r) { run_stage<0>(p, l); GSYNC(); }
        for (int r = 0; r < REP1; ++r) { run_stage<1>(p, l); GSYNC(); }
        for (int r = 0; r < REP2; ++r) { run_stage<2>(p, l); GSYNC(); }
        for (int r = 0; r < REP3; ++r) { run_stage<3>(p, l); GSYNC(); }
        for (int r = 0; r < REP4; ++r) { run_stage<4>(p, l); GSYNC(); }
        run_stage<5>(p, l); GSYNC();
        for (int r = 0; r < REP6; ++r) { run_stage<6>(p, l); if (l + 1 < DEPTH || r + 1 < REP6) GSYNC(); }
    }
}
#else
template <int ST> __global__ void __launch_bounds__(512, 2) stage_k(Params p, int l) { run_stage<ST>(p, l); }
#endif

template <class K> static void set_lds(K k, size_t bytes) { (void)hipFuncSetAttribute((const void*)k, hipFuncAttributeMaxDynamicSharedMemorySize, (int)bytes); }

extern "C" void kernel_launch(void* const* d_in, const int* in_sizes, int n_in, void* d_out, int out_size, void* d_ws, size_t ws_size, hipStream_t stream) {
    constexpr size_t kDynLds = 131072;
    static int grid_blocks = 0;
    if (!grid_blocks) {
        int dev = 0, cus = 0;
        (void)hipGetDevice(&dev);
        (void)hipDeviceGetAttribute(&cus, hipDeviceAttributeMultiprocessorCount, dev);
#if MK_SINGLE
        int per_cu = 0;
        set_lds(mega, kDynLds);
        (void)hipOccupancyMaxActiveBlocksPerMultiprocessor(&per_cu, mega, 512, kDynLds);
        if (per_cu < 1) fprintf(stderr, "occupancy query returned %d\n", per_cu);
#else
        set_lds(stage_k<0>, kDynLds); set_lds(stage_k<1>, kDynLds); set_lds(stage_k<2>, kDynLds); set_lds(stage_k<3>, kDynLds);
        set_lds(stage_k<4>, kDynLds); set_lds(stage_k<5>, kDynLds); set_lds(stage_k<6>, kDynLds); set_lds(stage_k<7>, kDynLds);
#endif
        grid_blocks = cus > 0 ? cus : 256;
    }
    Params p{};
    for (int i = 0; i < 24; ++i) p.in[i] = (const float*)d_in[i];
    p.out = (float*)d_out; p.ws = (char*)d_ws;
    if (ws_size < WS_END) fprintf(stderr, "workspace too small: %zu < %zu\n", ws_size, (size_t)WS_END);
#if MK_SINGLE
    (void)hipMemsetAsync(p.ws + WS_BAR, 0, (size_t)XCD_BAR_WORDS_C * 4, stream);
    void* args[] = {&p};
    hipError_t e = hipLaunchCooperativeKernel((void*)mega, dim3(grid_blocks), dim3(512), args, kDynLds, stream);
    if (e != hipSuccess) fprintf(stderr, "cooperative launch failed: %s (grid %d)\n", hipGetErrorString(e), grid_blocks);
#else
    const dim3 G(grid_blocks), B(512);
    hipLaunchKernelGGL(stage_k<7>, G, B, kDynLds, stream, p, 0);
    for (int l = 0; l < DEPTH; ++l) {
        hipLaunchKernelGGL(stage_k<0>, G, B, kDynLds, stream, p, l);
        hipLaunchKernelGGL(stage_k<1>, G, B, kDynLds, stream, p, l);
        hipLaunchKernelGGL(stage_k<2>, G, B, kDynLds, stream, p, l);
        hipLaunchKernelGGL(stage_k<3>, G, B, kDynLds, stream, p, l);
        hipLaunchKernelGGL(stage_k<4>, G, B, kDynLds, stream, p, l);
        hipLaunchKernelGGL(stage_k<5>, G, B, kDynLds, stream, p, l);
        hipLaunchKernelGGL(stage_k<6>, G, B, kDynLds, stream, p, l);
    }
#endif
}
```

```cpp
#include <hip/hip_runtime.h>
#include <hip/hip_cooperative_groups.h>
#include <cstdio>
namespace cg = cooperative_groups;

#ifndef MK_SINGLE
#define MK_SINGLE 1
#endif

#define LAS __attribute__((address_space(3)))
typedef unsigned short bf16_t;
typedef short bf16x8 __attribute__((ext_vector_type(8)));
typedef float f32x4 __attribute__((ext_vector_type(4)));
typedef float f32x2 __attribute__((ext_vector_type(2)));
typedef unsigned u32x4 __attribute__((ext_vector_type(4)));
typedef unsigned u32x2 __attribute__((ext_vector_type(2)));

constexpr int DM = 2048, DEPTH = 4;
constexpr int MP = 8192, MS = 1024, MT = 9216;
constexpr int DSH = 3200;
constexpr int NP = 11520;
constexpr int NIN = 11392;
constexpr int C_R = 0, C_K = 1024, C_V = 2048, C_WD = 3072, C_AD = 3136, C_GR = 3200, C_U = 4224, C_VG = 5248, C_GG = 6272, C_GA = 7296, C_GB = 9344;
constexpr size_t O_YP = 0, O_WKVP = 18874368, O_SHP = 19922944, O_WKVS = 19974144, O_SHS = 53528576, O_CV = 55166976;
constexpr int NPHASE = 1 + 7 * DEPTH;

constexpr int XCD_BAR_WORDS_C = 3456;
struct Params { const float* in[24]; float* out; char* ws; };
constexpr size_t al256(size_t x) { return (x + 255) & ~(size_t)255; }
constexpr size_t WS_WINT = 0;
constexpr size_t WS_PABT = WS_WINT + al256((size_t)DEPTH * NP * DM * 2);
constexpr size_t WS_WOT = WS_PABT + al256((size_t)DEPTH * DM * DM * 2);
constexpr size_t WS_XN = WS_WOT + al256((size_t)DEPTH * DM * DM * 2);
constexpr size_t WS_Z = WS_XN + al256((size_t)MT * DM * 2);
constexpr size_t WS_VNT = WS_Z + al256((size_t)MT * NP * 2);
constexpr size_t WS_VNTS = WS_VNT + al256((size_t)64 * 1024 * 128 * 2);
constexpr size_t WS_YAB = WS_VNTS + al256((size_t)128 * 1024 * 8 * 2);
constexpr size_t WS_M = WS_YAB + al256((size_t)MT * DM * 2);
constexpr size_t WS_H = WS_M + al256((size_t)MT * DM * 2);
constexpr size_t WS_REC = WS_H + al256((size_t)MT * DM * 4);
constexpr int RECF = 256;
constexpr size_t WS_YBUF = WS_REC + al256((size_t)MT * 16 * RECF * 4);
constexpr size_t WS_PART = WS_YBUF + al256((size_t)MT * 1024 * 4);
constexpr size_t WS_W2T = WS_PART + al256((size_t)2 * MS * DM * 4);
constexpr size_t WS_A2T = WS_W2T + al256((size_t)DEPTH * 1024 * 64 * 2);
constexpr size_t WS_BAR = WS_A2T + al256((size_t)DEPTH * 1024 * 64 * 2);
constexpr size_t WS_END = WS_BAR + al256((size_t)XCD_BAR_WORDS_C * 4);
#define P_X_PROMPT (p.in[0])
#define P_X_SAMPLE (p.in[1])
#define P_STATE_WKV (p.in[2])
#define P_STATE_SHIFT (p.in[3])
#define P_NORM_G (p.in[4])
#define P_W_IN (p.in[5])
#define P_SHIFT_MU (p.in[6])
#define P_W0 (p.in[7])
#define P_W2 (p.in[8])
#define P_A0 (p.in[9])
#define P_A2 (p.in[10])
#define P_K_K (p.in[11])
#define P_K_A (p.in[12])
#define P_R_K (p.in[13])
#define P_LNX_G (p.in[14])
#define P_LNX_B (p.in[15])
#define P_SGU_LN_G (p.in[16])
#define P_SGU_LN_B (p.in[17])
#define P_SGU_W (p.in[18])
#define P_SGU_B (p.in[19])
#define P_W_PROJ_A (p.in[20])
#define P_W_PROJ_B (p.in[21])
#define P_W_OUT (p.in[22])
#define P_FINAL_G (p.in[23])
#define P_WINT ((bf16_t*)(p.ws + WS_WINT))
#define P_PABT ((bf16_t*)(p.ws + WS_PABT))
#define P_WOT ((bf16_t*)(p.ws + WS_WOT))
#define P_XN ((bf16_t*)(p.ws + WS_XN))
#define P_Z ((bf16_t*)(p.ws + WS_Z))
#define P_VNT ((bf16_t*)(p.ws + WS_VNT))
#define P_VNTS ((bf16_t*)(p.ws + WS_VNTS))
#define P_YAB ((bf16_t*)(p.ws + WS_YAB))
#define P_M ((bf16_t*)(p.ws + WS_M))
#define P_H ((float*)(p.ws + WS_H))
#define P_REC ((float*)(p.ws + WS_REC))
#define P_YBUF ((float*)(p.ws + WS_YBUF))
#define P_PART ((float*)(p.ws + WS_PART))
#define P_W2T ((bf16_t*)(p.ws + WS_W2T))
#define P_A2T ((bf16_t*)(p.ws + WS_A2T))

extern __shared__ __attribute__((aligned(16))) unsigned char smem_raw[];

__device__ __forceinline__ int otid() { int t = threadIdx.x; asm volatile("" : "+v"(t)); return t; }
__device__ __forceinline__ float bf2f(bf16_t v) { return __uint_as_float(((unsigned)v) << 16); }
__device__ __forceinline__ float bflo(unsigned v) { return __uint_as_float(v << 16); }
__device__ __forceinline__ float bfhi(unsigned v) { return __uint_as_float(v & 0xffff0000u); }
__device__ __forceinline__ unsigned pk_bf16(float lo, float hi) { unsigned r; asm("v_cvt_pk_bf16_f32 %0, %1, %2" : "=v"(r) : "v"(lo), "v"(hi)); return r; }
template <int CTRL> __device__ __forceinline__ float dppf(float x) { return __int_as_float(__builtin_amdgcn_update_dpp(0, __float_as_int(x), CTRL, 0xF, 0xF, true)); }
__device__ __forceinline__ float red16(float x) { x += dppf<0xB1>(x); x += dppf<0x4E>(x); x += dppf<0x141>(x); x += dppf<0x140>(x); return x; }
__device__ __forceinline__ void red16x2(float& x, float& y) { x += dppf<0xB1>(x); y += dppf<0xB1>(y); x += dppf<0x4E>(x); y += dppf<0x4E>(y); x += dppf<0x141>(x); y += dppf<0x141>(y); x += dppf<0x140>(x); y += dppf<0x140>(y); }
__device__ __forceinline__ float red32(float x) { x = red16(x); x += __shfl_xor(x, 16); return x; }
__device__ __forceinline__ float red64(float x) { x = red16(x); x += __shfl_xor(x, 16); x += __shfl_xor(x, 32); return x; }
__device__ __forceinline__ float sigmoidf_(float x) { return __builtin_amdgcn_rcpf(1.f + __expf(-x)); }
__device__ __forceinline__ float tanhf_(float x) { const float e = __expf(2.f * fminf(fmaxf(x, -15.f), 15.f)); return 1.f - 2.f * __builtin_amdgcn_rcpf(1.f + e); }
__device__ __forceinline__ float siluf_(float x) { return x * __builtin_amdgcn_rcpf(1.f + __expf(-x)); }

namespace pg8 {
constexpr int TAILK = 2;
constexpr int BM = 256, BK = 64, HALF = 128, HTB = HALF * BK * 2, STAGE_BYTES = 8 * HTB, NXCD = 8, WGM = 8;
__device__ __forceinline__ int lds_byte(int r, int c) { const int st = (r >> 4) * 2 + (c >> 5), rr = r & 15, cc = c & 31, ob = rr * 64 + cc * 2; return st * 1024 + (ob ^ (((ob >> 9) & 1) << 5)); }
__device__ __forceinline__ void stage_rc(int b, int& R, int& C) { const int st = b / 1024, sb = b % 1024, swz = sb ^ (((sb >> 9) & 1) << 5); R = (st >> 1) * 16 + swz / 64; C = (st & 1) * 32 + (swz % 64) / 2; }
__device__ __forceinline__ int perm32(int rho) { const int n = rho >> 4, i = rho & 15; return 8 * (i >> 2) + 4 * n + (i & 3); }
struct Unit { int pm, pn, seg, nt, kofs; };
struct Gemm { const bf16_t* A; const bf16_t* Bt; int M, N, K; };
struct StaticOrder {
    int nM, nN, nwg, G, c;
    __device__ void init(int M, int N, int K, int G_, int c_, int split_ = 0, int tail_pm0_ = 0) { nM = M / BM; nN = N / BM; nwg = nM * nN; G = G_; c = c_; split = split_; ntk = K / BK; tail_pm0 = tail_pm0_; }
    int split, ntk;
    int tail_pm0;
    __device__ bool next(int i, Unit& u) const {
        if (tail_pm0 > 0) {
            const int nmain = tail_pm0 * nN; const long L = (long)i * G + c;
            if (L >= nmain) { const long sidx = L - nmain; if (sidx >= (long)(nM - tail_pm0) * nN * TAILK) return false;
                const int tt = (int)(sidx / TAILK), sl = (int)(sidx % TAILK); u.pm = tail_pm0 + tt / nN; u.pn = tt % nN; u.seg = 1 + sl; u.nt = ntk / TAILK; u.kofs = sl * (ntk / TAILK); return true; }
            int wgid = (int)L; { const int q = nmain / NXCD, r = nmain % NXCD, xcd = wgid % NXCD, off = wgid / NXCD; wgid = (xcd < r ? xcd * (q + 1) : r * (q + 1) + (xcd - r) * q) + off; }
            const int nig = WGM * nN, gid = wgid / nig, fm = gid * WGM, gsz = (tail_pm0 - fm) < WGM ? (tail_pm0 - fm) : WGM;
            u.pm = fm + ((wgid % nig) % gsz); u.pn = (wgid % nig) / gsz; u.seg = 0; u.nt = ntk; u.kofs = 0; return true;
        }
        u.seg = split ? (i & 1) : 0; if (split) i >>= 1;
        u.nt = split ? ntk / 2 : ntk; u.kofs = u.seg * u.nt;
        const long L = (long)i * G + c; if (L >= nwg) return false;
        int wgid = (int)L; { const int q = nwg / NXCD, r = nwg % NXCD, xcd = wgid % NXCD, off = wgid / NXCD; wgid = (xcd < r ? xcd * (q + 1) : r * (q + 1) + (xcd - r) * q) + off; }
        const int nig = WGM * nN, gid = wgid / nig, fm = gid * WGM, gsz = (nM - fm) < WGM ? (nM - fm) : WGM;
        u.pm = fm + ((wgid % nig) % gsz); u.pn = (wgid % nig) / gsz; return true;
    }
};

template <class Epi, class Sched>
__device__ __forceinline__ void gemm_phase(LAS unsigned char* lds, const Gemm g, const Sched& S, const Epi& E) {
    const int tid = otid(), wid = __builtin_amdgcn_readfirstlane(tid >> 6), lane = tid & 63, wr = wid >> 2, wc = wid & 3, fr = lane & 15, fq = lane >> 4;
    const int ld = g.K;
    unsigned voffA[2], voffB[2];
#pragma unroll
    for (int i = 0; i < 2; ++i) { int R, C; stage_rc(tid * 16 + i * 8192, R, C); const int Rb = Epi::PERM ? ((R & ~31) + perm32(R & 31)) : R;
        voffA[i] = (unsigned)(R * ld + C) * 2u; voffB[i] = (unsigned)(Rb * ld + C) * 2u; }
    const size_t kstep = (size_t)(BK * 2);
    const size_t hstep = (size_t)HALF * ld * 2;
    const size_t tstep = 2 * hstep;
    const unsigned ldsw = (unsigned)wid * 1024u;
    const int aoff = lds_byte(wr * 64 + fr, fq * 8), boff = lds_byte(wc * 32 + fr, fq * 8);
#define PG8_SA(b, h) (((b) * 2 + (h)) * HTB)
#define PG8_SB(b, h) ((4 + (b) * 2 + (h)) * HTB)
#define PG8_STAGE(bufoff, gbase, voff) do { _Pragma("unroll") for (int _i = 0; _i < 2; ++_i) \
        __builtin_amdgcn_global_load_lds((const unsigned*)((const char*)(gbase) + (voff)[_i]), (LAS unsigned*)(lds + (bufoff) + ldsw + _i * 8192), 16, 0, 0); } while (0)
#define PG8_LDA(dst, b, h) do { _Pragma("unroll") for (int m = 0; m < 4; ++m) _Pragma("unroll") for (int k = 0; k < 2; ++k) dst[m][k] = *(const LAS bf16x8*)(lds + PG8_SA(b, h) + aoff + m * 2048 + k * 1024); } while (0)
#define PG8_LDB(dst, b, h) do { _Pragma("unroll") for (int n = 0; n < 2; ++n) _Pragma("unroll") for (int k = 0; k < 2; ++k) dst[n][k] = *(const LAS bf16x8*)(lds + PG8_SB(b, h) + boff + n * 2048 + k * 1024); } while (0)
#define PG8_MMA(ai, bj, At, Bt) do { __builtin_amdgcn_s_setprio(1); _Pragma("unroll") for (int m = 0; m < 4; ++m) _Pragma("unroll") for (int n = 0; n < 2; ++n) _Pragma("unroll") for (int k = 0; k < 2; ++k) \
        acc[ai][bj][m][n] = __builtin_amdgcn_mfma_f32_16x16x32_bf16(Bt[n][k], At[m][k], acc[ai][bj][m][n], 0, 0, 0); __builtin_amdgcn_s_setprio(0); } while (0)
#define PG8_WAIT_V(n) asm volatile("s_waitcnt vmcnt(" #n ")" ::: "memory")
#define PG8_WAIT_L(n) asm volatile("s_waitcnt lgkmcnt(" #n ")" ::: "memory")
#define PG8_BAR __builtin_amdgcn_s_barrier()
#define PG8_SCHED __builtin_amdgcn_sched_barrier(0)
    Unit cur, nxt; int ui = 0;
    if (!S.next(0, cur)) return;
    f32x4 acc[2][2][4][2];
#pragma unroll
    for (int a = 0; a < 2; ++a)
#pragma unroll
        for (int b = 0; b < 2; ++b)
#pragma unroll
            for (int m = 0; m < 4; ++m)
#pragma unroll
                for (int n = 0; n < 2; ++n) acc[a][b][m][n] = (f32x4){0.f, 0.f, 0.f, 0.f};
    bf16x8 At[4][2], B0[2][2], B1[2][2];
    const char* cA = (const char*)g.A + (size_t)cur.pm * tstep + (size_t)cur.kofs * kstep; const char* cB = (const char*)g.Bt + (size_t)cur.pn * tstep + (size_t)cur.kofs * kstep;
    PG8_STAGE(PG8_SB(0, 0), cB, voffB); PG8_STAGE(PG8_SA(0, 0), cA, voffA); PG8_STAGE(PG8_SB(0, 1), cB + hstep, voffB); PG8_STAGE(PG8_SA(0, 1), cA + hstep, voffA);
    if (wr == 1) PG8_BAR;
    PG8_WAIT_V(4); PG8_BAR;
    PG8_STAGE(PG8_SB(1, 0), cB + kstep, voffB); PG8_STAGE(PG8_SA(1, 0), cA + kstep, voffA); PG8_STAGE(PG8_SB(1, 1), cB + hstep + kstep, voffB);
    PG8_WAIT_V(6); PG8_BAR;
    for (;;) {
        const bool has_next = S.next(ui + 1, nxt);
        const char* nA = has_next ? (const char*)g.A + (size_t)nxt.pm * tstep + (size_t)nxt.kofs * kstep : cA; const char* nB = has_next ? (const char*)g.Bt + (size_t)nxt.pn * tstep + (size_t)nxt.kofs * kstep : cB;
        const int nt = cur.nt;
        for (int t = 0; t < nt; t += 2) {
            const bool last = (t == nt - 2);
            const char* a1 = cA + (size_t)(t + 1) * kstep;
            const char* a2 = last ? nA : cA + (size_t)(t + 2) * kstep; const char* b2 = last ? nB : cB + (size_t)(t + 2) * kstep;
            const char* a3 = a2 + kstep; const char* b3 = b2 + kstep;
            PG8_LDB(B0, 0, 0); PG8_SCHED; PG8_LDA(At, 0, 0); PG8_STAGE(PG8_SA(1, 1), a1 + hstep, voffA);
            PG8_WAIT_L(8); PG8_BAR; PG8_WAIT_L(0); PG8_MMA(0, 0, At, B0); PG8_BAR; PG8_SCHED;
            PG8_LDB(B1, 0, 1); PG8_STAGE(PG8_SB(0, 0), b2, voffB);
            PG8_BAR; PG8_WAIT_L(0); PG8_MMA(0, 1, At, B1); PG8_BAR;
            PG8_LDA(At, 0, 1); PG8_STAGE(PG8_SA(0, 0), a2, voffA);
            PG8_BAR; PG8_WAIT_L(0); PG8_MMA(1, 0, At, B0); PG8_BAR; PG8_SCHED;
            PG8_STAGE(PG8_SB(0, 1), b2 + hstep, voffB);
            PG8_WAIT_V(6); PG8_BAR; PG8_MMA(1, 1, At, B1); PG8_BAR;
            PG8_LDB(B0, 1, 0); PG8_SCHED; PG8_LDA(At, 1, 0); PG8_STAGE(PG8_SA(0, 1), a2 + hstep, voffA);
            PG8_WAIT_L(8); PG8_BAR; PG8_WAIT_L(0); PG8_MMA(0, 0, At, B0); PG8_BAR; PG8_SCHED;
            PG8_LDB(B1, 1, 1); PG8_STAGE(PG8_SB(1, 0), b3, voffB);
            PG8_BAR; PG8_WAIT_L(0); PG8_MMA(0, 1, At, B1); PG8_BAR;
            PG8_LDA(At, 1, 1); PG8_STAGE(PG8_SA(1, 0), a3, voffA);
            PG8_BAR; PG8_WAIT_L(0); PG8_MMA(1, 0, At, B0); PG8_BAR; PG8_SCHED;
            PG8_STAGE(PG8_SB(1, 1), b3 + hstep, voffB);
            PG8_WAIT_V(6); PG8_BAR; PG8_MMA(1, 1, At, B1); PG8_BAR;
        }
        E(acc, cur, wr, wc, fr, fq);
        if (!has_next) break;
        if (!(Epi::SPLIT2 && cur.seg == 0))
#pragma unroll
        for (int a = 0; a < 2; ++a)
#pragma unroll
            for (int b = 0; b < 2; ++b)
#pragma unroll
                for (int m = 0; m < 4; ++m)
#pragma unroll
                    for (int n = 0; n < 2; ++n) acc[a][b][m][n] = (f32x4){0.f, 0.f, 0.f, 0.f};
        cur = nxt; cA = nA; cB = nB; ++ui;
    }
    PG8_WAIT_V(0);
    if (wr == 0) PG8_BAR;
    PG8_BAR;
#undef PG8_SA
#undef PG8_SB
#undef PG8_STAGE
#undef PG8_LDA
#undef PG8_LDB
#undef PG8_MMA
#undef PG8_WAIT_V
#undef PG8_WAIT_L
#undef PG8_BAR
#undef PG8_SCHED
}
}

struct EpiZ {
    static constexpr bool PERM = true, SPLIT2 = false;
    bf16_t* Z;
    __device__ __forceinline__ void operator()(f32x4 (&acc)[2][2][4][2], const pg8::Unit& u, int wr, int wc, int fr, int fq) const {
        const int row0 = u.pm * 256 + wr * 64 + fr, col0 = u.pn * 256 + wc * 32 + 8 * fq;
#pragma unroll
        for (int ai = 0; ai < 2; ++ai)
#pragma unroll
            for (int m = 0; m < 4; ++m) { bf16_t* rowp = Z + (size_t)(row0 + ai * 128 + m * 16) * NP + col0;
#pragma unroll
                for (int bj = 0; bj < 2; ++bj) { const f32x4 v0 = acc[ai][bj][m][0], v1 = acc[ai][bj][m][1];
                    u32x4 o; o[0] = pk_bf16(v0[0], v0[1]); o[1] = pk_bf16(v0[2], v0[3]); o[2] = pk_bf16(v1[0], v1[1]); o[3] = pk_bf16(v1[2], v1[3]);
                    *(u32x4*)(rowp + bj * 128) = o; } }
    }
};
struct EpiMerge {
    static constexpr bool PERM = true, SPLIT2 = true;
    const bf16_t* Z; bf16_t* Mo;
    __device__ __forceinline__ void mid(f32x4 (&acc)[2][2][4][2], const pg8::Unit& u, int wr, int wc, int fr, int fq) const {
        const int row0 = u.pm * 256 + wr * 64 + fr, col0 = u.pn * 256 + wc * 32 + 8 * fq;
#pragma unroll
        for (int ai = 0; ai < 2; ++ai)
#pragma unroll
            for (int m = 0; m < 4; ++m) { const bf16_t* zr = Z + (size_t)(row0 + ai * 128 + m * 16) * NP + col0;
#pragma unroll
                for (int bj = 0; bj < 2; ++bj) { const u32x4 ga = *(const u32x4*)(zr + C_GA + bj * 128), gb = *(const u32x4*)(zr + C_GB + bj * 128);
#pragma unroll
                    for (int q = 0; q < 4; ++q) { const float a0 = bflo(ga[q]), a1 = bfhi(ga[q]), b0 = bflo(gb[q]), b1 = bfhi(gb[q]);
                        const float r0 = (1.f + __expf(-b0)) * __builtin_amdgcn_rcpf(1.f + __expf(-a0)), r1 = (1.f + __expf(-b1)) * __builtin_amdgcn_rcpf(1.f + __expf(-a1));
                        acc[ai][bj][m][q >> 1][(q & 1) * 2] *= r0; acc[ai][bj][m][q >> 1][(q & 1) * 2 + 1] *= r1; } } }
    }
    __device__ __forceinline__ void fin(f32x4 (&acc)[2][2][4][2], const pg8::Unit& u, int wr, int wc, int fr, int fq) const {
        const int row0 = u.pm * 256 + wr * 64 + fr, col0 = u.pn * 256 + wc * 32 + 8 * fq;
#pragma unroll
        for (int ai = 0; ai < 2; ++ai)
#pragma unroll
            for (int m = 0; m < 4; ++m) { const size_t r = (size_t)(row0 + ai * 128 + m * 16); const bf16_t* zr = Z + r * NP + col0; bf16_t* mo = Mo + r * DM + col0;
#pragma unroll
                for (int bj = 0; bj < 2; ++bj) { const u32x4 gb = *(const u32x4*)(zr + C_GB + bj * 128); u32x4 o;
#pragma unroll
                    for (int q = 0; q < 4; ++q) { const float s0 = sigmoidf_(bflo(gb[q])), s1 = sigmoidf_(bfhi(gb[q]));
                        o[q] = pk_bf16(acc[ai][bj][m][q >> 1][(q & 1) * 2] * s0, acc[ai][bj][m][q >> 1][(q & 1) * 2 + 1] * s1); }
                    *(u32x4*)(mo + bj * 128) = o; } }
    }
    __device__ __forceinline__ void operator()(f32x4 (&acc)[2][2][4][2], const pg8::Unit& u, int wr, int wc, int fr, int fq) const {
        if (u.seg == 0) mid(acc, u, wr, wc, fr, fq); else fin(acc, u, wr, wc, fr, fq);
    }
};
struct EpiOut {
    static constexpr bool PERM = false, SPLIT2 = false;
    const float* hp; const float* hs; float* Ho; float* Part;
    __device__ __forceinline__ void operator()(f32x4 (&acc)[2][2][4][2], const pg8::Unit& u, int wr, int wc, int fr, int fq) const {
        const int row0 = u.pm * 256 + wr * 64 + fr, col0 = u.pn * 256 + wc * 32 + 4 * fq;
        if (u.seg) {
            float* pb = Part + ((size_t)(u.seg - 1) * MS + (row0 - MP)) * DM + col0;
#pragma unroll
            for (int ai = 0; ai < 2; ++ai)
#pragma unroll
                for (int m = 0; m < 4; ++m)
#pragma unroll
                    for (int bj = 0; bj < 2; ++bj)
#pragma unroll
                        for (int n = 0; n < 2; ++n) *(f32x4*)(pb + (size_t)(ai * 128 + m * 16) * DM + bj * 128 + n * 16) = acc[ai][bj][m][n];
            return;
        }
        const float* src = (u.pm < 32) ? hp + (size_t)row0 * DM : hs + (size_t)(row0 - MP) * DM;
#pragma unroll
        for (int ai = 0; ai < 2; ++ai)
#pragma unroll
            for (int m = 0; m < 4; ++m) { const size_t ro = (size_t)(ai * 128 + m * 16) * DM + col0; float* dst = Ho + (size_t)row0 * DM + ro;
#pragma unroll
                for (int bj = 0; bj < 2; ++bj)
#pragma unroll
                    for (int n = 0; n < 2; ++n) { const f32x4 o = *(const f32x4*)(src + ro + bj * 128 + n * 16) + acc[ai][bj][m][n]; *(f32x4*)(dst + bj * 128 + n * 16) = o; } }
    }
};

__device__ __forceinline__ void conv_unit(const float* __restrict__ W, int K, int N, int Npad, bf16_t* __restrict__ Wt, int ldt, int unit, int lane) {
    const int nnb = Npad >> 6; const int kb = unit / nnb, nb = unit - kb * nnb;
    const int n = nb * 64 + lane, k0 = kb * 64;
    bf16_t* dst = Wt + (size_t)n * ldt + k0;
    if (n < N) {
        const float* src = W + (size_t)k0 * N + n;
        float v[64];
#pragma unroll
        for (int j = 0; j < 64; ++j) v[j] = src[(size_t)j * N];
#pragma unroll
        for (int kk = 0; kk < 64; kk += 8) { u32x4 o; o[0] = pk_bf16(v[kk], v[kk + 1]); o[1] = pk_bf16(v[kk + 2], v[kk + 3]); o[2] = pk_bf16(v[kk + 4], v[kk + 5]); o[3] = pk_bf16(v[kk + 6], v[kk + 7]);
            *(u32x4*)(dst + kk) = o; }
    } else {
#pragma unroll
        for (int kk = 0; kk < 64; kk += 8) *(u32x4*)(dst + kk) = (u32x4){0u, 0u, 0u, 0u};
    }
}
__device__ void phase_convert(const Params& p, int l, int gw, int nw) {
    const int lane = otid() & 63;
    constexpr int U_IN = (NP / 64) * 32, U_P = 32 * 16, U_O = 32 * 32, U_L = U_IN + 2 * U_P + U_O;
    for (int u = gw; u < U_L; u += nw) {
        int r = u;
        if (r < U_IN) conv_unit(P_W_IN + (size_t)l * DM * NIN, DM, NIN, NP, P_WINT + (size_t)l * NP * DM, DM, r, lane);
        else if ((r -= U_IN) < U_P) conv_unit(P_W_PROJ_A + (size_t)l * 1024 * DM, 1024, DM, DM, P_PABT + (size_t)l * DM * DM, DM, r, lane);
        else if ((r -= U_P) < U_P) conv_unit(P_W_PROJ_B + (size_t)l * 1024 * DM, 1024, DM, DM, P_PABT + (size_t)l * DM * DM + 1024, DM, r, lane);
        else { r -= U_P; conv_unit(P_W_OUT + (size_t)l * DM * DM, DM, DM, DM, P_WOT + (size_t)l * DM * DM, DM, r, lane); }
    }
}

__device__ void phase_rmsnorm(const float* hp, const float* hs, const float* g, bf16_t* obf, float* of32, const float* part, float* hs_w) {
    const int lane = otid() & 63, gw = blockIdx.x * 8 + (otid() >> 6), nw = gridDim.x * 8;
    for (int row = gw; row < MT; row += nw) {
        const f32x4* x = (const f32x4*)(row < MP ? hp + (size_t)row * DM : hs + (size_t)(row - MP) * DM);
        f32x4 v[8]; float ss = 0.f;
#pragma unroll
        for (int i = 0; i < 8; ++i) v[i] = x[lane + 64 * i];
        if (part && row >= MP) {
#pragma unroll
            for (int sl = 0; sl < pg8::TAILK; ++sl) { const f32x4* pp = (const f32x4*)(part + ((size_t)sl * MS + (row - MP)) * DM);
#pragma unroll
                for (int i = 0; i < 8; ++i) v[i] += pp[lane + 64 * i]; }
#pragma unroll
            for (int i = 0; i < 8; ++i) ((f32x4*)(hs_w + (size_t)(row - MP) * DM))[lane + 64 * i] = v[i];
        }
#pragma unroll
        for (int i = 0; i < 8; ++i) ss += v[i][0] * v[i][0] + v[i][1] * v[i][1] + v[i][2] * v[i][2] + v[i][3] * v[i][3];
        ss = red64(ss);
        const float rstd = rsqrtf(ss * (1.f / DM) + 1e-6f);
#pragma unroll
        for (int i = 0; i < 8; ++i) { const f32x4 gg = ((const f32x4*)g)[lane + 64 * i]; const f32x4 o = v[i] * rstd * gg;
            if (obf) { u32x2 w; w[0] = pk_bf16(o[0], o[1]); w[1] = pk_bf16(o[2], o[3]); *(u32x2*)(obf + (size_t)row * DM + (lane + 64 * i) * 4) = w; }
            else *(f32x4*)(of32 + (size_t)row * DM + (lane + 64 * i) * 4) = o; }
    }
}

__device__ void phase_prep(const Params& p, int l) {
    LAS float* sm = (LAS float*)smem_raw;
    LAS bf16_t* twb = (LAS bf16_t*)sm;
    LAS bf16_t* adb = twb + 16 * 72;
    LAS float* red = sm + 1152;
    LAS float* lwla = sm + 2048;
    const int tid = otid(), lane = tid & 63, wv = tid >> 6;
    const int c = tid * 2;
    const float* mu = P_SHIFT_MU + l * DSH;
    for (int i = tid; i < 2 * 8 * 72 / 2; i += 512) { const int m_ = i / 288, r_ = i % 288; ((LAS unsigned*)(twb + m_ * 16 * 72 + 8 * 72))[r_] = 0u; }
    for (int item = blockIdx.x; item < MT / 8; item += gridDim.x) {
        const int row0 = item * 8;
        const bool samp = row0 >= MP;
        const int sb = (row0 - MP) >> 3, pb = row0 >> 11, t0 = row0 & 2047;
        const bf16_t* zr = P_Z + (size_t)row0 * NP;
        const float* sprev = P_STATE_SHIFT + (size_t)(l * 128 + (samp ? sb : 0)) * DSH;
        const bool zprev = (!samp) && (t0 == 0);
        {
            const int j = tid & 127, col = C_WD + j, tp = tid >> 7;
            const float m_ = mu[col];
#pragma unroll
            for (int tt = 0; tt < 2; ++tt) { const int t = tp * 2 + tt;
                const float cur = bf2f(zr[(size_t)t * NP + col]);
                float prv;
                if (t == 0) prv = samp ? sprev[col] : (zprev ? 0.f : bf2f(*(zr + col - NP))); else prv = bf2f(zr[(size_t)(t - 1) * NP + col]);
                const float mix = cur + (prv - cur) * m_;
                if (j < 64) twb[t * 72 + j] = (bf16_t)(pk_bf16(tanhf_(mix), 0.f) & 0xffffu); else adb[t * 72 + j - 64] = (bf16_t)(pk_bf16(mix, 0.f) & 0xffffu); }
        }
        unsigned vgw[8];
#pragma unroll
        for (int t = 0; t < 8; ++t) vgw[t] = *(const unsigned*)(zr + (size_t)t * NP + C_VG + c);
        float rm[8][2], km[8][2], vm[8][2];
#pragma unroll
        for (int sec = 0; sec < 3; ++sec) { const int col = sec * 1024 + c;
            float p0, p1;
            if (samp) { const f32x2 s2 = *(const f32x2*)(sprev + col); p0 = s2[0]; p1 = s2[1]; }
            else if (zprev) { p0 = 0.f; p1 = 0.f; }
            else { const unsigned w = *(const unsigned*)(zr + col - NP); p0 = bflo(w); p1 = bfhi(w); }
            const f32x2 m2 = *(const f32x2*)(mu + col);
#pragma unroll
            for (int t = 0; t < 8; ++t) { const unsigned w = *(const unsigned*)(zr + (size_t)t * NP + col); const float c0 = bflo(w), c1 = bfhi(w);
                const float x0 = c0 + (p0 - c0) * m2[0], x1 = c1 + (p1 - c1) * m2[1];
                if (sec == 0) { rm[t][0] = x0; rm[t][1] = x1; } else if (sec == 1) { km[t][0] = x0; km[t][1] = x1; } else { vm[t][0] = x0; vm[t][1] = x1; }
                p0 = c0; p1 = c1; } }
        __syncthreads();
        {
            const int fr = lane & 15, fq = lane >> 4;
            bf16x8 aw[2], aa[2];
#pragma unroll
            for (int ks = 0; ks < 2; ++ks) { aw[ks] = *(const LAS bf16x8*)(twb + fr * 72 + ks * 32 + fq * 8); aa[ks] = *(const LAS bf16x8*)(adb + fr * 72 + ks * 32 + fq * 8); }
            const bf16_t* w2t = P_W2T + ((size_t)l * 1024 + wv * 128 + fr) * 64 + fq * 8;
            const bf16_t* a2t = P_A2T + ((size_t)l * 1024 + wv * 128 + fr) * 64 + fq * 8;
#pragma unroll
            for (int nt = 0; nt < 8; ++nt) {
                f32x4 dw = (f32x4){0.f, 0.f, 0.f, 0.f}, da = (f32x4){0.f, 0.f, 0.f, 0.f};
#pragma unroll
                for (int ks = 0; ks < 2; ++ks) { const bf16x8 bw = *(const bf16x8*)(w2t + nt * 16 * 64 + ks * 32), ba = *(const bf16x8*)(a2t + nt * 16 * 64 + ks * 32);
                    dw = __builtin_amdgcn_mfma_f32_16x16x32_bf16(aw[ks], bw, dw, 0, 0, 0); da = __builtin_amdgcn_mfma_f32_16x16x32_bf16(aa[ks], ba, da, 0, 0, 0); }
                if (fq < 2) { const int ch = wv * 128 + nt * 16 + fr;
#pragma unroll
                    for (int r = 0; r < 4; ++r) *(LAS f32x2*)(lwla + ((fq * 4 + r) * 1024 + ch) * 2) = (f32x2){dw[r], da[r]}; }
            }
        }
        __syncthreads();
        float lw[8][2], la[8][2];
        { const f32x2 w0v = *(const f32x2*)(P_W0 + l * 1024 + c), a0v = *(const f32x2*)(P_A0 + l * 1024 + c);
#pragma unroll
          for (int t = 0; t < 8; ++t) { const f32x4 v = *(const LAS f32x4*)(lwla + (t * 1024 + c) * 2);
              lw[t][0] = w0v[0] + v[0]; la[t][0] = a0v[0] + v[1]; lw[t][1] = w0v[1] + v[2]; la[t][1] = a0v[1] + v[3]; } }
        {
            const f32x2 kkv = *(const f32x2*)(P_K_K + l * 1024 + c), kav = *(const f32x2*)(P_K_A + l * 1024 + c);
            const int hh = c >> 6, cc = c & 63;
#pragma unroll
            for (int t = 0; t < 8; ++t) {
                float dec[2], ag[2], kk[2], kp[2];
#pragma unroll
                for (int e = 0; e < 2; ++e) { const float y = -lw[t][e]; const float sp = fmaxf(y, 0.f) + __logf(1.f + __expf(-fabsf(y)));
                    const float wl = -sp - 0.5f; dec[e] = __expf(-__expf(wl)); ag[e] = sigmoidf_(la[t][e]); kk[e] = km[t][e] * kkv[e]; kp[e] = km[t][e] * (1.f + (ag[e] - 1.f) * kav[e]); }
                const float ss = red32(kk[0] * kk[0] + kk[1] * kk[1]);
                const float inv = __builtin_amdgcn_rsqf(fmaxf(ss, 1e-24f));
                float* rc = P_REC + ((size_t)(row0 + t) * 16 + hh) * RECF;
                u32x4 pkd; pkd[0] = pk_bf16(rm[t][0], rm[t][1]); pkd[1] = pk_bf16(kp[0], kp[1]); pkd[2] = pk_bf16(-kk[0] * inv, -kk[1] * inv); pkd[3] = pk_bf16(kk[0] * inv * ag[0], kk[1] * inv * ag[1]);
                *(u32x4*)(rc + (cc >> 1) * 4) = pkd;
                *(f32x4*)(rc + 128 + (cc >> 1) * 4) = (f32x4){dec[0], dec[1], vm[t][0], vm[t][1]};
            }
        }
        {
            float x[8][2];
#pragma unroll
            for (int t = 0; t < 8; ++t) { x[t][0] = bflo(vgw[t]); x[t][1] = bfhi(vgw[t]); }
#pragma unroll
            for (int t = 0; t < 8; ++t) { const float s1 = red64(x[t][0] + x[t][1]), s2 = red64(x[t][0] * x[t][0] + x[t][1] * x[t][1]);
                if (lane == 0) { red[wv * 16 + t] = s1; red[wv * 16 + 8 + t] = s2; } }
            __syncthreads();
            const f32x2 gv = *(const f32x2*)(P_SGU_LN_G + l * 1024 + c), bv = *(const f32x2*)(P_SGU_LN_B + l * 1024 + c);
            float vn[8][2];
#pragma unroll
            for (int t = 0; t < 8; ++t) { float s1 = 0.f, s2 = 0.f;
#pragma unroll
                for (int w = 0; w < 8; ++w) { s1 += red[w * 16 + t]; s2 += red[w * 16 + 8 + t]; }
                const float mean = s1 * (1.f / 1024.f), var = fmaxf(s2 * (1.f / 1024.f) - mean * mean, 0.f), rstd = rsqrtf(var + 1e-5f);
                vn[t][0] = (x[t][0] - mean) * rstd * gv[0] + bv[0]; vn[t][1] = (x[t][1] - mean) * rstd * gv[1] + bv[1]; }
#pragma unroll
            for (int e = 0; e < 2; ++e) { u32x4 o; o[0] = pk_bf16(vn[0][e], vn[1][e]); o[1] = pk_bf16(vn[2][e], vn[3][e]); o[2] = pk_bf16(vn[4][e], vn[5][e]); o[3] = pk_bf16(vn[6][e], vn[7][e]);
                if (samp) *(u32x4*)(P_VNTS + ((size_t)sb * 1024 + c + e) * 8) = o;
                else *(u32x4*)(P_VNT + (((size_t)(pb * 16 + (t0 >> 7)) * 16 + ((t0 & 127) >> 3)) * 1024 + c + e) * 8) = o; }
            if (samp) {
#pragma unroll
                for (int t = 0; t < 8; ++t) *(f32x2*)(p.out + O_CV + ((size_t)(l * 128 + sb) * 8 + t) * 1024 + c) = (f32x2){vn[t][0], vn[t][1]};
            }
        }
        if (samp) { for (int col = tid; col < DSH; col += 512) p.out[O_SHS + (size_t)(l * 128 + sb) * DSH + col] = bf2f(zr[(size_t)7 * NP + col]); }
        else if (t0 == 2040) { for (int col = tid; col < DSH; col += 512) p.out[O_SHP + (size_t)(l * 4 + pb) * DSH + col] = bf2f(zr[(size_t)7 * NP + col]); }
        __syncthreads();
    }
}

#define WAVE_SYNC() do { asm volatile("s_waitcnt lgkmcnt(0)" ::: "memory"); __builtin_amdgcn_wave_barrier(); } while (0)
__device__ __forceinline__ float dot4(const f32x4 a, const f32x4 b) { return a[0] * b[0] + a[1] * b[1] + a[2] * b[2] + a[3] * b[3]; }

__device__ void scan_prompt_unit(const Params& p, int l, int unit, int wv, int lane, LAS float* lw) {
    const int bh = unit >> 2, b = bh >> 4, h = bh & 15;
    const int rg = lane >> 4, kq = lane & 15;
    const int v0 = (unit & 3) * 16 + wv * 4 + rg;
    const float* recb = P_REC + ((size_t)(b * 2048) * 16 + h) * RECF;
    float* yb = P_YBUF + (size_t)(b * 2048) * 1024 + h * 64 + v0;
    constexpr size_t TS = 16 * RECF;
    LAS float* lv = lw + 16 * 5 * 64;
    LAS float* ly = lv + 64;
    f32x4 s = (f32x4){0.f, 0.f, 0.f, 0.f};
    u32x2 nxA[4][4], nxB[4][4]; f32x4 nwA[4], nwB[4]; float nvA, nvB;
#define SCAN_LOAD_BATCH(nx, nw, nv, tb_) do { \
        _Pragma("unroll") for (int j = 0; j < 4; ++j) { const float* rp = recb + (size_t)((tb_) + rg + 4 * j) * TS; \
            const u32x4 q0 = *(const u32x4*)(rp + kq * 8), q1 = *(const u32x4*)(rp + kq * 8 + 4);     \
            nx[j][0] = (u32x2){q0[0], q1[0]}; nx[j][1] = (u32x2){q0[1], q1[1]}; nx[j][2] = (u32x2){q0[2], q1[2]}; nx[j][3] = (u32x2){q0[3], q1[3]}; \
            const f32x2 w0 = *(const f32x2*)(rp + 128 + kq * 8), w1 = *(const f32x2*)(rp + 128 + kq * 8 + 4); nw[j] = (f32x4){w0[0], w0[1], w1[0], w1[1]}; } \
        nv = recb[(size_t)((tb_) + kq) * TS + 128 + (v0 >> 1) * 4 + 2 + (v0 & 1)]; } while (0)
#define BF4(u) ((f32x4){bflo((u)[0]), bfhi((u)[0]), bflo((u)[1]), bfhi((u)[1])})
#define SCAN_BATCH(nx, nw, nv, tb_) do { \
        WAVE_SYNC(); \
        _Pragma("unroll") for (int j = 0; j < 4; ++j) { LAS float* ls = lw + (rg + 4 * j) * 5 * 64 + kq * 4;     \
            *(LAS f32x4*)(ls) = BF4(nx[j][0]); *(LAS f32x4*)(ls + 64) = nw[j]; *(LAS f32x4*)(ls + 128) = BF4(nx[j][1]); *(LAS f32x4*)(ls + 192) = BF4(nx[j][2]); *(LAS f32x4*)(ls + 256) = BF4(nx[j][3]); } \
        lv[kq * 4 + rg] = nv; \
        WAVE_SYNC(); \
        if ((tb_) + 32 < 2048) SCAN_LOAD_BATCH(nx, nw, nv, (tb_) + 32); \
        f32x4 a4 = *(const LAS f32x4*)(lw + 3 * 64 + kq * 4); \
        float pa = dot4(s, a4), py = 0.f; \
        _Pragma("unroll") for (int q = 0; q < 16; ++q) { \
            const LAS float* lc = lw + q * 5 * 64 + kq * 4; \
            const f32x4 w4 = *(const LAS f32x4*)(lc + 64), k4 = *(const LAS f32x4*)(lc + 128), b4 = *(const LAS f32x4*)(lc + 256), r4 = *(const LAS f32x4*)(lc); \
            const float vv = lv[q * 4 + rg]; \
            f32x4 a4n = a4; \
            if (q < 15) a4n = *(const LAS f32x4*)(lc + 5 * 64 + 192); \
            if (q > 0) { red16x2(pa, py); ly[(q - 1) * 4 + rg] = py; } else pa = red16(pa); \
            s = s * w4 + vv * k4 + pa * b4; \
            py = dot4(s, r4); \
            if (q < 15) pa = dot4(s, a4n); \
            a4 = a4n; } \
        py = red16(py); ly[15 * 4 + rg] = py; \
        asm volatile("s_waitcnt lgkmcnt(0)" ::: "memory"); \
        yb[(size_t)((tb_) + kq) * 1024] = ly[kq * 4 + rg]; } while (0)
    SCAN_LOAD_BATCH(nxA, nwA, nvA, 0);
    SCAN_LOAD_BATCH(nxB, nwB, nvB, 16);
    for (int tb = 0; tb < 2048; tb += 32) {
        SCAN_BATCH(nxA, nwA, nvA, tb);
        SCAN_BATCH(nxB, nwB, nvB, tb + 16);
    }
#undef SCAN_BATCH
#undef SCAN_LOAD_BATCH
#undef BF4
    *(f32x4*)(p.out + O_WKVP + ((size_t)((l * 4 + b) * 16 + h) * 64 + v0) * 64 + kq * 4) = s;
}

__device__ void scan_sample_item(const Params& p, int l, int item, int lane, LAS float* lw) {
    const int b = item >> 4, h = item & 15;
    const int rg = lane >> 4, kq = lane & 15;
    const size_t sbase = (size_t)((l * 128 + b) * 16 + h) * 4096;
    const float* S0 = P_STATE_WKV + sbase;
    f32x4 s[16];
#pragma unroll
    for (int i = 0; i < 16; ++i) s[i] = *(const f32x4*)(S0 + (rg * 16 + i) * 64 + kq * 4);
    const float* recb = P_REC + ((size_t)(MP + b * 8) * 16 + h) * RECF;
    float nx[6];
#define SAMPLE_LOAD(rp_) do { const bf16_t* rb = (const bf16_t*)(rp_) + (lane >> 1) * 8 + (lane & 1); const float* rf = (rp_) + 128 + (lane >> 1) * 4 + (lane & 1); \
        nx[0] = bf2f(rb[0]); nx[2] = bf2f(rb[2]); nx[4] = bf2f(rb[4]); nx[5] = bf2f(rb[6]); nx[1] = rf[0]; nx[3] = rf[2]; } while (0)
    SAMPLE_LOAD(recb);
    for (int t = 0; t < 8; ++t) {
        WAVE_SYNC();
#pragma unroll
        for (int j = 0; j < 6; ++j) lw[j * 64 + lane] = nx[j];
        WAVE_SYNC();
        if (t < 7) SAMPLE_LOAD(recb + (size_t)(t + 1) * 16 * RECF);
        const f32x4 r4 = *(const LAS f32x4*)(lw + 0 * 64 + kq * 4), w4 = *(const LAS f32x4*)(lw + 1 * 64 + kq * 4), k4 = *(const LAS f32x4*)(lw + 2 * 64 + kq * 4),
                    a4 = *(const LAS f32x4*)(lw + 4 * 64 + kq * 4), b4 = *(const LAS f32x4*)(lw + 5 * 64 + kq * 4);
        float ysel = 0.f;
#pragma unroll
        for (int i4 = 0; i4 < 4; ++i4) {
            const f32x4 vv = *(const LAS f32x4*)(lw + 3 * 64 + rg * 16 + i4 * 4);
#pragma unroll
            for (int ii = 0; ii < 4; ++ii) { const int i = i4 * 4 + ii;
                const float sa = red16(dot4(s[i], a4));
                s[i] = s[i] * w4 + vv[ii] * k4 + sa * b4;
                const float y = red16(dot4(s[i], r4));
                ysel = (kq == i) ? y : ysel; }
        }
        P_YBUF[(size_t)(MP + b * 8 + t) * 1024 + h * 64 + rg * 16 + kq] = ysel;
    }
    float* So = p.out + O_WKVS + sbase;
#pragma unroll
    for (int i = 0; i < 16; ++i) *(f32x4*)(So + (rg * 16 + i) * 64 + kq * 4) = s[i];
}

__device__ void sgu_prompt_item(const Params& p, int l, int item, int lane) {
    const int slab = item & 7, g = (item >> 3) & 7, bc = item >> 6;
    const int fr = lane & 15, fq = lane >> 4;
    bf16x8 vf[4];
#pragma unroll
    for (int ks = 0; ks < 4; ++ks) vf[ks] = *(const bf16x8*)(P_VNT + (((size_t)bc * 16 + ks * 4 + fq) * 1024 + g * 128 + slab * 16 + fr) * 8);
    const float* Wg = P_SGU_W + (size_t)(l * 8 + g) * 16384;
    const float* bg = P_SGU_B + (size_t)(l * 8 + g) * 128;
    const int ch = g * 128 + slab * 16 + fq * 4;
#pragma unroll
    for (int tt = 0; tt < 8; ++tt) {
        f32x4 acc = (f32x4){0.f, 0.f, 0.f, 0.f};
        const int t = tt * 16 + fr;
#pragma unroll
        for (int ks = 0; ks <= tt / 2; ++ks) {
            const int s0 = ks * 32 + fq * 8;
            const f32x4 wa = *(const f32x4*)(Wg + t * 128 + s0), wb = *(const f32x4*)(Wg + t * 128 + s0 + 4);
            float wv[8] = {wa[0], wa[1], wa[2], wa[3], wb[0], wb[1], wb[2], wb[3]};
#pragma unroll
            for (int j = 0; j < 8; ++j) wv[j] = (s0 + j <= t) ? wv[j] : 0.f;
            u32x4 pk; pk[0] = pk_bf16(wv[0], wv[1]); pk[1] = pk_bf16(wv[2], wv[3]); pk[2] = pk_bf16(wv[4], wv[5]); pk[3] = pk_bf16(wv[6], wv[7]);
            bf16x8 wf; __builtin_memcpy(&wf, &pk, 16);
            acc = __builtin_amdgcn_mfma_f32_16x16x32_bf16(vf[ks], wf, acc, 0, 0, 0);
        }
        const size_t row = (size_t)bc * 128 + t;
        const float sbv = bg[t];
        const u32x2 uu = *(const u32x2*)(P_Z + row * NP + C_U + ch), gg = *(const u32x2*)(P_Z + row * NP + C_GG + ch);
        const float o0 = bflo(uu[0]) * (acc[0] + sbv) * siluf_(bflo(gg[0])), o1 = bfhi(uu[0]) * (acc[1] + sbv) * siluf_(bfhi(gg[0]));
        const float o2 = bflo(uu[1]) * (acc[2] + sbv) * siluf_(bflo(gg[1])), o3 = bfhi(uu[1]) * (acc[3] + sbv) * siluf_(bfhi(gg[1]));
        u32x2 o; o[0] = pk_bf16(o0, o1); o[1] = pk_bf16(o2, o3);
        *(u32x2*)(P_YAB + row * DM + 1024 + ch) = o;
    }
}

__device__ void sgu_sample_item(const Params& p, int l, int item, int lane) {
    const int b = item >> 4, ch = (item & 15) * 64 + lane, g = ch >> 7;
    const u32x4 vv = *(const u32x4*)(P_VNTS + ((size_t)b * 1024 + ch) * 8);
    float vn[8] = {bflo(vv[0]), bfhi(vv[0]), bflo(vv[1]), bfhi(vv[1]), bflo(vv[2]), bfhi(vv[2]), bflo(vv[3]), bfhi(vv[3])};
    const float* Wg = P_SGU_W + (size_t)(l * 8 + g) * 16384;
    const float* bg = P_SGU_B + (size_t)(l * 8 + g) * 128;
#pragma unroll
    for (int t = 0; t < 8; ++t) {
        float sacc = bg[t];
#pragma unroll
        for (int s = 0; s <= t; ++s) sacc += Wg[t * 128 + s] * vn[s];
        const size_t row = (size_t)MP + b * 8 + t;
        const float u = bf2f(P_Z[row * NP + C_U + ch]), gg = bf2f(P_Z[row * NP + C_GG + ch]);
        const float o = u * sacc * siluf_(gg);
        P_YAB[row * DM + 1024 + ch] = (bf16_t)(pk_bf16(o, 0.f) & 0xffffu);
    }
}

__device__ void phase_scan(const Params& p, int l) {
    const int tid = otid(), lane = tid & 63, wv = __builtin_amdgcn_readfirstlane(tid >> 6);
    LAS float* lw = (wv < 4) ? (LAS float*)smem_raw + wv * 6144 : (LAS float*)smem_raw + 24576 + (wv - 4) * 2048;
#ifndef REP_PR
#define REP_PR 1
#endif
#ifndef REP_IT
#define REP_IT 1
#endif
    if (wv < 4) {
      for (int rr = 0; rr < REP_PR; ++rr)
        for (int u0 = blockIdx.x; u0 < 256; u0 += gridDim.x) { const int unit = (gridDim.x == 256) ? ((u0 & 7) * 32 + (u0 >> 3)) : u0; scan_prompt_unit(p, l, unit, wv, lane, lw); }
    } else {
        const int nw = gridDim.x * 4;
      for (int rr = 0; rr < REP_IT; ++rr)
        for (int it = blockIdx.x * 4 + (wv - 4); it < 2048 + 4096 + 2048; it += nw) {
            if (it < 2048) scan_sample_item(p, l, it, lane, lw);
            else if (it < 6144) sgu_prompt_item(p, l, it - 2048, lane);
            else sgu_sample_item(p, l, it - 6144, lane);
        }
        if (l + 1 < DEPTH) phase_convert(p, l + 1, blockIdx.x * 4 + (wv - 4), nw);
    }
}

__device__ void phase_post(const Params& p, int l) {
    const int lane = otid() & 63, gw = blockIdx.x * 8 + (otid() >> 6), nw = gridDim.x * 8;
    const int hg = lane >> 4, kq = lane & 15;
    for (int it = gw; it < MT * 4; it += nw) {
        const int row = it >> 2, h = (it & 3) * 4 + hg, ch = h * 64 + kq * 4;
        const f32x4 y = *(const f32x4*)(P_YBUF + (size_t)row * 1024 + ch);
        const float* rc = P_REC + ((size_t)row * 16 + h) * RECF;
        const u32x2 p0 = *(const u32x2*)(rc + kq * 8), p1 = *(const u32x2*)(rc + kq * 8 + 4);
        const f32x2 va = *(const f32x2*)(rc + 128 + kq * 8 + 2), vb = *(const f32x2*)(rc + 128 + kq * 8 + 6);
        const f32x4 r4 = (f32x4){bflo(p0[0]), bfhi(p0[0]), bflo(p1[0]), bfhi(p1[0])}, k4 = (f32x4){bflo(p0[1]), bfhi(p0[1]), bflo(p1[1]), bfhi(p1[1])}, v4 = (f32x4){va[0], va[1], vb[0], vb[1]};
        const f32x4 rk = *(const f32x4*)(P_R_K + (size_t)l * 1024 + ch);
        const float mean = red16(y[0] + y[1] + y[2] + y[3]) * (1.f / 64.f);
        const f32x4 d = y - mean;
        const float var = red16(dot4(d, d)) * (1.f / 64.f);
        const float rs = rsqrtf(var + 64e-5f);
        const float srk = red16(r4[0] * k4[0] * rk[0] + r4[1] * k4[1] * rk[1] + r4[2] * k4[2] * rk[2] + r4[3] * k4[3] * rk[3]);
        const f32x4 lg = *(const f32x4*)(P_LNX_G + (size_t)l * 1024 + ch), lb = *(const f32x4*)(P_LNX_B + (size_t)l * 1024 + ch);
        const u32x2 gr = *(const u32x2*)(P_Z + (size_t)row * NP + C_GR + ch);
        const f32x4 yo = d * rs * lg + lb + srk * v4;
        u32x2 o; o[0] = pk_bf16(yo[0] * siluf_(bflo(gr[0])), yo[1] * siluf_(bfhi(gr[0]))); o[1] = pk_bf16(yo[2] * siluf_(bflo(gr[1])), yo[3] * siluf_(bfhi(gr[1])));
        *(u32x2*)(P_YAB + (size_t)row * DM + ch) = o;
    }
}


#define XB_TMO      128
#define XB_XCNT(j)  (256  + 64 * (j))
#define XB_XSUB(j)  (1280 + 64 * (j))
#define XB_XGEN(j)  (2304 + 64 * (j))
#define XB_TOP      3328
#define XB_TOPGEN   3392
#define XCD_BAR_WORDS 3456
#define XB_SPIN_CAP (1u << 20)
__device__ __forceinline__ unsigned xb_ld(unsigned* p)              { return __hip_atomic_load(p, __ATOMIC_RELAXED, __HIP_MEMORY_SCOPE_AGENT); }
__device__ __forceinline__ unsigned xb_add(unsigned* p, unsigned v) { return __hip_atomic_fetch_add(p, v, __ATOMIC_RELAXED, __HIP_MEMORY_SCOPE_AGENT); }
__device__ __forceinline__ unsigned xb_xcc_id() { return (unsigned)__builtin_amdgcn_s_getreg((3 << 11) | 20) & 0xFu; }
#define XB_SPIN(cond, bar) do { unsigned _sp = 0; while (cond) { __builtin_amdgcn_s_sleep(1); \
    if ((++_sp & 255u) == 0u) { if (xb_ld(&(bar)[XB_TMO])) break; if (_sp > XB_SPIN_CAP) { atomicAdd(&(bar)[XB_TMO], 1u); break; } } } } while (0)
struct XcdBarrier { unsigned* bar; unsigned x; volatile LAS unsigned* st; };
__device__ __forceinline__ XcdBarrier xcd_barrier_post(unsigned* bar, volatile LAS unsigned* st) {
    XcdBarrier b; b.bar = bar; b.x = xb_xcc_id(); b.st = st;
    if (threadIdx.x == 0) (void)xb_add(&bar[XB_XCNT(b.x)], 1u);
    return b;
}
__device__ __forceinline__ void xcd_barrier_complete(unsigned* bar, unsigned x, unsigned& nloc, unsigned& nx) {
    const unsigned G = gridDim.x * gridDim.y * gridDim.z;
    unsigned sum, cnt, mine, sp = 0u;
    for (;;) {
        sum = 0u; cnt = 0u; mine = 0u;
#pragma unroll
        for (unsigned j = 0; j < 16; ++j) { const unsigned c = xb_ld(&bar[XB_XCNT(j)]); sum += c; cnt += (c > 0u) ? 1u : 0u; mine = (j == x) ? c : mine; }
        if (sum == G) break;
        __builtin_amdgcn_s_sleep(1);
        if ((++sp & 255u) == 0u) { if (xb_ld(&bar[XB_TMO])) break; if (sp > XB_SPIN_CAP) { atomicAdd(&bar[XB_TMO], 1u); break; } }
    }
    nloc = mine > 0u ? mine : 1u; nx = cnt > 0u ? cnt : 1u;
}
__device__ __forceinline__ void xcd_barrier(const XcdBarrier& b) {
    asm volatile("s_waitcnt vmcnt(0)" ::: "memory");
    __syncthreads();
    if (threadIdx.x == 0) {
        unsigned* bar = b.bar;
        __builtin_amdgcn_s_waitcnt(0);
        unsigned nloc = b.st[0], nx = b.st[1];
        if (nloc == 0u) { xcd_barrier_complete(bar, b.x, nloc, nx); b.st[0] = nloc; b.st[1] = nx; }
        const unsigned old = xb_add(&bar[XB_XSUB(b.x)], 1u);
        const unsigned gen = old / nloc;
        if (old + 1u == (gen + 1u) * nloc) {
            __builtin_amdgcn_fence(__ATOMIC_RELEASE, "agent");
            asm volatile("s_waitcnt vmcnt(0)" ::: "memory");
            const unsigned og = xb_add(&bar[XB_TOP], 1u);
            const unsigned tg = og / nx;
            if (og + 1u == (tg + 1u) * nx) xb_add(&bar[XB_TOPGEN], 1u);
            else XB_SPIN(xb_ld(&bar[XB_TOPGEN]) == tg, bar);
            __builtin_amdgcn_fence(__ATOMIC_ACQUIRE, "agent");
            xb_add(&bar[XB_XGEN(b.x)], 1u);
            asm volatile("s_waitcnt vmcnt(0)" ::: "memory");
        } else {
            XB_SPIN(xb_ld(&bar[XB_XGEN(b.x)]) == gen, bar);
            __builtin_amdgcn_fence(__ATOMIC_ACQUIRE, "agent");
            asm volatile("s_waitcnt vmcnt(0)" ::: "memory");
        }
    }
    __syncthreads();
}

template <int ST> __device__ __forceinline__ void run_stage(const Params& p, int l) {
    LAS unsigned char* lds = (LAS unsigned char*)smem_raw;
    pg8::StaticOrder S;
    if (ST == 7) { { const int gw = blockIdx.x * 8 + (otid() >> 6), lane = otid() & 63;
                     if (gw < 128) { const int l2 = gw >> 5, m2 = (gw >> 4) & 1, u2 = gw & 15;
                         conv_unit((m2 ? P_A2 : P_W2) + (size_t)l2 * 64 * 1024, 64, 1024, 1024, (m2 ? P_A2T : P_W2T) + (size_t)l2 * 1024 * 64, 64, u2, lane); } }
                   { const f32x4* xs = (const f32x4*)P_X_SAMPLE; f32x4* hd = (f32x4*)(P_H + (size_t)MP * DM);
                     for (int i = blockIdx.x * 512 + otid(); i < MS * DM / 4; i += gridDim.x * 512) hd[i] = xs[i]; }
                   phase_convert(p, 0, blockIdx.x * 8 + (otid() >> 6), gridDim.x * 8); phase_rmsnorm(P_X_PROMPT, P_X_SAMPLE, P_NORM_G, P_XN, nullptr, nullptr, nullptr); }
    if (ST == 0) { pg8::Gemm g{P_XN, P_WINT + (size_t)l * NP * DM, MT, NP, DM}; S.init(MT, NP, DM, gridDim.x, blockIdx.x); EpiZ e{P_Z}; pg8::gemm_phase(lds, g, S, e); }
    if (ST == 1) phase_prep(p, l);
    if (ST == 2) phase_scan(p, l);
    if (ST == 3) phase_post(p, l);
    if (ST == 4) { pg8::Gemm g{P_YAB, P_PABT + (size_t)l * DM * DM, MT, DM, DM}; S.init(MT, DM, DM, gridDim.x, blockIdx.x, 1); EpiMerge e{P_Z, P_M}; pg8::gemm_phase(lds, g, S, e); }
    if (ST == 5) { pg8::Gemm g{P_M, P_WOT + (size_t)l * DM * DM, MT, DM, DM}; S.init(MT, DM, DM, gridDim.x, blockIdx.x, 0, MP / 256);
                   EpiOut e{l == 0 ? P_X_PROMPT : P_H, P_H + (size_t)MP * DM, P_H, P_PART}; pg8::gemm_phase(lds, g, S, e); }
    if (ST == 6) { if (l < DEPTH - 1) phase_rmsnorm(P_H, P_H + (size_t)MP * DM, P_NORM_G + (size_t)(l + 1) * DM, P_XN, nullptr, P_PART, P_H + (size_t)MP * DM);
                   else phase_rmsnorm(P_H, P_H + (size_t)MP * DM, P_FINAL_G, nullptr, p.out + O_YP, P_PART, P_H + (size_t)MP * DM); }
}

#if MK_SINGLE
#ifndef REP0
#define REP0 1
#endif
#ifndef REP1
#define REP1 1
#endif
#ifndef REP2
#define REP2 1
#endif
#ifndef REP3
#define REP3 1
#endif
#ifndef REP4
#define REP4 1
#endif
#ifndef REP6
#define REP6 1
#endif
#ifndef REP7
#define REP7 1
#endif
__global__ void __launch_bounds__(512, 2) mega(Params p) {
    cg::grid_group grid = cg::this_grid();
    __shared__ uint4 xb_words;
    if (threadIdx.x == 0) xb_words = make_uint4(0u, 0u, 0u, 0u);
    __syncthreads();
    const XcdBarrier xb = xcd_barrier_post((unsigned*)(p.ws + WS_BAR), (volatile LAS unsigned*)&xb_words);
#define GSYNC() xcd_barrier(xb)
    for (int r = 0; r < REP7; ++r) { run_stage<7>(p, 0); grid.sync(); }
    for (int l = 0; l < DEPTH; ++l) {
        for (int r = 0; r < REP0; ++r) { run_stage<0>(p, l); GSYNC(); }
        for (int r = 0; r < REP1; ++r) { run_stage<1>(p, l); GSYNC(); }
        for (int r = 0; r < REP2; ++r) { run_stage<2>(p, l); GSYNC(); }
        for (int r = 0; r < REP3; ++r) { run_stage<3>(p, l); GSYNC(); }
        for (int r = 0; r < REP4; ++r) { run_stage<4>(p, l); GSYNC(); }
        run_stage<5>(p, l); GSYNC();
        for (int r = 0; r < REP6; ++r) { run_stage<6>(p, l); if (l + 1 < DEPTH || r + 1 < REP6) GSYNC(); }
    }
}
#else
template <int ST> __global__ void __launch_bounds__(512, 2) stage_k(Params p, int l) { run_stage<ST>(p, l); }
#endif

template <class K> static void set_lds(K k, size_t bytes) { (void)hipFuncSetAttribute((const void*)k, hipFuncAttributeMaxDynamicSharedMemorySize, (int)bytes); }

extern "C" void kernel_launch(void* const* d_in, const int* in_sizes, int n_in, void* d_out, int out_size, void* d_ws, size_t ws_size, hipStream_t stream) {
    constexpr size_t kDynLds = 131072;
    static int grid_blocks = 0;
    if (!grid_blocks) {
        int dev = 0, cus = 0;
        (void)hipGetDevice(&dev);
        (void)hipDeviceGetAttribute(&cus, hipDeviceAttributeMultiprocessorCount, dev);
#if MK_SINGLE
        int per_cu = 0;
        set_lds(mega, kDynLds);
        (void)hipOccupancyMaxActiveBlocksPerMultiprocessor(&per_cu, mega, 512, kDynLds);
        if (per_cu < 1) fprintf(stderr, "occupancy query returned %d\n", per_cu);
#else
        set_lds(stage_k<0>, kDynLds); set_lds(stage_k<1>, kDynLds); set_lds(stage_k<2>, kDynLds); set_lds(stage_k<3>, kDynLds);
        set_lds(stage_k<4>, kDynLds); set_lds(stage_k<5>, kDynLds); set_lds(stage_k<6>, kDynLds); set_lds(stage_k<7>, kDynLds);
#endif
        grid_blocks = cus > 0 ? cus : 256;
    }
    Params p{};
    for (int i = 0; i < 24; ++i) p.in[i] = (const float*)d_in[i];
    p.out = (float*)d_out; p.ws = (char*)d_ws;
    if (ws_size < WS_END) fprintf(stderr, "workspace too small: %zu < %zu\n", ws_size, (size_t)WS_END);
#if MK_SINGLE
    (void)hipMemsetAsync(p.ws + WS_BAR, 0, (size_t)XCD_BAR_WORDS_C * 4, stream);
    void* args[] = {&p};
    hipError_t e = hipLaunchCooperativeKernel((void*)mega, dim3(grid_blocks), dim3(512), args, kDynLds, stream);
    if (e != hipSuccess) fprintf(stderr, "cooperative launch failed: %s (grid %d)\n", hipGetErrorString(e), grid_blocks);
#else
    const dim3 G(grid_blocks), B(512);
    hipLaunchKernelGGL(stage_k<7>, G, B, kDynLds, stream, p, 0);
    for (int l = 0; l < DEPTH; ++l) {
        hipLaunchKernelGGL(stage_k<0>, G, B, kDynLds, stream, p, l);
        hipLaunchKernelGGL(stage_k<1>, G, B, kDynLds, stream, p, l);
        hipLaunchKernelGGL(stage_k<2>, G, B, kDynLds, stream, p, l);
        hipLaunchKernelGGL(stage_k<3>, G, B, kDynLds, stream, p, l);
        hipLaunchKernelGGL(stage_k<4>, G, B, kDynLds, stream, p, l);
        hipLaunchKernelGGL(stage_k<5>, G, B, kDynLds, stream, p, l);
        hipLaunchKernelGGL(stage_k<6>, G, B, kDynLds, stream, p, l);
    }
#endif
}
```

```cpp
#include <hip/hip_runtime.h>
#include <hip/hip_cooperative_groups.h>
#include <cstdio>
namespace cg = cooperative_groups;

#ifndef MK_SINGLE
#define MK_SINGLE 1
#endif

#define LAS __attribute__((address_space(3)))
typedef unsigned short bf16_t;
typedef short bf16x8 __attribute__((ext_vector_type(8)));
typedef float f32x4 __attribute__((ext_vector_type(4)));
typedef float f32x2 __attribute__((ext_vector_type(2)));
typedef unsigned u32x4 __attribute__((ext_vector_type(4)));
typedef unsigned u32x2 __attribute__((ext_vector_type(2)));

constexpr int DM = 2048, DEPTH = 4;
constexpr int MP = 8192, MS = 1024, MT = 9216;
constexpr int DSH = 3200;
constexpr int NP = 11520;
constexpr int NIN = 11392;
constexpr int C_R = 0, C_K = 1024, C_V = 2048, C_WD = 3072, C_AD = 3136, C_GR = 3200, C_U = 4224, C_VG = 5248, C_GG = 6272, C_GA = 7296, C_GB = 9344;
constexpr size_t O_YP = 0, O_WKVP = 18874368, O_SHP = 19922944, O_WKVS = 19974144, O_SHS = 53528576, O_CV = 55166976;
constexpr int NPHASE = 1 + 7 * DEPTH;

constexpr int XCD_BAR_WORDS_C = 3456 + 256;
struct Params { const float* in[24]; float* out; char* ws; };
constexpr size_t al256(size_t x) { return (x + 255) & ~(size_t)255; }
constexpr size_t WS_WINT = 0;
constexpr size_t WS_PABT = WS_WINT + al256((size_t)DEPTH * NP * DM * 2);
constexpr size_t WS_WOT = WS_PABT + al256((size_t)DEPTH * DM * DM * 2);
constexpr size_t WS_XN = WS_WOT + al256((size_t)DEPTH * DM * DM * 2);
constexpr size_t WS_Z = WS_XN + al256((size_t)MT * DM * 2);
constexpr size_t WS_VNT = WS_Z + al256((size_t)MT * NP * 2);
constexpr size_t WS_VNTS = WS_VNT + al256((size_t)64 * 1024 * 128 * 2);
constexpr size_t WS_YAB = WS_VNTS + al256((size_t)128 * 1024 * 8 * 2);
constexpr size_t WS_M = WS_YAB + al256((size_t)MT * DM * 2);
constexpr size_t WS_H = WS_M + al256((size_t)MT * DM * 2);
constexpr size_t WS_REC = WS_H + al256((size_t)MT * DM * 4);
constexpr int RECF = 256;
constexpr size_t WS_YBUF = WS_REC + al256((size_t)MT * 16 * RECF * 4);
constexpr size_t WS_PART = WS_YBUF + al256((size_t)MT * 1024 * 4);
constexpr size_t WS_W2T = WS_PART + al256((size_t)2 * MS * DM * 4);
constexpr size_t WS_A2T = WS_W2T + al256((size_t)DEPTH * 1024 * 64 * 2);
constexpr size_t WS_BAR = WS_A2T + al256((size_t)DEPTH * 1024 * 64 * 2);
constexpr size_t WS_END = WS_BAR + al256((size_t)XCD_BAR_WORDS_C * 4);
#define P_X_PROMPT (p.in[0])
#define P_X_SAMPLE (p.in[1])
#define P_STATE_WKV (p.in[2])
#define P_STATE_SHIFT (p.in[3])
#define P_NORM_G (p.in[4])
#define P_W_IN (p.in[5])
#define P_SHIFT_MU (p.in[6])
#define P_W0 (p.in[7])
#define P_W2 (p.in[8])
#define P_A0 (p.in[9])
#define P_A2 (p.in[10])
#define P_K_K (p.in[11])
#define P_K_A (p.in[12])
#define P_R_K (p.in[13])
#define P_LNX_G (p.in[14])
#define P_LNX_B (p.in[15])
#define P_SGU_LN_G (p.in[16])
#define P_SGU_LN_B (p.in[17])
#define P_SGU_W (p.in[18])
#define P_SGU_B (p.in[19])
#define P_W_PROJ_A (p.in[20])
#define P_W_PROJ_B (p.in[21])
#define P_W_OUT (p.in[22])
#define P_FINAL_G (p.in[23])
#define P_WINT ((bf16_t*)(p.ws + WS_WINT))
#define P_PABT ((bf16_t*)(p.ws + WS_PABT))
#define P_WOT ((bf16_t*)(p.ws + WS_WOT))
#define P_XN ((bf16_t*)(p.ws + WS_XN))
#define P_Z ((bf16_t*)(p.ws + WS_Z))
#define P_VNT ((bf16_t*)(p.ws + WS_VNT))
#define P_VNTS ((bf16_t*)(p.ws + WS_VNTS))
#define P_YAB ((bf16_t*)(p.ws + WS_YAB))
#define P_M ((bf16_t*)(p.ws + WS_M))
#define P_H ((float*)(p.ws + WS_H))
#define P_REC ((float*)(p.ws + WS_REC))
#define P_YBUF ((float*)(p.ws + WS_YBUF))
#define P_PART ((float*)(p.ws + WS_PART))
#define P_W2T ((bf16_t*)(p.ws + WS_W2T))
#define P_A2T ((bf16_t*)(p.ws + WS_A2T))

extern __shared__ __attribute__((aligned(16))) unsigned char smem_raw[];

__device__ __forceinline__ int otid() { int t = threadIdx.x; asm volatile("" : "+v"(t)); return t; }
__device__ __forceinline__ float bf2f(bf16_t v) { return __uint_as_float(((unsigned)v) << 16); }
__device__ __forceinline__ float bflo(unsigned v) { return __uint_as_float(v << 16); }
__device__ __forceinline__ float bfhi(unsigned v) { return __uint_as_float(v & 0xffff0000u); }
__device__ __forceinline__ unsigned pk_bf16(float lo, float hi) { unsigned r; asm("v_cvt_pk_bf16_f32 %0, %1, %2" : "=v"(r) : "v"(lo), "v"(hi)); return r; }
template <int CTRL> __device__ __forceinline__ float dppf(float x) { return __int_as_float(__builtin_amdgcn_update_dpp(0, __float_as_int(x), CTRL, 0xF, 0xF, true)); }
__device__ __forceinline__ float red16(float x) { x += dppf<0xB1>(x); x += dppf<0x4E>(x); x += dppf<0x141>(x); x += dppf<0x140>(x); return x; }
__device__ __forceinline__ void red16x2(float& x, float& y) { x += dppf<0xB1>(x); y += dppf<0xB1>(y); x += dppf<0x4E>(x); y += dppf<0x4E>(y); x += dppf<0x141>(x); y += dppf<0x141>(y); x += dppf<0x140>(x); y += dppf<0x140>(y); }
__device__ __forceinline__ float red32(float x) { x = red16(x); x += __shfl_xor(x, 16); return x; }
__device__ __forceinline__ float red64(float x) { x = red16(x); x += __shfl_xor(x, 16); x += __shfl_xor(x, 32); return x; }
__device__ __forceinline__ float sigmoidf_(float x) { return __builtin_amdgcn_rcpf(1.f + __expf(-x)); }
__device__ __forceinline__ float tanhf_(float x) { const float e = __expf(2.f * fminf(fmaxf(x, -15.f), 15.f)); return 1.f - 2.f * __builtin_amdgcn_rcpf(1.f + e); }
__device__ __forceinline__ float siluf_(float x) { return x * __builtin_amdgcn_rcpf(1.f + __expf(-x)); }

namespace pg8 {
constexpr int TAILK = 2;
constexpr int BM = 256, BK = 64, HALF = 128, HTB = HALF * BK * 2, STAGE_BYTES = 8 * HTB, NXCD = 8, WGM = 8;
__device__ __forceinline__ int lds_byte(int r, int c) { const int st = (r >> 4) * 2 + (c >> 5), rr = r & 15, cc = c & 31, ob = rr * 64 + cc * 2; return st * 1024 + (ob ^ (((ob >> 9) & 1) << 5)); }
__device__ __forceinline__ void stage_rc(int b, int& R, int& C) { const int st = b / 1024, sb = b % 1024, swz = sb ^ (((sb >> 9) & 1) << 5); R = (st >> 1) * 16 + swz / 64; C = (st & 1) * 32 + (swz % 64) / 2; }
__device__ __forceinline__ int perm32(int rho) { const int n = rho >> 4, i = rho & 15; return 8 * (i >> 2) + 4 * n + (i & 3); }
struct Unit { int pm, pn, seg, nt, kofs; };
struct Gemm { const bf16_t* A; const bf16_t* Bt; int M, N, K; };
struct StaticOrder {
    int nM, nN, nwg, G, c;
    __device__ void init(int M, int N, int K, int G_, int c_, int split_ = 0, int tail_pm0_ = 0) { nM = M / BM; nN = N / BM; nwg = nM * nN; G = G_; c = c_; split = split_; ntk = K / BK; tail_pm0 = tail_pm0_; }
    int split, ntk;
    int tail_pm0;
    __device__ bool next(int i, Unit& u) const {
        if (tail_pm0 > 0) {
            const int nmain = tail_pm0 * nN; const long L = (long)i * G + c;
            if (L >= nmain) { const long sidx = L - nmain; if (sidx >= (long)(nM - tail_pm0) * nN * TAILK) return false;
                const int tt = (int)(sidx / TAILK), sl = (int)(sidx % TAILK); u.pm = tail_pm0 + tt / nN; u.pn = tt % nN; u.seg = 1 + sl; u.nt = ntk / TAILK; u.kofs = sl * (ntk / TAILK); return true; }
            int wgid = (int)L; { const int q = nmain / NXCD, r = nmain % NXCD, xcd = wgid % NXCD, off = wgid / NXCD; wgid = (xcd < r ? xcd * (q + 1) : r * (q + 1) + (xcd - r) * q) + off; }
            const int nig = WGM * nN, gid = wgid / nig, fm = gid * WGM, gsz = (tail_pm0 - fm) < WGM ? (tail_pm0 - fm) : WGM;
            u.pm = fm + ((wgid % nig) % gsz); u.pn = (wgid % nig) / gsz; u.seg = 0; u.nt = ntk; u.kofs = 0; return true;
        }
        u.seg = split ? (i & 1) : 0; if (split) i >>= 1;
        u.nt = split ? ntk / 2 : ntk; u.kofs = u.seg * u.nt;
        const long L = (long)i * G + c; if (L >= nwg) return false;
        int wgid = (int)L; { const int q = nwg / NXCD, r = nwg % NXCD, xcd = wgid % NXCD, off = wgid / NXCD; wgid = (xcd < r ? xcd * (q + 1) : r * (q + 1) + (xcd - r) * q) + off; }
        const int nig = WGM * nN, gid = wgid / nig, fm = gid * WGM, gsz = (nM - fm) < WGM ? (nM - fm) : WGM;
        u.pm = fm + ((wgid % nig) % gsz); u.pn = (wgid % nig) / gsz; return true;
    }
};

template <class Epi, class Sched>
__device__ __forceinline__ void gemm_phase(LAS unsigned char* lds, const Gemm g, const Sched& S, const Epi& E) {
    const int tid = otid(), wid = __builtin_amdgcn_readfirstlane(tid >> 6), lane = tid & 63, wr = wid >> 2, wc = wid & 3, fr = lane & 15, fq = lane >> 4;
    const int ld = g.K;
    unsigned voffA[2], voffB[2];
#pragma unroll
    for (int i = 0; i < 2; ++i) { int R, C; stage_rc(tid * 16 + i * 8192, R, C); const int Rb = Epi::PERM ? ((R & ~31) + perm32(R & 31)) : R;
        voffA[i] = (unsigned)(R * ld + C) * 2u; voffB[i] = (unsigned)(Rb * ld + C) * 2u; }
    const size_t kstep = (size_t)(BK * 2);
    const size_t hstep = (size_t)HALF * ld * 2;
    const size_t tstep = 2 * hstep;
    const unsigned ldsw = (unsigned)wid * 1024u;
    const int aoff = lds_byte(wr * 64 + fr, fq * 8), boff = lds_byte(wc * 32 + fr, fq * 8);
#define PG8_SA(b, h) (((b) * 2 + (h)) * HTB)
#define PG8_SB(b, h) ((4 + (b) * 2 + (h)) * HTB)
#define PG8_STAGE(bufoff, gbase, voff) do { _Pragma("unroll") for (int _i = 0; _i < 2; ++_i) \
        __builtin_amdgcn_global_load_lds((const unsigned*)((const char*)(gbase) + (voff)[_i]), (LAS unsigned*)(lds + (bufoff) + ldsw + _i * 8192), 16, 0, 0); } while (0)
#define PG8_LDA(dst, b, h) do { _Pragma("unroll") for (int m = 0; m < 4; ++m) _Pragma("unroll") for (int k = 0; k < 2; ++k) dst[m][k] = *(const LAS bf16x8*)(lds + PG8_SA(b, h) + aoff + m * 2048 + k * 1024); } while (0)
#define PG8_LDB(dst, b, h) do { _Pragma("unroll") for (int n = 0; n < 2; ++n) _Pragma("unroll") for (int k = 0; k < 2; ++k) dst[n][k] = *(const LAS bf16x8*)(lds + PG8_SB(b, h) + boff + n * 2048 + k * 1024); } while (0)
#define PG8_MMA(ai, bj, At, Bt) do { __builtin_amdgcn_s_setprio(1); _Pragma("unroll") for (int m = 0; m < 4; ++m) _Pragma("unroll") for (int n = 0; n < 2; ++n) _Pragma("unroll") for (int k = 0; k < 2; ++k) \
        acc[ai][bj][m][n] = __builtin_amdgcn_mfma_f32_16x16x32_bf16(Bt[n][k], At[m][k], acc[ai][bj][m][n], 0, 0, 0); __builtin_amdgcn_s_setprio(0); } while (0)
#define PG8_WAIT_V(n) asm volatile("s_waitcnt vmcnt(" #n ")" ::: "memory")
#define PG8_WAIT_L(n) asm volatile("s_waitcnt lgkmcnt(" #n ")" ::: "memory")
#define PG8_BAR __builtin_amdgcn_s_barrier()
#define PG8_SCHED __builtin_amdgcn_sched_barrier(0)
    Unit cur, nxt; int ui = 0;
    if (!S.next(0, cur)) return;
    f32x4 acc[2][2][4][2];
#pragma unroll
    for (int a = 0; a < 2; ++a)
#pragma unroll
        for (int b = 0; b < 2; ++b)
#pragma unroll
            for (int m = 0; m < 4; ++m)
#pragma unroll
                for (int n = 0; n < 2; ++n) acc[a][b][m][n] = (f32x4){0.f, 0.f, 0.f, 0.f};
    bf16x8 At[4][2], B0[2][2], B1[2][2];
    const char* cA = (const char*)g.A + (size_t)cur.pm * tstep + (size_t)cur.kofs * kstep; const char* cB = (const char*)g.Bt + (size_t)cur.pn * tstep + (size_t)cur.kofs * kstep;
    PG8_STAGE(PG8_SB(0, 0), cB, voffB); PG8_STAGE(PG8_SA(0, 0), cA, voffA); PG8_STAGE(PG8_SB(0, 1), cB + hstep, voffB); PG8_STAGE(PG8_SA(0, 1), cA + hstep, voffA);
    if (wr == 1) PG8_BAR;
    PG8_WAIT_V(4); PG8_BAR;
    PG8_STAGE(PG8_SB(1, 0), cB + kstep, voffB); PG8_STAGE(PG8_SA(1, 0), cA + kstep, voffA); PG8_STAGE(PG8_SB(1, 1), cB + hstep + kstep, voffB);
    PG8_WAIT_V(6); PG8_BAR;
    for (;;) {
        const bool has_next = S.next(ui + 1, nxt);
        const char* nA = has_next ? (const char*)g.A + (size_t)nxt.pm * tstep + (size_t)nxt.kofs * kstep : cA; const char* nB = has_next ? (const char*)g.Bt + (size_t)nxt.pn * tstep + (size_t)nxt.kofs * kstep : cB;
        const int nt = cur.nt;
        for (int t = 0; t < nt; t += 2) {
            const bool last = (t == nt - 2);
            const char* a1 = cA + (size_t)(t + 1) * kstep;
            const char* a2 = last ? nA : cA + (size_t)(t + 2) * kstep; const char* b2 = last ? nB : cB + (size_t)(t + 2) * kstep;
            const char* a3 = a2 + kstep; const char* b3 = b2 + kstep;
            PG8_LDB(B0, 0, 0); PG8_SCHED; PG8_LDA(At, 0, 0); PG8_STAGE(PG8_SA(1, 1), a1 + hstep, voffA);
            PG8_WAIT_L(8); PG8_BAR; PG8_WAIT_L(0); PG8_MMA(0, 0, At, B0); PG8_BAR; PG8_SCHED;
            PG8_LDB(B1, 0, 1); PG8_STAGE(PG8_SB(0, 0), b2, voffB);
            PG8_BAR; PG8_WAIT_L(0); PG8_MMA(0, 1, At, B1); PG8_BAR;
            PG8_LDA(At, 0, 1); PG8_STAGE(PG8_SA(0, 0), a2, voffA);
            PG8_BAR; PG8_WAIT_L(0); PG8_MMA(1, 0, At, B0); PG8_BAR; PG8_SCHED;
            PG8_STAGE(PG8_SB(0, 1), b2 + hstep, voffB);
            PG8_WAIT_V(6); PG8_BAR; PG8_MMA(1, 1, At, B1); PG8_BAR;
            PG8_LDB(B0, 1, 0); PG8_SCHED; PG8_LDA(At, 1, 0); PG8_STAGE(PG8_SA(0, 1), a2 + hstep, voffA);
            PG8_WAIT_L(8); PG8_BAR; PG8_WAIT_L(0); PG8_MMA(0, 0, At, B0); PG8_BAR; PG8_SCHED;
            PG8_LDB(B1, 1, 1); PG8_STAGE(PG8_SB(1, 0), b3, voffB);
            PG8_BAR; PG8_WAIT_L(0); PG8_MMA(0, 1, At, B1); PG8_BAR;
            PG8_LDA(At, 1, 1); PG8_STAGE(PG8_SA(1, 0), a3, voffA);
            PG8_BAR; PG8_WAIT_L(0); PG8_MMA(1, 0, At, B0); PG8_BAR; PG8_SCHED;
            PG8_STAGE(PG8_SB(1, 1), b3 + hstep, voffB);
            PG8_WAIT_V(6); PG8_BAR; PG8_MMA(1, 1, At, B1); PG8_BAR;
        }
        E(acc, cur, wr, wc, fr, fq);
        if (!has_next) break;
        if (!(Epi::SPLIT2 && cur.seg == 0))
#pragma unroll
        for (int a = 0; a < 2; ++a)
#pragma unroll
            for (int b = 0; b < 2; ++b)
#pragma unroll
                for (int m = 0; m < 4; ++m)
#pragma unroll
                    for (int n = 0; n < 2; ++n) acc[a][b][m][n] = (f32x4){0.f, 0.f, 0.f, 0.f};
        cur = nxt; cA = nA; cB = nB; ++ui;
    }
    PG8_WAIT_V(0);
    if (wr == 0) PG8_BAR;
    PG8_BAR;
#undef PG8_SA
#undef PG8_SB
#undef PG8_STAGE
#undef PG8_LDA
#undef PG8_LDB
#undef PG8_MMA
#undef PG8_WAIT_V
#undef PG8_WAIT_L
#undef PG8_BAR
#undef PG8_SCHED
}
}

struct EpiZ {
    static constexpr bool PERM = true, SPLIT2 = false;
    bf16_t* Z;
    __device__ __forceinline__ void operator()(f32x4 (&acc)[2][2][4][2], const pg8::Unit& u, int wr, int wc, int fr, int fq) const {
        const int row0 = u.pm * 256 + wr * 64 + fr, col0 = u.pn * 256 + wc * 32 + 8 * fq;
#pragma unroll
        for (int ai = 0; ai < 2; ++ai)
#pragma unroll
            for (int m = 0; m < 4; ++m) { bf16_t* rowp = Z + (size_t)(row0 + ai * 128 + m * 16) * NP + col0;
#pragma unroll
                for (int bj = 0; bj < 2; ++bj) { const f32x4 v0 = acc[ai][bj][m][0], v1 = acc[ai][bj][m][1];
                    u32x4 o; o[0] = pk_bf16(v0[0], v0[1]); o[1] = pk_bf16(v0[2], v0[3]); o[2] = pk_bf16(v1[0], v1[1]); o[3] = pk_bf16(v1[2], v1[3]);
                    *(u32x4*)(rowp + bj * 128) = o; } }
    }
};
struct EpiMerge {
    static constexpr bool PERM = true, SPLIT2 = true;
    const bf16_t* Z; bf16_t* Mo;
    __device__ __forceinline__ void mid(f32x4 (&acc)[2][2][4][2], const pg8::Unit& u, int wr, int wc, int fr, int fq) const {
        const int row0 = u.pm * 256 + wr * 64 + fr, col0 = u.pn * 256 + wc * 32 + 8 * fq;
#pragma unroll
        for (int ai = 0; ai < 2; ++ai)
#pragma unroll
            for (int m = 0; m < 4; ++m) { const bf16_t* zr = Z + (size_t)(row0 + ai * 128 + m * 16) * NP + col0;
#pragma unroll
                for (int bj = 0; bj < 2; ++bj) { const u32x4 ga = *(const u32x4*)(zr + C_GA + bj * 128), gb = *(const u32x4*)(zr + C_GB + bj * 128);
#pragma unroll
                    for (int q = 0; q < 4; ++q) { const float a0 = bflo(ga[q]), a1 = bfhi(ga[q]), b0 = bflo(gb[q]), b1 = bfhi(gb[q]);
                        const float r0 = (1.f + __expf(-b0)) * __builtin_amdgcn_rcpf(1.f + __expf(-a0)), r1 = (1.f + __expf(-b1)) * __builtin_amdgcn_rcpf(1.f + __expf(-a1));
                        acc[ai][bj][m][q >> 1][(q & 1) * 2] *= r0; acc[ai][bj][m][q >> 1][(q & 1) * 2 + 1] *= r1; } } }
    }
    __device__ __forceinline__ void fin(f32x4 (&acc)[2][2][4][2], const pg8::Unit& u, int wr, int wc, int fr, int fq) const {
        const int row0 = u.pm * 256 + wr * 64 + fr, col0 = u.pn * 256 + wc * 32 + 8 * fq;
#pragma unroll
        for (int ai = 0; ai < 2; ++ai)
#pragma unroll
            for (int m = 0; m < 4; ++m) { const size_t r = (size_t)(row0 + ai * 128 + m * 16); const bf16_t* zr = Z + r * NP + col0; bf16_t* mo = Mo + r * DM + col0;
#pragma unroll
                for (int bj = 0; bj < 2; ++bj) { const u32x4 gb = *(const u32x4*)(zr + C_GB + bj * 128); u32x4 o;
#pragma unroll
                    for (int q = 0; q < 4; ++q) { const float s0 = sigmoidf_(bflo(gb[q])), s1 = sigmoidf_(bfhi(gb[q]));
                        o[q] = pk_bf16(acc[ai][bj][m][q >> 1][(q & 1) * 2] * s0, acc[ai][bj][m][q >> 1][(q & 1) * 2 + 1] * s1); }
                    *(u32x4*)(mo + bj * 128) = o; } }
    }
    __device__ __forceinline__ void operator()(f32x4 (&acc)[2][2][4][2], const pg8::Unit& u, int wr, int wc, int fr, int fq) const {
        if (u.seg == 0) mid(acc, u, wr, wc, fr, fq); else fin(acc, u, wr, wc, fr, fq);
    }
};
struct EpiOut {
    static constexpr bool PERM = false, SPLIT2 = false;
    const float* hp; const float* hs; float* Ho; float* Part;
    __device__ __forceinline__ void operator()(f32x4 (&acc)[2][2][4][2], const pg8::Unit& u, int wr, int wc, int fr, int fq) const {
        const int row0 = u.pm * 256 + wr * 64 + fr, col0 = u.pn * 256 + wc * 32 + 4 * fq;
        if (u.seg) {
            float* pb = Part + ((size_t)(u.seg - 1) * MS + (row0 - MP)) * DM + col0;
#pragma unroll
            for (int ai = 0; ai < 2; ++ai)
#pragma unroll
                for (int m = 0; m < 4; ++m)
#pragma unroll
                    for (int bj = 0; bj < 2; ++bj)
#pragma unroll
                        for (int n = 0; n < 2; ++n) *(f32x4*)(pb + (size_t)(ai * 128 + m * 16) * DM + bj * 128 + n * 16) = acc[ai][bj][m][n];
            return;
        }
        const float* src = (u.pm < 32) ? hp + (size_t)row0 * DM : hs + (size_t)(row0 - MP) * DM;
#pragma unroll
        for (int ai = 0; ai < 2; ++ai)
#pragma unroll
            for (int m = 0; m < 4; ++m) { const size_t ro = (size_t)(ai * 128 + m * 16) * DM + col0; float* dst = Ho + (size_t)row0 * DM + ro;
#pragma unroll
                for (int bj = 0; bj < 2; ++bj)
#pragma unroll
                    for (int n = 0; n < 2; ++n) { const f32x4 o = *(const f32x4*)(src + ro + bj * 128 + n * 16) + acc[ai][bj][m][n]; *(f32x4*)(dst + bj * 128 + n * 16) = o; } }
    }
};

__device__ __forceinline__ void conv_unit(const float* __restrict__ W, int K, int N, int Npad, bf16_t* __restrict__ Wt, int ldt, int unit, int lane) {
    const int nnb = Npad >> 6; const int kb = unit / nnb, nb = unit - kb * nnb;
    const int n = nb * 64 + lane, k0 = kb * 64;
    bf16_t* dst = Wt + (size_t)n * ldt + k0;
    if (n < N) {
        const float* src = W + (size_t)k0 * N + n;
        float v[64];
#pragma unroll
        for (int j = 0; j < 64; ++j) v[j] = src[(size_t)j * N];
#pragma unroll
        for (int kk = 0; kk < 64; kk += 8) { u32x4 o; o[0] = pk_bf16(v[kk], v[kk + 1]); o[1] = pk_bf16(v[kk + 2], v[kk + 3]); o[2] = pk_bf16(v[kk + 4], v[kk + 5]); o[3] = pk_bf16(v[kk + 6], v[kk + 7]);
            *(u32x4*)(dst + kk) = o; }
    } else {
#pragma unroll
        for (int kk = 0; kk < 64; kk += 8) *(u32x4*)(dst + kk) = (u32x4){0u, 0u, 0u, 0u};
    }
}
__device__ void phase_convert(const Params& p, int l, int gw, int nw) {
    const int lane = otid() & 63;
    constexpr int U_IN = (NP / 64) * 32, U_P = 32 * 16, U_O = 32 * 32, U_L = U_IN + 2 * U_P + U_O;
    for (int u = gw; u < U_L; u += nw) {
        int r = u;
        if (r < U_IN) conv_unit(P_W_IN + (size_t)l * DM * NIN, DM, NIN, NP, P_WINT + (size_t)l * NP * DM, DM, r, lane);
        else if ((r -= U_IN) < U_P) conv_unit(P_W_PROJ_A + (size_t)l * 1024 * DM, 1024, DM, DM, P_PABT + (size_t)l * DM * DM, DM, r, lane);
        else if ((r -= U_P) < U_P) conv_unit(P_W_PROJ_B + (size_t)l * 1024 * DM, 1024, DM, DM, P_PABT + (size_t)l * DM * DM + 1024, DM, r, lane);
        else { r -= U_P; conv_unit(P_W_OUT + (size_t)l * DM * DM, DM, DM, DM, P_WOT + (size_t)l * DM * DM, DM, r, lane); }
    }
}

__device__ void phase_rmsnorm(const float* hp, const float* hs, const float* g, bf16_t* obf, float* of32, const float* part, float* hs_w) {
    const int lane = otid() & 63, gw = blockIdx.x * 8 + (otid() >> 6), nw = gridDim.x * 8;
    for (int row = gw; row < MT; row += nw) {
        const f32x4* x = (const f32x4*)(row < MP ? hp + (size_t)row * DM : hs + (size_t)(row - MP) * DM);
        f32x4 v[8]; float ss = 0.f;
#pragma unroll
        for (int i = 0; i < 8; ++i) v[i] = x[lane + 64 * i];
        if (part && row >= MP) {
#pragma unroll
            for (int sl = 0; sl < pg8::TAILK; ++sl) { const f32x4* pp = (const f32x4*)(part + ((size_t)sl * MS + (row - MP)) * DM);
#pragma unroll
                for (int i = 0; i < 8; ++i) v[i] += pp[lane + 64 * i]; }
#pragma unroll
            for (int i = 0; i < 8; ++i) ((f32x4*)(hs_w + (size_t)(row - MP) * DM))[lane + 64 * i] = v[i];
        }
#pragma unroll
        for (int i = 0; i < 8; ++i) ss += v[i][0] * v[i][0] + v[i][1] * v[i][1] + v[i][2] * v[i][2] + v[i][3] * v[i][3];
        ss = red64(ss);
        const float rstd = rsqrtf(ss * (1.f / DM) + 1e-6f);
#pragma unroll
        for (int i = 0; i < 8; ++i) { const f32x4 gg = ((const f32x4*)g)[lane + 64 * i]; const f32x4 o = v[i] * rstd * gg;
            if (obf) { u32x2 w; w[0] = pk_bf16(o[0], o[1]); w[1] = pk_bf16(o[2], o[3]); *(u32x2*)(obf + (size_t)row * DM + (lane + 64 * i) * 4) = w; }
            else *(f32x4*)(of32 + (size_t)row * DM + (lane + 64 * i) * 4) = o; }
    }
}

__device__ void phase_prep(const Params& p, int l) {
    LAS float* sm = (LAS float*)smem_raw;
    LAS bf16_t* twb = (LAS bf16_t*)sm;
    LAS bf16_t* adb = twb + 16 * 72;
    LAS float* red = sm + 1152;
    LAS float* lwla = sm + 2048;
    const int tid = otid(), lane = tid & 63, wv = tid >> 6;
    const int c = tid * 2;
    const float* mu = P_SHIFT_MU + l * DSH;
    for (int i = tid; i < 2 * 8 * 72 / 2; i += 512) { const int m_ = i / 288, r_ = i % 288; ((LAS unsigned*)(twb + m_ * 16 * 72 + 8 * 72))[r_] = 0u; }
    unsigned* qhead = (unsigned*)(p.ws + WS_BAR) + 3456 + 64 * l;
    LAS int* qslot = (LAS int*)(sm + 1300);
    for (;;) {
        if (tid == 0) *qslot = (int)__hip_atomic_fetch_add(qhead, 1u, __ATOMIC_RELAXED, __HIP_MEMORY_SCOPE_AGENT);
        __syncthreads();
        const int qi = *qslot;
        if (qi >= MT / 8) break;
        const int item = qi < MS / 8 ? MP / 8 + qi : qi - MS / 8;
        const int row0 = item * 8;
        const bool samp = row0 >= MP;
        const int sb = (row0 - MP) >> 3, pb = row0 >> 11, t0 = row0 & 2047;
        const bf16_t* zr = P_Z + (size_t)row0 * NP;
        const float* sprev = P_STATE_SHIFT + (size_t)(l * 128 + (samp ? sb : 0)) * DSH;
        const bool zprev = (!samp) && (t0 == 0);
        {
            const int j = tid & 127, col = C_WD + j, tp = tid >> 7;
            const float m_ = mu[col];
#pragma unroll
            for (int tt = 0; tt < 2; ++tt) { const int t = tp * 2 + tt;
                const float cur = bf2f(zr[(size_t)t * NP + col]);
                float prv;
                if (t == 0) prv = samp ? sprev[col] : (zprev ? 0.f : bf2f(*(zr + col - NP))); else prv = bf2f(zr[(size_t)(t - 1) * NP + col]);
                const float mix = cur + (prv - cur) * m_;
                if (j < 64) twb[t * 72 + j] = (bf16_t)(pk_bf16(tanhf_(mix), 0.f) & 0xffffu); else adb[t * 72 + j - 64] = (bf16_t)(pk_bf16(mix, 0.f) & 0xffffu); }
        }
        unsigned vgw[8];
#pragma unroll
        for (int t = 0; t < 8; ++t) vgw[t] = *(const unsigned*)(zr + (size_t)t * NP + C_VG + c);
        float rm[8][2], km[8][2], vm[8][2];
#pragma unroll
        for (int sec = 0; sec < 3; ++sec) { const int col = sec * 1024 + c;
            float p0, p1;
            if (samp) { const f32x2 s2 = *(const f32x2*)(sprev + col); p0 = s2[0]; p1 = s2[1]; }
            else if (zprev) { p0 = 0.f; p1 = 0.f; }
            else { const unsigned w = *(const unsigned*)(zr + col - NP); p0 = bflo(w); p1 = bfhi(w); }
            const f32x2 m2 = *(const f32x2*)(mu + col);
#pragma unroll
            for (int t = 0; t < 8; ++t) { const unsigned w = *(const unsigned*)(zr + (size_t)t * NP + col); const float c0 = bflo(w), c1 = bfhi(w);
                const float x0 = c0 + (p0 - c0) * m2[0], x1 = c1 + (p1 - c1) * m2[1];
                if (sec == 0) { rm[t][0] = x0; rm[t][1] = x1; } else if (sec == 1) { km[t][0] = x0; km[t][1] = x1; } else { vm[t][0] = x0; vm[t][1] = x1; }
                p0 = c0; p1 = c1; } }
        __syncthreads();
        {
            const int fr = lane & 15, fq = lane >> 4;
            bf16x8 aw[2], aa[2];
#pragma unroll
            for (int ks = 0; ks < 2; ++ks) { aw[ks] = *(const LAS bf16x8*)(twb + fr * 72 + ks * 32 + fq * 8); aa[ks] = *(const LAS bf16x8*)(adb + fr * 72 + ks * 32 + fq * 8); }
            const bf16_t* w2t = P_W2T + ((size_t)l * 1024 + wv * 128 + fr) * 64 + fq * 8;
            const bf16_t* a2t = P_A2T + ((size_t)l * 1024 + wv * 128 + fr) * 64 + fq * 8;
#pragma unroll
            for (int nt = 0; nt < 8; ++nt) {
                f32x4 dw = (f32x4){0.f, 0.f, 0.f, 0.f}, da = (f32x4){0.f, 0.f, 0.f, 0.f};
#pragma unroll
                for (int ks = 0; ks < 2; ++ks) { const bf16x8 bw = *(const bf16x8*)(w2t + nt * 16 * 64 + ks * 32), ba = *(const bf16x8*)(a2t + nt * 16 * 64 + ks * 32);
                    dw = __builtin_amdgcn_mfma_f32_16x16x32_bf16(aw[ks], bw, dw, 0, 0, 0); da = __builtin_amdgcn_mfma_f32_16x16x32_bf16(aa[ks], ba, da, 0, 0, 0); }
                if (fq < 2) { const int ch = wv * 128 + nt * 16 + fr;
#pragma unroll
                    for (int r = 0; r < 4; ++r) *(LAS f32x2*)(lwla + ((fq * 4 + r) * 1024 + ch) * 2) = (f32x2){dw[r], da[r]}; }
            }
        }
        __syncthreads();
        float lw[8][2], la[8][2];
        { const f32x2 w0v = *(const f32x2*)(P_W0 + l * 1024 + c), a0v = *(const f32x2*)(P_A0 + l * 1024 + c);
#pragma unroll
          for (int t = 0; t < 8; ++t) { const f32x4 v = *(const LAS f32x4*)(lwla + (t * 1024 + c) * 2);
              lw[t][0] = w0v[0] + v[0]; la[t][0] = a0v[0] + v[1]; lw[t][1] = w0v[1] + v[2]; la[t][1] = a0v[1] + v[3]; } }
        {
            const f32x2 kkv = *(const f32x2*)(P_K_K + l * 1024 + c), kav = *(const f32x2*)(P_K_A + l * 1024 + c);
            const int hh = c >> 6, cc = c & 63;
#pragma unroll
            for (int t = 0; t < 8; ++t) {
                float dec[2], ag[2], kk[2], kp[2];
#pragma unroll
                for (int e = 0; e < 2; ++e) { const float y = -lw[t][e]; const float sp = fmaxf(y, 0.f) + __logf(1.f + __expf(-fabsf(y)));
                    const float wl = -sp - 0.5f; dec[e] = __expf(-__expf(wl)); ag[e] = sigmoidf_(la[t][e]); kk[e] = km[t][e] * kkv[e]; kp[e] = km[t][e] * (1.f + (ag[e] - 1.f) * kav[e]); }
                const float ss = red32(kk[0] * kk[0] + kk[1] * kk[1]);
                const float inv = __builtin_amdgcn_rsqf(fmaxf(ss, 1e-24f));
                float* rc = P_REC + ((size_t)(row0 + t) * 16 + hh) * RECF;
                u32x4 pkd; pkd[0] = pk_bf16(rm[t][0], rm[t][1]); pkd[1] = pk_bf16(kp[0], kp[1]); pkd[2] = pk_bf16(-kk[0] * inv, -kk[1] * inv); pkd[3] = pk_bf16(kk[0] * inv * ag[0], kk[1] * inv * ag[1]);
                *(u32x4*)(rc + (cc >> 1) * 4) = pkd;
                *(f32x4*)(rc + 128 + (cc >> 1) * 4) = (f32x4){dec[0], dec[1], vm[t][0], vm[t][1]};
            }
        }
        {
            float x[8][2];
#pragma unroll
            for (int t = 0; t < 8; ++t) { x[t][0] = bflo(vgw[t]); x[t][1] = bfhi(vgw[t]); }
#pragma unroll
            for (int t = 0; t < 8; ++t) { const float s1 = red64(x[t][0] + x[t][1]), s2 = red64(x[t][0] * x[t][0] + x[t][1] * x[t][1]);
                if (lane == 0) { red[wv * 16 + t] = s1; red[wv * 16 + 8 + t] = s2; } }
            __syncthreads();
            const f32x2 gv = *(const f32x2*)(P_SGU_LN_G + l * 1024 + c), bv = *(const f32x2*)(P_SGU_LN_B + l * 1024 + c);
            float vn[8][2];
#pragma unroll
            for (int t = 0; t < 8; ++t) { float s1 = 0.f, s2 = 0.f;
#pragma unroll
                for (int w = 0; w < 8; ++w) { s1 += red[w * 16 + t]; s2 += red[w * 16 + 8 + t]; }
                const float mean = s1 * (1.f / 1024.f), var = fmaxf(s2 * (1.f / 1024.f) - mean * mean, 0.f), rstd = rsqrtf(var + 1e-5f);
                vn[t][0] = (x[t][0] - mean) * rstd * gv[0] + bv[0]; vn[t][1] = (x[t][1] - mean) * rstd * gv[1] + bv[1]; }
#pragma unroll
            for (int e = 0; e < 2; ++e) { u32x4 o; o[0] = pk_bf16(vn[0][e], vn[1][e]); o[1] = pk_bf16(vn[2][e], vn[3][e]); o[2] = pk_bf16(vn[4][e], vn[5][e]); o[3] = pk_bf16(vn[6][e], vn[7][e]);
                if (samp) *(u32x4*)(P_VNTS + ((size_t)sb * 1024 + c + e) * 8) = o;
                else *(u32x4*)(P_VNT + (((size_t)(pb * 16 + (t0 >> 7)) * 16 + ((t0 & 127) >> 3)) * 1024 + c + e) * 8) = o; }
            if (samp) {
#pragma unroll
                for (int t = 0; t < 8; ++t) *(f32x2*)(p.out + O_CV + ((size_t)(l * 128 + sb) * 8 + t) * 1024 + c) = (f32x2){vn[t][0], vn[t][1]};
            }
        }
        if (samp) { for (int col = tid; col < DSH; col += 512) p.out[O_SHS + (size_t)(l * 128 + sb) * DSH + col] = bf2f(zr[(size_t)7 * NP + col]); }
        else if (t0 == 2040) { for (int col = tid; col < DSH; col += 512) p.out[O_SHP + (size_t)(l * 4 + pb) * DSH + col] = bf2f(zr[(size_t)7 * NP + col]); }
        __syncthreads();
    }
}

#define WAVE_SYNC() do { asm volatile("s_waitcnt lgkmcnt(0)" ::: "memory"); __builtin_amdgcn_wave_barrier(); } while (0)
__device__ __forceinline__ float dot4(const f32x4 a, const f32x4 b) { return a[0] * b[0] + a[1] * b[1] + a[2] * b[2] + a[3] * b[3]; }

__device__ void scan_prompt_unit(const Params& p, int l, int unit, int wv, int lane, LAS float* lw) {
    const int bh = unit >> 2, b = bh >> 4, h = bh & 15;
    const int rg = lane >> 4, kq = lane & 15;
    const int v0 = (unit & 3) * 16 + wv * 4 + rg;
    const float* recb = P_REC + ((size_t)(b * 2048) * 16 + h) * RECF;
    float* yb = P_YBUF + (size_t)(b * 2048) * 1024 + h * 64 + v0;
    constexpr size_t TS = 16 * RECF;
    LAS float* lv = lw + 16 * 5 * 64;
    LAS float* ly = lv + 64;
    f32x4 s = (f32x4){0.f, 0.f, 0.f, 0.f};
    u32x2 nxA[4][4], nxB[4][4]; f32x4 nwA[4], nwB[4]; float nvA, nvB;
#define SCAN_LOAD_BATCH(nx, nw, nv, tb_) do { \
        _Pragma("unroll") for (int j = 0; j < 4; ++j) { const float* rp = recb + (size_t)((tb_) + rg + 4 * j) * TS; \
            const u32x4 q0 = *(const u32x4*)(rp + kq * 8), q1 = *(const u32x4*)(rp + kq * 8 + 4);     \
            nx[j][0] = (u32x2){q0[0], q1[0]}; nx[j][1] = (u32x2){q0[1], q1[1]}; nx[j][2] = (u32x2){q0[2], q1[2]}; nx[j][3] = (u32x2){q0[3], q1[3]}; \
            const f32x2 w0 = *(const f32x2*)(rp + 128 + kq * 8), w1 = *(const f32x2*)(rp + 128 + kq * 8 + 4); nw[j] = (f32x4){w0[0], w0[1], w1[0], w1[1]}; } \
        nv = recb[(size_t)((tb_) + kq) * TS + 128 + (v0 >> 1) * 4 + 2 + (v0 & 1)]; } while (0)
#define BF4(u) ((f32x4){bflo((u)[0]), bfhi((u)[0]), bflo((u)[1]), bfhi((u)[1])})
#define SCAN_BATCH(nx, nw, nv, tb_) do { \
        WAVE_SYNC(); \
        _Pragma("unroll") for (int j = 0; j < 4; ++j) { LAS float* ls = lw + (rg + 4 * j) * 5 * 64 + kq * 4;     \
            *(LAS f32x4*)(ls) = BF4(nx[j][0]); *(LAS f32x4*)(ls + 64) = nw[j]; *(LAS f32x4*)(ls + 128) = BF4(nx[j][1]); *(LAS f32x4*)(ls + 192) = BF4(nx[j][2]); *(LAS f32x4*)(ls + 256) = BF4(nx[j][3]); } \
        lv[kq * 4 + rg] = nv; \
        WAVE_SYNC(); \
        if ((tb_) + 32 < 2048) SCAN_LOAD_BATCH(nx, nw, nv, (tb_) + 32); \
        f32x4 a4 = *(const LAS f32x4*)(lw + 3 * 64 + kq * 4); \
        float pa = dot4(s, a4), py = 0.f; \
        _Pragma("unroll") for (int q = 0; q < 16; ++q) { \
            const LAS float* lc = lw + q * 5 * 64 + kq * 4; \
            const f32x4 w4 = *(const LAS f32x4*)(lc + 64), k4 = *(const LAS f32x4*)(lc + 128), b4 = *(const LAS f32x4*)(lc + 256), r4 = *(const LAS f32x4*)(lc); \
            const float vv = lv[q * 4 + rg]; \
            f32x4 a4n = a4; \
            if (q < 15) a4n = *(const LAS f32x4*)(lc + 5 * 64 + 192); \
            if (q > 0) { red16x2(pa, py); ly[(q - 1) * 4 + rg] = py; } else pa = red16(pa); \
            s = s * w4 + vv * k4 + pa * b4; \
            py = dot4(s, r4); \
            if (q < 15) pa = dot4(s, a4n); \
            a4 = a4n; } \
        py = red16(py); ly[15 * 4 + rg] = py; \
        asm volatile("s_waitcnt lgkmcnt(0)" ::: "memory"); \
        yb[(size_t)((tb_) + kq) * 1024] = ly[kq * 4 + rg]; } while (0)
    SCAN_LOAD_BATCH(nxA, nwA, nvA, 0);
    SCAN_LOAD_BATCH(nxB, nwB, nvB, 16);
    for (int tb = 0; tb < 2048; tb += 32) {
        SCAN_BATCH(nxA, nwA, nvA, tb);
        SCAN_BATCH(nxB, nwB, nvB, tb + 16);
    }
#undef SCAN_BATCH
#undef SCAN_LOAD_BATCH
#undef BF4
    *(f32x4*)(p.out + O_WKVP + ((size_t)((l * 4 + b) * 16 + h) * 64 + v0) * 64 + kq * 4) = s;
}

__device__ void scan_sample_item(const Params& p, int l, int item, int lane, LAS float* lw) {
    const int b = item >> 4, h = item & 15;
    const int rg = lane >> 4, kq = lane & 15;
    const size_t sbase = (size_t)((l * 128 + b) * 16 + h) * 4096;
    const float* S0 = P_STATE_WKV + sbase;
    f32x4 s[16];
#pragma unroll
    for (int i = 0; i < 16; ++i) s[i] = *(const f32x4*)(S0 + (rg * 16 + i) * 64 + kq * 4);
    const float* recb = P_REC + ((size_t)(MP + b * 8) * 16 + h) * RECF;
    float nx[6];
#define SAMPLE_LOAD(rp_) do { const bf16_t* rb = (const bf16_t*)(rp_) + (lane >> 1) * 8 + (lane & 1); const float* rf = (rp_) + 128 + (lane >> 1) * 4 + (lane & 1); \
        nx[0] = bf2f(rb[0]); nx[2] = bf2f(rb[2]); nx[4] = bf2f(rb[4]); nx[5] = bf2f(rb[6]); nx[1] = rf[0]; nx[3] = rf[2]; } while (0)
    SAMPLE_LOAD(recb);
    for (int t = 0; t < 8; ++t) {
        WAVE_SYNC();
#pragma unroll
        for (int j = 0; j < 6; ++j) lw[j * 64 + lane] = nx[j];
        WAVE_SYNC();
        if (t < 7) SAMPLE_LOAD(recb + (size_t)(t + 1) * 16 * RECF);
        const f32x4 r4 = *(const LAS f32x4*)(lw + 0 * 64 + kq * 4), w4 = *(const LAS f32x4*)(lw + 1 * 64 + kq * 4), k4 = *(const LAS f32x4*)(lw + 2 * 64 + kq * 4),
                    a4 = *(const LAS f32x4*)(lw + 4 * 64 + kq * 4), b4 = *(const LAS f32x4*)(lw + 5 * 64 + kq * 4);
        float ysel = 0.f;
#pragma unroll
        for (int i4 = 0; i4 < 4; ++i4) {
            const f32x4 vv = *(const LAS f32x4*)(lw + 3 * 64 + rg * 16 + i4 * 4);
#pragma unroll
            for (int ii = 0; ii < 4; ++ii) { const int i = i4 * 4 + ii;
                const float sa = red16(dot4(s[i], a4));
                s[i] = s[i] * w4 + vv[ii] * k4 + sa * b4;
                const float y = red16(dot4(s[i], r4));
                ysel = (kq == i) ? y : ysel; }
        }
        P_YBUF[(size_t)(MP + b * 8 + t) * 1024 + h * 64 + rg * 16 + kq] = ysel;
    }
    float* So = p.out + O_WKVS + sbase;
#pragma unroll
    for (int i = 0; i < 16; ++i) *(f32x4*)(So + (rg * 16 + i) * 64 + kq * 4) = s[i];
}

__device__ void sgu_prompt_item(const Params& p, int l, int item, int lane) {
    const int slab = item & 7, g = (item >> 3) & 7, bc = item >> 6;
    const int fr = lane & 15, fq = lane >> 4;
    bf16x8 vf[4];
#pragma unroll
    for (int ks = 0; ks < 4; ++ks) vf[ks] = *(const bf16x8*)(P_VNT + (((size_t)bc * 16 + ks * 4 + fq) * 1024 + g * 128 + slab * 16 + fr) * 8);
    const float* Wg = P_SGU_W + (size_t)(l * 8 + g) * 16384;
    const float* bg = P_SGU_B + (size_t)(l * 8 + g) * 128;
    const int ch = g * 128 + slab * 16 + fq * 4;
#pragma unroll
    for (int tt = 0; tt < 8; ++tt) {
        f32x4 acc = (f32x4){0.f, 0.f, 0.f, 0.f};
        const int t = tt * 16 + fr;
#pragma unroll
        for (int ks = 0; ks <= tt / 2; ++ks) {
            const int s0 = ks * 32 + fq * 8;
            const f32x4 wa = *(const f32x4*)(Wg + t * 128 + s0), wb = *(const f32x4*)(Wg + t * 128 + s0 + 4);
            float wv[8] = {wa[0], wa[1], wa[2], wa[3], wb[0], wb[1], wb[2], wb[3]};
#pragma unroll
            for (int j = 0; j < 8; ++j) wv[j] = (s0 + j <= t) ? wv[j] : 0.f;
            u32x4 pk; pk[0] = pk_bf16(wv[0], wv[1]); pk[1] = pk_bf16(wv[2], wv[3]); pk[2] = pk_bf16(wv[4], wv[5]); pk[3] = pk_bf16(wv[6], wv[7]);
            bf16x8 wf; __builtin_memcpy(&wf, &pk, 16);
            acc = __builtin_amdgcn_mfma_f32_16x16x32_bf16(vf[ks], wf, acc, 0, 0, 0);
        }
        const size_t row = (size_t)bc * 128 + t;
        const float sbv = bg[t];
        const u32x2 uu = *(const u32x2*)(P_Z + row * NP + C_U + ch), gg = *(const u32x2*)(P_Z + row * NP + C_GG + ch);
        const float o0 = bflo(uu[0]) * (acc[0] + sbv) * siluf_(bflo(gg[0])), o1 = bfhi(uu[0]) * (acc[1] + sbv) * siluf_(bfhi(gg[0]));
        const float o2 = bflo(uu[1]) * (acc[2] + sbv) * siluf_(bflo(gg[1])), o3 = bfhi(uu[1]) * (acc[3] + sbv) * siluf_(bfhi(gg[1]));
        u32x2 o; o[0] = pk_bf16(o0, o1); o[1] = pk_bf16(o2, o3);
        *(u32x2*)(P_YAB + row * DM + 1024 + ch) = o;
    }
}

__device__ void sgu_sample_item(const Params& p, int l, int item, int lane) {
    const int b = item >> 4, ch = (item & 15) * 64 + lane, g = ch >> 7;
    const u32x4 vv = *(const u32x4*)(P_VNTS + ((size_t)b * 1024 + ch) * 8);
    float vn[8] = {bflo(vv[0]), bfhi(vv[0]), bflo(vv[1]), bfhi(vv[1]), bflo(vv[2]), bfhi(vv[2]), bflo(vv[3]), bfhi(vv[3])};
    const float* Wg = P_SGU_W + (size_t)(l * 8 + g) * 16384;
    const float* bg = P_SGU_B + (size_t)(l * 8 + g) * 128;
#pragma unroll
    for (int t = 0; t < 8; ++t) {
        float sacc = bg[t];
#pragma unroll
        for (int s = 0; s <= t; ++s) sacc += Wg[t * 128 + s] * vn[s];
        const size_t row = (size_t)MP + b * 8 + t;
        const float u = bf2f(P_Z[row * NP + C_U + ch]), gg = bf2f(P_Z[row * NP + C_GG + ch]);
        const float o = u * sacc * siluf_(gg);
        P_YAB[row * DM + 1024 + ch] = (bf16_t)(pk_bf16(o, 0.f) & 0xffffu);
    }
}

__device__ void phase_scan(const Params& p, int l) {
    const int tid = otid(), lane = tid & 63, wv = __builtin_amdgcn_readfirstlane(tid >> 6);
    LAS float* lw = (wv < 4) ? (LAS float*)smem_raw + wv * 6144 : (LAS float*)smem_raw + 24576 + (wv - 4) * 2048;
#ifndef REP_PR
#define REP_PR 1
#endif
#ifndef REP_IT
#define REP_IT 1
#endif
    if (wv < 4) {
      for (int rr = 0; rr < REP_PR; ++rr)
        for (int u0 = blockIdx.x; u0 < 256; u0 += gridDim.x) { const int unit = (gridDim.x == 256) ? ((u0 & 7) * 32 + (u0 >> 3)) : u0; scan_prompt_unit(p, l, unit, wv, lane, lw); }
    } else {
        const int nw = gridDim.x * 4;
      for (int rr = 0; rr < REP_IT; ++rr)
        for (int it = blockIdx.x * 4 + (wv - 4); it < 2048 + 4096 + 2048; it += nw) {
            if (it < 2048) scan_sample_item(p, l, it, lane, lw);
            else if (it < 6144) sgu_prompt_item(p, l, it - 2048, lane);
            else sgu_sample_item(p, l, it - 6144, lane);
        }
        if (l + 1 < DEPTH) phase_convert(p, l + 1, blockIdx.x * 4 + (wv - 4), nw);
    }
}

__device__ void phase_post(const Params& p, int l) {
    const int lane = otid() & 63, gw = blockIdx.x * 8 + (otid() >> 6), nw = gridDim.x * 8;
    const int hg = lane >> 4, kq = lane & 15;
    for (int it = gw; it < MT * 4; it += nw) {
        const int row = it >> 2, h = (it & 3) * 4 + hg, ch = h * 64 + kq * 4;
        const f32x4 y = *(const f32x4*)(P_YBUF + (size_t)row * 1024 + ch);
        const float* rc = P_REC + ((size_t)row * 16 + h) * RECF;
        const u32x2 p0 = *(const u32x2*)(rc + kq * 8), p1 = *(const u32x2*)(rc + kq * 8 + 4);
        const f32x2 va = *(const f32x2*)(rc + 128 + kq * 8 + 2), vb = *(const f32x2*)(rc + 128 + kq * 8 + 6);
        const f32x4 r4 = (f32x4){bflo(p0[0]), bfhi(p0[0]), bflo(p1[0]), bfhi(p1[0])}, k4 = (f32x4){bflo(p0[1]), bfhi(p0[1]), bflo(p1[1]), bfhi(p1[1])}, v4 = (f32x4){va[0], va[1], vb[0], vb[1]};
        const f32x4 rk = *(const f32x4*)(P_R_K + (size_t)l * 1024 + ch);
        const float mean = red16(y[0] + y[1] + y[2] + y[3]) * (1.f / 64.f);
        const f32x4 d = y - mean;
        const float var = red16(dot4(d, d)) * (1.f / 64.f);
        const float rs = rsqrtf(var + 64e-5f);
        const float srk = red16(r4[0] * k4[0] * rk[0] + r4[1] * k4[1] * rk[1] + r4[2] * k4[2] * rk[2] + r4[3] * k4[3] * rk[3]);
        const f32x4 lg = *(const f32x4*)(P_LNX_G + (size_t)l * 1024 + ch), lb = *(const f32x4*)(P_LNX_B + (size_t)l * 1024 + ch);
        const u32x2 gr = *(const u32x2*)(P_Z + (size_t)row * NP + C_GR + ch);
        const f32x4 yo = d * rs * lg + lb + srk * v4;
        u32x2 o; o[0] = pk_bf16(yo[0] * siluf_(bflo(gr[0])), yo[1] * siluf_(bfhi(gr[0]))); o[1] = pk_bf16(yo[2] * siluf_(bflo(gr[1])), yo[3] * siluf_(bfhi(gr[1])));
        *(u32x2*)(P_YAB + (size_t)row * DM + ch) = o;
    }
}


#define XB_TMO      128
#define XB_XCNT(j)  (256  + 64 * (j))
#define XB_XSUB(j)  (1280 + 64 * (j))
#define XB_XGEN(j)  (2304 + 64 * (j))
#define XB_TOP      3328
#define XB_TOPGEN   3392
#define XCD_BAR_WORDS 3456
#define XB_SPIN_CAP (1u << 20)
__device__ __forceinline__ unsigned xb_ld(unsigned* p)              { return __hip_atomic_load(p, __ATOMIC_RELAXED, __HIP_MEMORY_SCOPE_AGENT); }
__device__ __forceinline__ unsigned xb_add(unsigned* p, unsigned v) { return __hip_atomic_fetch_add(p, v, __ATOMIC_RELAXED, __HIP_MEMORY_SCOPE_AGENT); }
__device__ __forceinline__ unsigned xb_xcc_id() { return (unsigned)__builtin_amdgcn_s_getreg((3 << 11) | 20) & 0xFu; }
#define XB_SPIN(cond, bar) do { unsigned _sp = 0; while (cond) { __builtin_amdgcn_s_sleep(1); \
    if ((++_sp & 255u) == 0u) { if (xb_ld(&(bar)[XB_TMO])) break; if (_sp > XB_SPIN_CAP) { atomicAdd(&(bar)[XB_TMO], 1u); break; } } } } while (0)
struct XcdBarrier { unsigned* bar; unsigned x; volatile LAS unsigned* st; };
__device__ __forceinline__ XcdBarrier xcd_barrier_post(unsigned* bar, volatile LAS unsigned* st) {
    XcdBarrier b; b.bar = bar; b.x = xb_xcc_id(); b.st = st;
    if (threadIdx.x == 0) (void)xb_add(&bar[XB_XCNT(b.x)], 1u);
    return b;
}
__device__ __forceinline__ void xcd_barrier_complete(unsigned* bar, unsigned x, unsigned& nloc, unsigned& nx) {
    const unsigned G = gridDim.x * gridDim.y * gridDim.z;
    unsigned sum, cnt, mine, sp = 0u;
    for (;;) {
        sum = 0u; cnt = 0u; mine = 0u;
#pragma unroll
        for (unsigned j = 0; j < 16; ++j) { const unsigned c = xb_ld(&bar[XB_XCNT(j)]); sum += c; cnt += (c > 0u) ? 1u : 0u; mine = (j == x) ? c : mine; }
        if (sum == G) break;
        __builtin_amdgcn_s_sleep(1);
        if ((++sp & 255u) == 0u) { if (xb_ld(&bar[XB_TMO])) break; if (sp > XB_SPIN_CAP) { atomicAdd(&bar[XB_TMO], 1u); break; } }
    }
    nloc = mine > 0u ? mine : 1u; nx = cnt > 0u ? cnt : 1u;
}
__device__ __forceinline__ void xcd_barrier(const XcdBarrier& b) {
    asm volatile("s_waitcnt vmcnt(0)" ::: "memory");
    __syncthreads();
    if (threadIdx.x == 0) {
        unsigned* bar = b.bar;
        __builtin_amdgcn_s_waitcnt(0);
        unsigned nloc = b.st[0], nx = b.st[1];
        if (nloc == 0u) { xcd_barrier_complete(bar, b.x, nloc, nx); b.st[0] = nloc; b.st[1] = nx; }
        const unsigned old = xb_add(&bar[XB_XSUB(b.x)], 1u);
        const unsigned gen = old / nloc;
        if (old + 1u == (gen + 1u) * nloc) {
            __builtin_amdgcn_fence(__ATOMIC_RELEASE, "agent");
            asm volatile("s_waitcnt vmcnt(0)" ::: "memory");
            const unsigned og = xb_add(&bar[XB_TOP], 1u);
            const unsigned tg = og / nx;
            if (og + 1u == (tg + 1u) * nx) xb_add(&bar[XB_TOPGEN], 1u);
            else XB_SPIN(xb_ld(&bar[XB_TOPGEN]) == tg, bar);
            __builtin_amdgcn_fence(__ATOMIC_ACQUIRE, "agent");
            xb_add(&bar[XB_XGEN(b.x)], 1u);
            asm volatile("s_waitcnt vmcnt(0)" ::: "memory");
        } else {
            XB_SPIN(xb_ld(&bar[XB_XGEN(b.x)]) == gen, bar);
            __builtin_amdgcn_fence(__ATOMIC_ACQUIRE, "agent");
            asm volatile("s_waitcnt vmcnt(0)" ::: "memory");
        }
    }
    __syncthreads();
}

template <int ST> __device__ __forceinline__ void run_stage(const Params& p, int l) {
    LAS unsigned char* lds = (LAS unsigned char*)smem_raw;
    pg8::StaticOrder S;
    if (ST == 7) { { const int gw = blockIdx.x * 8 + (otid() >> 6), lane = otid() & 63;
                     if (gw < 128) { const int l2 = gw >> 5, m2 = (gw >> 4) & 1, u2 = gw & 15;
                         conv_unit((m2 ? P_A2 : P_W2) + (size_t)l2 * 64 * 1024, 64, 1024, 1024, (m2 ? P_A2T : P_W2T) + (size_t)l2 * 1024 * 64, 64, u2, lane); } }
                   { const f32x4* xs = (const f32x4*)P_X_SAMPLE; f32x4* hd = (f32x4*)(P_H + (size_t)MP * DM);
                     for (int i = blockIdx.x * 512 + otid(); i < MS * DM / 4; i += gridDim.x * 512) hd[i] = xs[i]; }
                   phase_convert(p, 0, blockIdx.x * 8 + (otid() >> 6), gridDim.x * 8); phase_rmsnorm(P_X_PROMPT, P_X_SAMPLE, P_NORM_G, P_XN, nullptr, nullptr, nullptr); }
    if (ST == 0) { pg8::Gemm g{P_XN, P_WINT + (size_t)l * NP * DM, MT, NP, DM}; S.init(MT, NP, DM, gridDim.x, blockIdx.x); EpiZ e{P_Z}; pg8::gemm_phase(lds, g, S, e); }
    if (ST == 1) phase_prep(p, l);
    if (ST == 2) phase_scan(p, l);
    if (ST == 3) phase_post(p, l);
    if (ST == 4) { pg8::Gemm g{P_YAB, P_PABT + (size_t)l * DM * DM, MT, DM, DM}; S.init(MT, DM, DM, gridDim.x, blockIdx.x, 1); EpiMerge e{P_Z, P_M}; pg8::gemm_phase(lds, g, S, e); }
    if (ST == 5) { pg8::Gemm g{P_M, P_WOT + (size_t)l * DM * DM, MT, DM, DM}; S.init(MT, DM, DM, gridDim.x, blockIdx.x, 0, MP / 256);
                   EpiOut e{l == 0 ? P_X_PROMPT : P_H, P_H + (size_t)MP * DM, P_H, P_PART}; pg8::gemm_phase(lds, g, S, e); }
    if (ST == 6) { if (l < DEPTH - 1) phase_rmsnorm(P_H, P_H + (size_t)MP * DM, P_NORM_G + (size_t)(l + 1) * DM, P_XN, nullptr, P_PART, P_H + (size_t)MP * DM);
                   else phase_rmsnorm(P_H, P_H + (size_t)MP * DM, P_FINAL_G, nullptr, p.out + O_YP, P_PART, P_H + (size_t)MP * DM); }
}

#if MK_SINGLE
#ifndef REP0
#define REP0 1
#endif
#ifndef REP1
#define REP1 1
#endif
#ifndef REP2
#define REP2 1
#endif
#ifndef REP3
#define REP3 1
#endif
#ifndef REP4
#define REP4 1
#endif
#ifndef REP6
#define REP6 1
#endif
#ifndef REP7
#define REP7 1
#endif
__global__ void __launch_bounds__(512, 2) mega(Params p) {
    cg::grid_group grid = cg::this_grid();
    __shared__ uint4 xb_words;
    if (threadIdx.x == 0) xb_words = make_uint4(0u, 0u, 0u, 0u);
    __syncthreads();
    const XcdBarrier xb = xcd_barrier_post((unsigned*)(p.ws + WS_BAR), (volatile LAS unsigned*)&xb_words);
#define GSYNC() xcd_barrier(xb)
    for (int r = 0; r < REP7; ++r) { run_stage<7>(p, 0); grid.sync(); }
    for (int l = 0; l < DEPTH; ++l) {
        for (int r = 0; r < REP0; ++r) { run_stage<0>(p, l); GSYNC(); }
        for (int r = 0; r < REP1; ++r) { run_stage<1>(p, l); GSYNC(); }
        for (int r = 0; r < REP2; ++r) { run_stage<2>(p, l); GSYNC(); }
        for (int r = 0; r < REP3; ++r) { run_stage<3>(p, l); GSYNC(); }
        for (int r = 0; r < REP4; ++r) { run_stage<4>(p, l); GSYNC(); }
        run_stage<5>(p, l); GSYNC();
        for (int r = 0; r < REP6; ++r) { run_stage<6>(p, l); if (l + 1 < DEPTH || r + 1 < REP6) GSYNC(); }
    }
}
#else
template <int ST> __global__ void __launch_bounds__(512, 2) stage_k(Params p, int l) { run_stage<ST>(p, l); }
#endif

template <class K> static void set_lds(K k, size_t bytes) { (void)hipFuncSetAttribute((const void*)k, hipFuncAttributeMaxDynamicSharedMemorySize, (int)bytes); }

extern "C" void kernel_launch(void* const* d_in, const int* in_sizes, int n_in, void* d_out, int out_size, void* d_ws, size_t ws_size, hipStream_t stream) {
    constexpr size_t kDynLds = 131072;
    static int grid_blocks = 0;
    if (!grid_blocks) {
        int dev = 0, cus = 0;
        (void)hipGetDevice(&dev);
        (void)hipDeviceGetAttribute(&cus, hipDeviceAttributeMultiprocessorCount, dev);
#if MK_SINGLE
        int per_cu = 0;
        set_lds(mega, kDynLds);
        (void)hipOccupancyMaxActiveBlocksPerMultiprocessor(&per_cu, mega, 512, kDynLds);
        if (per_cu < 1) fprintf(stderr, "occupancy query returned %d\n", per_cu);
#else
        set_lds(stage_k<0>, kDynLds); set_lds(stage_k<1>, kDynLds); set_lds(stage_k<2>, kDynLds); set_lds(stage_k<3>, kDynLds);
        set_lds(stage_k<4>, kDynLds); set_lds(stage_k<5>, kDynLds); set_lds(stage_k<6>, kDynLds); set_lds(stage_k<7>, kDynLds);
#endif
        grid_blocks = cus > 0 ? cus : 256;
    }
    Params p{};
    for (int i = 0; i < 24; ++i) p.in[i] = (const float*)d_in[i];
    p.out = (float*)d_out; p.ws = (char*)d_ws;
    if (ws_size < WS_END) fprintf(stderr, "workspace too small: %zu < %zu\n", ws_size, (size_t)WS_END);
#if MK_SINGLE
    (void)hipMemsetAsync(p.ws + WS_BAR, 0, (size_t)XCD_BAR_WORDS_C * 4, stream);
    void* args[] = {&p};
    hipError_t e = hipLaunchCooperativeKernel((void*)mega, dim3(grid_blocks), dim3(512), args, kDynLds, stream);
    if (e != hipSuccess) fprintf(stderr, "cooperative launch failed: %s (grid %d)\n", hipGetErrorString(e), grid_blocks);
#else
    const dim3 G(grid_blocks), B(512);
    hipLaunchKernelGGL(stage_k<7>, G, B, kDynLds, stream, p, 0);
    for (int l = 0; l < DEPTH; ++l) {
        hipLaunchKernelGGL(stage_k<0>, G, B, kDynLds, stream, p, l);
        hipLaunchKernelGGL(stage_k<1>, G, B, kDynLds, stream, p, l);
        hipLaunchKernelGGL(stage_k<2>, G, B, kDynLds, stream, p, l);
        hipLaunchKernelGGL(stage_k<3>, G, B, kDynLds, stream, p, l);
        hipLaunchKernelGGL(stage_k<4>, G, B, kDynLds, stream, p, l);
        hipLaunchKernelGGL(stage_k<5>, G, B, kDynLds, stream, p, l);
        hipLaunchKernelGGL(stage_k<6>, G, B, kDynLds, stream, p, l);
    }
#endif
}
```

```cpp
#include <hip/hip_runtime.h>
#include <hip/hip_cooperative_groups.h>
#include <cstdio>
namespace cg = cooperative_groups;

#ifndef MK_SINGLE
#define MK_SINGLE 1
#endif

#define LAS __attribute__((address_space(3)))
typedef unsigned short bf16_t;
typedef short bf16x8 __attribute__((ext_vector_type(8)));
typedef float f32x4 __attribute__((ext_vector_type(4)));
typedef float f32x2 __attribute__((ext_vector_type(2)));
typedef unsigned u32x4 __attribute__((ext_vector_type(4)));
typedef unsigned u32x2 __attribute__((ext_vector_type(2)));

constexpr int DM = 2048, DEPTH = 4;
constexpr int MP = 8192, MS = 1024, MT = 9216;
constexpr int DSH = 3200;
constexpr int NP = 11520;
constexpr int NIN = 11392;
constexpr int C_R = 0, C_K = 1024, C_V = 2048, C_WD = 3072, C_AD = 3136, C_GR = 3200, C_U = 4224, C_VG = 5248, C_GG = 6272, C_GA = 7296, C_GB = 9344;
constexpr size_t O_YP = 0, O_WKVP = 18874368, O_SHP = 19922944, O_WKVS = 19974144, O_SHS = 53528576, O_CV = 55166976;
constexpr int NPHASE = 1 + 7 * DEPTH;

constexpr int RDY_W0 = 3456 + 256;
constexpr int XCD_BAR_WORDS_C = RDY_W0 + 36 * 64;
struct Params { const float* in[24]; float* out; char* ws; };
constexpr size_t al256(size_t x) { return (x + 255) & ~(size_t)255; }
constexpr size_t WS_WINT = 0;
constexpr size_t WS_PABT = WS_WINT + al256((size_t)DEPTH * NP * DM * 2);
constexpr size_t WS_WOT = WS_PABT + al256((size_t)DEPTH * DM * DM * 2);
constexpr size_t WS_XN = WS_WOT + al256((size_t)DEPTH * DM * DM * 2);
constexpr size_t WS_Z = WS_XN + al256((size_t)MT * DM * 2);
constexpr size_t WS_VNT = WS_Z + al256((size_t)MT * NP * 2);
constexpr size_t WS_VNTS = WS_VNT + al256((size_t)64 * 1024 * 128 * 2);
constexpr size_t WS_YAB = WS_VNTS + al256((size_t)128 * 1024 * 8 * 2);
constexpr size_t WS_M = WS_YAB + al256((size_t)MT * DM * 2);
constexpr size_t WS_H = WS_M + al256((size_t)MT * DM * 2);
constexpr size_t WS_REC = WS_H + al256((size_t)MT * DM * 4);
constexpr int RECF = 256;
constexpr size_t WS_YBUF = WS_REC + al256((size_t)MT * 16 * RECF * 4);
constexpr size_t WS_PART = WS_YBUF + al256((size_t)MT * 1024 * 4);
constexpr size_t WS_W2T = WS_PART + al256((size_t)2 * MS * DM * 4);
constexpr size_t WS_A2T = WS_W2T + al256((size_t)DEPTH * 1024 * 64 * 2);
constexpr size_t WS_BAR = WS_A2T + al256((size_t)DEPTH * 1024 * 64 * 2);
constexpr size_t WS_END = WS_BAR + al256((size_t)XCD_BAR_WORDS_C * 4);
#define P_X_PROMPT (p.in[0])
#define P_X_SAMPLE (p.in[1])
#define P_STATE_WKV (p.in[2])
#define P_STATE_SHIFT (p.in[3])
#define P_NORM_G (p.in[4])
#define P_W_IN (p.in[5])
#define P_SHIFT_MU (p.in[6])
#define P_W0 (p.in[7])
#define P_W2 (p.in[8])
#define P_A0 (p.in[9])
#define P_A2 (p.in[10])
#define P_K_K (p.in[11])
#define P_K_A (p.in[12])
#define P_R_K (p.in[13])
#define P_LNX_G (p.in[14])
#define P_LNX_B (p.in[15])
#define P_SGU_LN_G (p.in[16])
#define P_SGU_LN_B (p.in[17])
#define P_SGU_W (p.in[18])
#define P_SGU_B (p.in[19])
#define P_W_PROJ_A (p.in[20])
#define P_W_PROJ_B (p.in[21])
#define P_W_OUT (p.in[22])
#define P_FINAL_G (p.in[23])
#define P_WINT ((bf16_t*)(p.ws + WS_WINT))
#define P_PABT ((bf16_t*)(p.ws + WS_PABT))
#define P_WOT ((bf16_t*)(p.ws + WS_WOT))
#define P_XN ((bf16_t*)(p.ws + WS_XN))
#define P_Z ((bf16_t*)(p.ws + WS_Z))
#define P_VNT ((bf16_t*)(p.ws + WS_VNT))
#define P_VNTS ((bf16_t*)(p.ws + WS_VNTS))
#define P_YAB ((bf16_t*)(p.ws + WS_YAB))
#define P_M ((bf16_t*)(p.ws + WS_M))
#define P_H ((float*)(p.ws + WS_H))
#define P_REC ((float*)(p.ws + WS_REC))
#define P_YBUF ((float*)(p.ws + WS_YBUF))
#define P_PART ((float*)(p.ws + WS_PART))
#define P_W2T ((bf16_t*)(p.ws + WS_W2T))
#define P_A2T ((bf16_t*)(p.ws + WS_A2T))

extern __shared__ __attribute__((aligned(16))) unsigned char smem_raw[];

__device__ __forceinline__ int otid() { int t = threadIdx.x; asm volatile("" : "+v"(t)); return t; }
__device__ __forceinline__ float bf2f(bf16_t v) { return __uint_as_float(((unsigned)v) << 16); }
__device__ __forceinline__ float bflo(unsigned v) { return __uint_as_float(v << 16); }
__device__ __forceinline__ float bfhi(unsigned v) { return __uint_as_float(v & 0xffff0000u); }
__device__ __forceinline__ unsigned pk_bf16(float lo, float hi) { unsigned r; asm("v_cvt_pk_bf16_f32 %0, %1, %2" : "=v"(r) : "v"(lo), "v"(hi)); return r; }
template <int CTRL> __device__ __forceinline__ float dppf(float x) { return __int_as_float(__builtin_amdgcn_update_dpp(0, __float_as_int(x), CTRL, 0xF, 0xF, true)); }
__device__ __forceinline__ float red16(float x) { x += dppf<0xB1>(x); x += dppf<0x4E>(x); x += dppf<0x141>(x); x += dppf<0x140>(x); return x; }
__device__ __forceinline__ void red16x2(float& x, float& y) { x += dppf<0xB1>(x); y += dppf<0xB1>(y); x += dppf<0x4E>(x); y += dppf<0x4E>(y); x += dppf<0x141>(x); y += dppf<0x141>(y); x += dppf<0x140>(x); y += dppf<0x140>(y); }
__device__ __forceinline__ float red32(float x) { x = red16(x); x += __shfl_xor(x, 16); return x; }
__device__ __forceinline__ float red64(float x) { x = red16(x); x += __shfl_xor(x, 16); x += __shfl_xor(x, 32); return x; }
__device__ __forceinline__ float sigmoidf_(float x) { return __builtin_amdgcn_rcpf(1.f + __expf(-x)); }
__device__ __forceinline__ float tanhf_(float x) { const float e = __expf(2.f * fminf(fmaxf(x, -15.f), 15.f)); return 1.f - 2.f * __builtin_amdgcn_rcpf(1.f + e); }
__device__ __forceinline__ float siluf_(float x) { return x * __builtin_amdgcn_rcpf(1.f + __expf(-x)); }

namespace pg8 {
constexpr int TAILK = 2;
constexpr int BM = 256, BK = 64, HALF = 128, HTB = HALF * BK * 2, STAGE_BYTES = 8 * HTB, NXCD = 8, WGM = 8;
__device__ __forceinline__ int lds_byte(int r, int c) { const int st = (r >> 4) * 2 + (c >> 5), rr = r & 15, cc = c & 31, ob = rr * 64 + cc * 2; return st * 1024 + (ob ^ (((ob >> 9) & 1) << 5)); }
__device__ __forceinline__ void stage_rc(int b, int& R, int& C) { const int st = b / 1024, sb = b % 1024, swz = sb ^ (((sb >> 9) & 1) << 5); R = (st >> 1) * 16 + swz / 64; C = (st & 1) * 32 + (swz % 64) / 2; }
__device__ __forceinline__ int perm32(int rho) { const int n = rho >> 4, i = rho & 15; return 8 * (i >> 2) + 4 * n + (i & 3); }
struct Unit { int pm, pn, seg, nt, kofs; };
struct Gemm { const bf16_t* A; const bf16_t* Bt; int M, N, K; };
struct StaticOrder {
    int nM, nN, nwg, G, c;
    __device__ void init(int M, int N, int K, int G_, int c_, int split_ = 0, int tail_pm0_ = 0) { nM = M / BM; nN = N / BM; nwg = nM * nN; G = G_; c = c_; split = split_; ntk = K / BK; tail_pm0 = tail_pm0_;
        tail_full = 0; tail_shift = 0; ready = nullptr; need = 0u; }
    int split, ntk;
    int tail_pm0, tail_full, tail_shift;
    unsigned* ready; unsigned need;
    __device__ static void map(int wgid, int nM_, int nN_, int& pm, int& pn) {
        const int nw_ = nM_ * nN_; { const int q = nw_ / NXCD, r = nw_ % NXCD, xcd = wgid % NXCD, off = wgid / NXCD; wgid = (xcd < r ? xcd * (q + 1) : r * (q + 1) + (xcd - r) * q) + off; }
        const int nig = WGM * nN_, gid = wgid / nig, fm = gid * WGM, gsz = (nM_ - fm) < WGM ? (nM_ - fm) : WGM;
        pm = fm + ((wgid % nig) % gsz); pn = (wgid % nig) / gsz;
    }
    __device__ bool next(int i, Unit& u) const {
        const int sg = split ? (i & 1) : 0; if (split) i >>= 1;
        const long L = (long)i * G + c;
        if (tail_pm0 > 0) {
            const int nmain = tail_pm0 * nN;
            if (L < nmain) { map((int)L, tail_pm0, nN, u.pm, u.pn); u.seg = sg; u.nt = split ? ntk / 2 : ntk; u.kofs = sg * u.nt; return true; }
            const long sidx = L - nmain - tail_shift; if (sidx < 0) return false;
            if (tail_full) { if (sidx >= (long)(nM - tail_pm0) * nN) return false;
                u.pm = tail_pm0 + (int)sidx / nN; u.pn = (int)sidx % nN; u.seg = sg; u.nt = split ? ntk / 2 : ntk; u.kofs = sg * u.nt; return true; }
            if (sidx >= (long)(nM - tail_pm0) * nN * TAILK) return false;
            const int tt = (int)(sidx / TAILK), sl = (int)(sidx % TAILK); u.pm = tail_pm0 + tt / nN; u.pn = tt % nN; u.seg = 1 + sl; u.nt = ntk / TAILK; u.kofs = sl * (ntk / TAILK); return true;
        }
        if (L >= nwg) return false;
        map((int)L, nM, nN, u.pm, u.pn); u.seg = sg; u.nt = split ? ntk / 2 : ntk; u.kofs = sg * u.nt; return true;
    }
    __device__ __forceinline__ void a_ready(const Unit& u) const {
        if (ready == nullptr) return;
        if (threadIdx.x < 64) {
            unsigned polls = 0;
            while ((unsigned)__builtin_amdgcn_readfirstlane(__hip_atomic_load(ready + 64 * u.pm, __ATOMIC_RELAXED, __HIP_MEMORY_SCOPE_AGENT)) < need) { if (++polls > (1u << 22)) break; __builtin_amdgcn_s_sleep(2); }
            __builtin_amdgcn_fence(__ATOMIC_ACQUIRE, "agent");
            asm volatile("s_waitcnt vmcnt(0)" ::: "memory");
        }
        asm volatile("" ::: "memory"); __builtin_amdgcn_s_barrier(); asm volatile("" ::: "memory");
    }
};

template <class Epi, class Sched>
__device__ __forceinline__ void gemm_phase(LAS unsigned char* lds, const Gemm g, const Sched& S, const Epi& E) {
    const int tid = otid(), wid = __builtin_amdgcn_readfirstlane(tid >> 6), lane = tid & 63, wr = wid >> 2, wc = wid & 3, fr = lane & 15, fq = lane >> 4;
    const int ld = g.K;
    unsigned voffA[2], voffB[2];
#pragma unroll
    for (int i = 0; i < 2; ++i) { int R, C; stage_rc(tid * 16 + i * 8192, R, C); const int Rb = Epi::PERM ? ((R & ~31) + perm32(R & 31)) : R;
        voffA[i] = (unsigned)(R * ld + C) * 2u; voffB[i] = (unsigned)(Rb * ld + C) * 2u; }
    const size_t kstep = (size_t)(BK * 2);
    const size_t hstep = (size_t)HALF * ld * 2;
    const size_t tstep = 2 * hstep;
    const unsigned ldsw = (unsigned)wid * 1024u;
    const int aoff = lds_byte(wr * 64 + fr, fq * 8), boff = lds_byte(wc * 32 + fr, fq * 8);
#define PG8_SA(b, h) (((b) * 2 + (h)) * HTB)
#define PG8_SB(b, h) ((4 + (b) * 2 + (h)) * HTB)
#define PG8_STAGE(bufoff, gbase, voff) do { _Pragma("unroll") for (int _i = 0; _i < 2; ++_i) \
        __builtin_amdgcn_global_load_lds((const unsigned*)((const char*)(gbase) + (voff)[_i]), (LAS unsigned*)(lds + (bufoff) + ldsw + _i * 8192), 16, 0, 0); } while (0)
#define PG8_LDA(dst, b, h) do { _Pragma("unroll") for (int m = 0; m < 4; ++m) _Pragma("unroll") for (int k = 0; k < 2; ++k) dst[m][k] = *(const LAS bf16x8*)(lds + PG8_SA(b, h) + aoff + m * 2048 + k * 1024); } while (0)
#define PG8_LDB(dst, b, h) do { _Pragma("unroll") for (int n = 0; n < 2; ++n) _Pragma("unroll") for (int k = 0; k < 2; ++k) dst[n][k] = *(const LAS bf16x8*)(lds + PG8_SB(b, h) + boff + n * 2048 + k * 1024); } while (0)
#define PG8_MMA(ai, bj, At, Bt) do { __builtin_amdgcn_s_setprio(1); _Pragma("unroll") for (int m = 0; m < 4; ++m) _Pragma("unroll") for (int n = 0; n < 2; ++n) _Pragma("unroll") for (int k = 0; k < 2; ++k) \
        acc[ai][bj][m][n] = __builtin_amdgcn_mfma_f32_16x16x32_bf16(Bt[n][k], At[m][k], acc[ai][bj][m][n], 0, 0, 0); __builtin_amdgcn_s_setprio(0); } while (0)
#define PG8_WAIT_V(n) asm volatile("s_waitcnt vmcnt(" #n ")" ::: "memory")
#define PG8_WAIT_L(n) asm volatile("s_waitcnt lgkmcnt(" #n ")" ::: "memory")
#define PG8_BAR __builtin_amdgcn_s_barrier()
#define PG8_SCHED __builtin_amdgcn_sched_barrier(0)
    Unit cur, nxt; int ui = 0;
    if (!S.next(0, cur)) return;
    S.a_ready(cur);
    f32x4 acc[2][2][4][2];
#pragma unroll
    for (int a = 0; a < 2; ++a)
#pragma unroll
        for (int b = 0; b < 2; ++b)
#pragma unroll
            for (int m = 0; m < 4; ++m)
#pragma unroll
                for (int n = 0; n < 2; ++n) acc[a][b][m][n] = (f32x4){0.f, 0.f, 0.f, 0.f};
    bf16x8 At[4][2], B0[2][2], B1[2][2];
    const char* cA = (const char*)g.A + (size_t)cur.pm * tstep + (size_t)cur.kofs * kstep; const char* cB = (const char*)g.Bt + (size_t)cur.pn * tstep + (size_t)cur.kofs * kstep;
    PG8_STAGE(PG8_SB(0, 0), cB, voffB); PG8_STAGE(PG8_SA(0, 0), cA, voffA); PG8_STAGE(PG8_SB(0, 1), cB + hstep, voffB); PG8_STAGE(PG8_SA(0, 1), cA + hstep, voffA);
    if (wr == 1) PG8_BAR;
    PG8_WAIT_V(4); PG8_BAR;
    PG8_STAGE(PG8_SB(1, 0), cB + kstep, voffB); PG8_STAGE(PG8_SA(1, 0), cA + kstep, voffA); PG8_STAGE(PG8_SB(1, 1), cB + hstep + kstep, voffB);
    PG8_WAIT_V(6); PG8_BAR;
    for (;;) {
        const bool has_next = S.next(ui + 1, nxt);
        const char* nA = has_next ? (const char*)g.A + (size_t)nxt.pm * tstep + (size_t)nxt.kofs * kstep : cA; const char* nB = has_next ? (const char*)g.Bt + (size_t)nxt.pn * tstep + (size_t)nxt.kofs * kstep : cB;
        const int nt = cur.nt;
        for (int t = 0; t < nt; t += 2) {
            const bool last = (t == nt - 2);
            if (last && has_next) S.a_ready(nxt);
            const char* a1 = cA + (size_t)(t + 1) * kstep;
            const char* a2 = last ? nA : cA + (size_t)(t + 2) * kstep; const char* b2 = last ? nB : cB + (size_t)(t + 2) * kstep;
            const char* a3 = a2 + kstep; const char* b3 = b2 + kstep;
            PG8_LDB(B0, 0, 0); PG8_SCHED; PG8_LDA(At, 0, 0); PG8_STAGE(PG8_SA(1, 1), a1 + hstep, voffA);
            PG8_WAIT_L(8); PG8_BAR; PG8_WAIT_L(0); PG8_MMA(0, 0, At, B0); PG8_BAR; PG8_SCHED;
            PG8_LDB(B1, 0, 1); PG8_STAGE(PG8_SB(0, 0), b2, voffB);
            PG8_BAR; PG8_WAIT_L(0); PG8_MMA(0, 1, At, B1); PG8_BAR;
            PG8_LDA(At, 0, 1); PG8_STAGE(PG8_SA(0, 0), a2, voffA);
            PG8_BAR; PG8_WAIT_L(0); PG8_MMA(1, 0, At, B0); PG8_BAR; PG8_SCHED;
            PG8_STAGE(PG8_SB(0, 1), b2 + hstep, voffB);
            PG8_WAIT_V(6); PG8_BAR; PG8_MMA(1, 1, At, B1); PG8_BAR;
            PG8_LDB(B0, 1, 0); PG8_SCHED; PG8_LDA(At, 1, 0); PG8_STAGE(PG8_SA(0, 1), a2 + hstep, voffA);
            PG8_WAIT_L(8); PG8_BAR; PG8_WAIT_L(0); PG8_MMA(0, 0, At, B0); PG8_BAR; PG8_SCHED;
            PG8_LDB(B1, 1, 1); PG8_STAGE(PG8_SB(1, 0), b3, voffB);
            PG8_BAR; PG8_WAIT_L(0); PG8_MMA(0, 1, At, B1); PG8_BAR;
            PG8_LDA(At, 1, 1); PG8_STAGE(PG8_SA(1, 0), a3, voffA);
            PG8_BAR; PG8_WAIT_L(0); PG8_MMA(1, 0, At, B0); PG8_BAR; PG8_SCHED;
            PG8_STAGE(PG8_SB(1, 1), b3 + hstep, voffB);
            PG8_WAIT_V(6); PG8_BAR; PG8_MMA(1, 1, At, B1); PG8_BAR;
        }
        E(acc, cur, wr, wc, fr, fq);
        if (!has_next) break;
        if (!(Epi::SPLIT2 && cur.seg == 0))
#pragma unroll
        for (int a = 0; a < 2; ++a)
#pragma unroll
            for (int b = 0; b < 2; ++b)
#pragma unroll
                for (int m = 0; m < 4; ++m)
#pragma unroll
                    for (int n = 0; n < 2; ++n) acc[a][b][m][n] = (f32x4){0.f, 0.f, 0.f, 0.f};
        cur = nxt; cA = nA; cB = nB; ++ui;
    }
    PG8_WAIT_V(0);
    if (wr == 0) PG8_BAR;
    PG8_BAR;
#undef PG8_SA
#undef PG8_SB
#undef PG8_STAGE
#undef PG8_LDA
#undef PG8_LDB
#undef PG8_MMA
#undef PG8_WAIT_V
#undef PG8_WAIT_L
#undef PG8_BAR
#undef PG8_SCHED
}
}

struct EpiZ {
    static constexpr bool PERM = true, SPLIT2 = false;
    bf16_t* Z;
    __device__ __forceinline__ void operator()(f32x4 (&acc)[2][2][4][2], const pg8::Unit& u, int wr, int wc, int fr, int fq) const {
        const int row0 = u.pm * 256 + wr * 64 + fr, col0 = u.pn * 256 + wc * 32 + 8 * fq;
#pragma unroll
        for (int ai = 0; ai < 2; ++ai)
#pragma unroll
            for (int m = 0; m < 4; ++m) { bf16_t* rowp = Z + (size_t)(row0 + ai * 128 + m * 16) * NP + col0;
#pragma unroll
                for (int bj = 0; bj < 2; ++bj) { const f32x4 v0 = acc[ai][bj][m][0], v1 = acc[ai][bj][m][1];
                    u32x4 o; o[0] = pk_bf16(v0[0], v0[1]); o[1] = pk_bf16(v0[2], v0[3]); o[2] = pk_bf16(v1[0], v1[1]); o[3] = pk_bf16(v1[2], v1[3]);
                    *(u32x4*)(rowp + bj * 128) = o; } }
    }
};
struct EpiMerge {
    static constexpr bool PERM = true, SPLIT2 = true;
    const bf16_t* Z; bf16_t* Mo; unsigned* ready;
    __device__ __forceinline__ void mid(f32x4 (&acc)[2][2][4][2], const pg8::Unit& u, int wr, int wc, int fr, int fq) const {
        const int row0 = u.pm * 256 + wr * 64 + fr, col0 = u.pn * 256 + wc * 32 + 8 * fq;
#pragma unroll
        for (int ai = 0; ai < 2; ++ai)
#pragma unroll
            for (int m = 0; m < 4; ++m) { const bf16_t* zr = Z + (size_t)(row0 + ai * 128 + m * 16) * NP + col0;
#pragma unroll
                for (int bj = 0; bj < 2; ++bj) { const u32x4 ga = *(const u32x4*)(zr + C_GA + bj * 128), gb = *(const u32x4*)(zr + C_GB + bj * 128);
#pragma unroll
                    for (int q = 0; q < 4; ++q) { const float a0 = bflo(ga[q]), a1 = bfhi(ga[q]), b0 = bflo(gb[q]), b1 = bfhi(gb[q]);
                        const float r0 = (1.f + __expf(-b0)) * __builtin_amdgcn_rcpf(1.f + __expf(-a0)), r1 = (1.f + __expf(-b1)) * __builtin_amdgcn_rcpf(1.f + __expf(-a1));
                        acc[ai][bj][m][q >> 1][(q & 1) * 2] *= r0; acc[ai][bj][m][q >> 1][(q & 1) * 2 + 1] *= r1; } } }
    }
    __device__ __forceinline__ void fin(f32x4 (&acc)[2][2][4][2], const pg8::Unit& u, int wr, int wc, int fr, int fq) const {
        const int row0 = u.pm * 256 + wr * 64 + fr, col0 = u.pn * 256 + wc * 32 + 8 * fq;
        const __amdgpu_buffer_rsrc_t rs = __builtin_amdgcn_make_buffer_rsrc((void*)Mo, 0, MT * DM * 2, 0x00020000);
#pragma unroll
        for (int ai = 0; ai < 2; ++ai)
#pragma unroll
            for (int m = 0; m < 4; ++m) { const size_t r = (size_t)(row0 + ai * 128 + m * 16); const bf16_t* zr = Z + r * NP + col0; const unsigned mo = (unsigned)((r * DM + col0) * 2);
#pragma unroll
                for (int bj = 0; bj < 2; ++bj) { const u32x4 gb = *(const u32x4*)(zr + C_GB + bj * 128); u32x4 o;
#pragma unroll
                    for (int q = 0; q < 4; ++q) { const float s0 = sigmoidf_(bflo(gb[q])), s1 = sigmoidf_(bfhi(gb[q]));
                        o[q] = pk_bf16(acc[ai][bj][m][q >> 1][(q & 1) * 2] * s0, acc[ai][bj][m][q >> 1][(q & 1) * 2 + 1] * s1); }
                    __builtin_amdgcn_raw_buffer_store_b128(o, rs, mo + bj * 256, 0, 16); } }
        asm volatile("s_waitcnt vmcnt(0)" ::: "memory");
        if (fr == 0 && fq == 0) (void)__hip_atomic_fetch_add(ready + 64 * u.pm, 1u, __ATOMIC_RELAXED, __HIP_MEMORY_SCOPE_AGENT);
    }
    __device__ __forceinline__ void operator()(f32x4 (&acc)[2][2][4][2], const pg8::Unit& u, int wr, int wc, int fr, int fq) const {
        if (u.seg == 0) mid(acc, u, wr, wc, fr, fq); else fin(acc, u, wr, wc, fr, fq);
    }
};
struct EpiOut {
    static constexpr bool PERM = false, SPLIT2 = false;
    const float* hp; const float* hs; float* Ho; float* Part;
    __device__ __forceinline__ void operator()(f32x4 (&acc)[2][2][4][2], const pg8::Unit& u, int wr, int wc, int fr, int fq) const {
        const int row0 = u.pm * 256 + wr * 64 + fr, col0 = u.pn * 256 + wc * 32 + 4 * fq;
        if (u.seg) {
            float* pb = Part + ((size_t)(u.seg - 1) * MS + (row0 - MP)) * DM + col0;
#pragma unroll
            for (int ai = 0; ai < 2; ++ai)
#pragma unroll
                for (int m = 0; m < 4; ++m)
#pragma unroll
                    for (int bj = 0; bj < 2; ++bj)
#pragma unroll
                        for (int n = 0; n < 2; ++n) *(f32x4*)(pb + (size_t)(ai * 128 + m * 16) * DM + bj * 128 + n * 16) = acc[ai][bj][m][n];
            return;
        }
        const float* src = (u.pm < 32) ? hp + (size_t)row0 * DM : hs + (size_t)(row0 - MP) * DM;
#pragma unroll
        for (int ai = 0; ai < 2; ++ai)
#pragma unroll
            for (int m = 0; m < 4; ++m) { const size_t ro = (size_t)(ai * 128 + m * 16) * DM + col0; float* dst = Ho + (size_t)row0 * DM + ro;
#pragma unroll
                for (int bj = 0; bj < 2; ++bj)
#pragma unroll
                    for (int n = 0; n < 2; ++n) { const f32x4 o = *(const f32x4*)(src + ro + bj * 128 + n * 16) + acc[ai][bj][m][n]; *(f32x4*)(dst + bj * 128 + n * 16) = o; } }
    }
};

__device__ __forceinline__ void conv_unit(const float* __restrict__ W, int K, int N, int Npad, bf16_t* __restrict__ Wt, int ldt, int unit, int lane) {
    const int nnb = Npad >> 6; const int kb = unit / nnb, nb = unit - kb * nnb;
    const int n = nb * 64 + lane, k0 = kb * 64;
    bf16_t* dst = Wt + (size_t)n * ldt + k0;
    if (n < N) {
        const float* src = W + (size_t)k0 * N + n;
        float v[64];
#pragma unroll
        for (int j = 0; j < 64; ++j) v[j] = src[(size_t)j * N];
#pragma unroll
        for (int kk = 0; kk < 64; kk += 8) { u32x4 o; o[0] = pk_bf16(v[kk], v[kk + 1]); o[1] = pk_bf16(v[kk + 2], v[kk + 3]); o[2] = pk_bf16(v[kk + 4], v[kk + 5]); o[3] = pk_bf16(v[kk + 6], v[kk + 7]);
            *(u32x4*)(dst + kk) = o; }
    } else {
#pragma unroll
        for (int kk = 0; kk < 64; kk += 8) *(u32x4*)(dst + kk) = (u32x4){0u, 0u, 0u, 0u};
    }
}
__device__ void phase_convert(const Params& p, int l, int gw, int nw) {
    const int lane = otid() & 63;
    constexpr int U_IN = (NP / 64) * 32, U_P = 32 * 16, U_O = 32 * 32, U_L = U_IN + 2 * U_P + U_O;
    for (int u = gw; u < U_L; u += nw) {
        int r = u;
        if (r < U_IN) conv_unit(P_W_IN + (size_t)l * DM * NIN, DM, NIN, NP, P_WINT + (size_t)l * NP * DM, DM, r, lane);
        else if ((r -= U_IN) < U_P) conv_unit(P_W_PROJ_A + (size_t)l * 1024 * DM, 1024, DM, DM, P_PABT + (size_t)l * DM * DM, DM, r, lane);
        else if ((r -= U_P) < U_P) conv_unit(P_W_PROJ_B + (size_t)l * 1024 * DM, 1024, DM, DM, P_PABT + (size_t)l * DM * DM + 1024, DM, r, lane);
        else { r -= U_P; conv_unit(P_W_OUT + (size_t)l * DM * DM, DM, DM, DM, P_WOT + (size_t)l * DM * DM, DM, r, lane); }
    }
}

__device__ void phase_rmsnorm(const float* hp, const float* hs, const float* g, bf16_t* obf, float* of32, const float* part, float* hs_w) {
    const int lane = otid() & 63, gw = blockIdx.x * 8 + (otid() >> 6), nw = gridDim.x * 8;
    for (int row = gw; row < MT; row += nw) {
        const f32x4* x = (const f32x4*)(row < MP ? hp + (size_t)row * DM : hs + (size_t)(row - MP) * DM);
        f32x4 v[8]; float ss = 0.f;
#pragma unroll
        for (int i = 0; i < 8; ++i) v[i] = x[lane + 64 * i];
        if (part && row >= MP) {
#pragma unroll
            for (int sl = 0; sl < pg8::TAILK; ++sl) { const f32x4* pp = (const f32x4*)(part + ((size_t)sl * MS + (row - MP)) * DM);
#pragma unroll
                for (int i = 0; i < 8; ++i) v[i] += pp[lane + 64 * i]; }
#pragma unroll
            for (int i = 0; i < 8; ++i) ((f32x4*)(hs_w + (size_t)(row - MP) * DM))[lane + 64 * i] = v[i];
        }
#pragma unroll
        for (int i = 0; i < 8; ++i) ss += v[i][0] * v[i][0] + v[i][1] * v[i][1] + v[i][2] * v[i][2] + v[i][3] * v[i][3];
        ss = red64(ss);
        const float rstd = rsqrtf(ss * (1.f / DM) + 1e-6f);
#pragma unroll
        for (int i = 0; i < 8; ++i) { const f32x4 gg = ((const f32x4*)g)[lane + 64 * i]; const f32x4 o = v[i] * rstd * gg;
            if (obf) { u32x2 w; w[0] = pk_bf16(o[0], o[1]); w[1] = pk_bf16(o[2], o[3]); *(u32x2*)(obf + (size_t)row * DM + (lane + 64 * i) * 4) = w; }
            else *(f32x4*)(of32 + (size_t)row * DM + (lane + 64 * i) * 4) = o; }
    }
}

__device__ void phase_prep(const Params& p, int l) {
    LAS float* sm = (LAS float*)smem_raw;
    LAS bf16_t* twb = (LAS bf16_t*)sm;
    LAS bf16_t* adb = twb + 16 * 72;
    LAS float* red = sm + 1152;
    LAS float* lwla = sm + 2048;
    const int tid = otid(), lane = tid & 63, wv = tid >> 6;
    const int c = tid * 2;
    const float* mu = P_SHIFT_MU + l * DSH;
    for (int i = tid; i < 2 * 8 * 72 / 2; i += 512) { const int m_ = i / 288, r_ = i % 288; ((LAS unsigned*)(twb + m_ * 16 * 72 + 8 * 72))[r_] = 0u; }
    unsigned* qhead = (unsigned*)(p.ws + WS_BAR) + 3456 + 64 * l;
    LAS int* qslot = (LAS int*)(sm + 1300);
    for (;;) {
        if (tid == 0) *qslot = (int)__hip_atomic_fetch_add(qhead, 1u, __ATOMIC_RELAXED, __HIP_MEMORY_SCOPE_AGENT);
        __syncthreads();
        const int qi = *qslot;
        if (qi >= MT / 8) break;
        const int item = qi < MS / 8 ? MP / 8 + qi : qi - MS / 8;
        const int row0 = item * 8;
        const bool samp = row0 >= MP;
        const int sb = (row0 - MP) >> 3, pb = row0 >> 11, t0 = row0 & 2047;
        const bf16_t* zr = P_Z + (size_t)row0 * NP;
        const float* sprev = P_STATE_SHIFT + (size_t)(l * 128 + (samp ? sb : 0)) * DSH;
        const bool zprev = (!samp) && (t0 == 0);
        {
            const int j = tid & 127, col = C_WD + j, tp = tid >> 7;
            const float m_ = mu[col];
#pragma unroll
            for (int tt = 0; tt < 2; ++tt) { const int t = tp * 2 + tt;
                const float cur = bf2f(zr[(size_t)t * NP + col]);
                float prv;
                if (t == 0) prv = samp ? sprev[col] : (zprev ? 0.f : bf2f(*(zr + col - NP))); else prv = bf2f(zr[(size_t)(t - 1) * NP + col]);
                const float mix = cur + (prv - cur) * m_;
                if (j < 64) twb[t * 72 + j] = (bf16_t)(pk_bf16(tanhf_(mix), 0.f) & 0xffffu); else adb[t * 72 + j - 64] = (bf16_t)(pk_bf16(mix, 0.f) & 0xffffu); }
        }
        unsigned vgw[8];
#pragma unroll
        for (int t = 0; t < 8; ++t) vgw[t] = *(const unsigned*)(zr + (size_t)t * NP + C_VG + c);
        float rm[8][2], km[8][2], vm[8][2];
#pragma unroll
        for (int sec = 0; sec < 3; ++sec) { const int col = sec * 1024 + c;
            float p0, p1;
            if (samp) { const f32x2 s2 = *(const f32x2*)(sprev + col); p0 = s2[0]; p1 = s2[1]; }
            else if (zprev) { p0 = 0.f; p1 = 0.f; }
            else { const unsigned w = *(const unsigned*)(zr + col - NP); p0 = bflo(w); p1 = bfhi(w); }
            const f32x2 m2 = *(const f32x2*)(mu + col);
#pragma unroll
            for (int t = 0; t < 8; ++t) { const unsigned w = *(const unsigned*)(zr + (size_t)t * NP + col); const float c0 = bflo(w), c1 = bfhi(w);
                const float x0 = c0 + (p0 - c0) * m2[0], x1 = c1 + (p1 - c1) * m2[1];
                if (sec == 0) { rm[t][0] = x0; rm[t][1] = x1; } else if (sec == 1) { km[t][0] = x0; km[t][1] = x1; } else { vm[t][0] = x0; vm[t][1] = x1; }
                p0 = c0; p1 = c1; } }
        __syncthreads();
        {
            const int fr = lane & 15, fq = lane >> 4;
            bf16x8 aw[2], aa[2];
#pragma unroll
            for (int ks = 0; ks < 2; ++ks) { aw[ks] = *(const LAS bf16x8*)(twb + fr * 72 + ks * 32 + fq * 8); aa[ks] = *(const LAS bf16x8*)(adb + fr * 72 + ks * 32 + fq * 8); }
            const bf16_t* w2t = P_W2T + ((size_t)l * 1024 + wv * 128 + fr) * 64 + fq * 8;
            const bf16_t* a2t = P_A2T + ((size_t)l * 1024 + wv * 128 + fr) * 64 + fq * 8;
#pragma unroll
            for (int nt = 0; nt < 8; ++nt) {
                f32x4 dw = (f32x4){0.f, 0.f, 0.f, 0.f}, da = (f32x4){0.f, 0.f, 0.f, 0.f};
#pragma unroll
                for (int ks = 0; ks < 2; ++ks) { const bf16x8 bw = *(const bf16x8*)(w2t + nt * 16 * 64 + ks * 32), ba = *(const bf16x8*)(a2t + nt * 16 * 64 + ks * 32);
                    dw = __builtin_amdgcn_mfma_f32_16x16x32_bf16(aw[ks], bw, dw, 0, 0, 0); da = __builtin_amdgcn_mfma_f32_16x16x32_bf16(aa[ks], ba, da, 0, 0, 0); }
                if (fq < 2) { const int ch = wv * 128 + nt * 16 + fr;
#pragma unroll
                    for (int r = 0; r < 4; ++r) *(LAS f32x2*)(lwla + ((fq * 4 + r) * 1024 + ch) * 2) = (f32x2){dw[r], da[r]}; }
            }
        }
        __syncthreads();
        float lw[8][2], la[8][2];
        { const f32x2 w0v = *(const f32x2*)(P_W0 + l * 1024 + c), a0v = *(const f32x2*)(P_A0 + l * 1024 + c);
#pragma unroll
          for (int t = 0; t < 8; ++t) { const f32x4 v = *(const LAS f32x4*)(lwla + (t * 1024 + c) * 2);
              lw[t][0] = w0v[0] + v[0]; la[t][0] = a0v[0] + v[1]; lw[t][1] = w0v[1] + v[2]; la[t][1] = a0v[1] + v[3]; } }
        {
            const f32x2 kkv = *(const f32x2*)(P_K_K + l * 1024 + c), kav = *(const f32x2*)(P_K_A + l * 1024 + c);
            const int hh = c >> 6, cc = c & 63;
#pragma unroll
            for (int t = 0; t < 8; ++t) {
                float dec[2], ag[2], kk[2], kp[2];
#pragma unroll
                for (int e = 0; e < 2; ++e) { const float y = -lw[t][e]; const float sp = fmaxf(y, 0.f) + __logf(1.f + __expf(-fabsf(y)));
                    const float wl = -sp - 0.5f; dec[e] = __expf(-__expf(wl)); ag[e] = sigmoidf_(la[t][e]); kk[e] = km[t][e] * kkv[e]; kp[e] = km[t][e] * (1.f + (ag[e] - 1.f) * kav[e]); }
                const float ss = red32(kk[0] * kk[0] + kk[1] * kk[1]);
                const float inv = __builtin_amdgcn_rsqf(fmaxf(ss, 1e-24f));
                float* rc = P_REC + ((size_t)(row0 + t) * 16 + hh) * RECF;
                u32x4 pkd; pkd[0] = pk_bf16(rm[t][0], rm[t][1]); pkd[1] = pk_bf16(kp[0], kp[1]); pkd[2] = pk_bf16(-kk[0] * inv, -kk[1] * inv); pkd[3] = pk_bf16(kk[0] * inv * ag[0], kk[1] * inv * ag[1]);
                *(u32x4*)(rc + (cc >> 1) * 4) = pkd;
                *(f32x4*)(rc + 128 + (cc >> 1) * 4) = (f32x4){dec[0], dec[1], vm[t][0], vm[t][1]};
            }
        }
        {
            float x[8][2];
#pragma unroll
            for (int t = 0; t < 8; ++t) { x[t][0] = bflo(vgw[t]); x[t][1] = bfhi(vgw[t]); }
#pragma unroll
            for (int t = 0; t < 8; ++t) { const float s1 = red64(x[t][0] + x[t][1]), s2 = red64(x[t][0] * x[t][0] + x[t][1] * x[t][1]);
                if (lane == 0) { red[wv * 16 + t] = s1; red[wv * 16 + 8 + t] = s2; } }
            __syncthreads();
            const f32x2 gv = *(const f32x2*)(P_SGU_LN_G + l * 1024 + c), bv = *(const f32x2*)(P_SGU_LN_B + l * 1024 + c);
            float vn[8][2];
#pragma unroll
            for (int t = 0; t < 8; ++t) { float s1 = 0.f, s2 = 0.f;
#pragma unroll
                for (int w = 0; w < 8; ++w) { s1 += red[w * 16 + t]; s2 += red[w * 16 + 8 + t]; }
                const float mean = s1 * (1.f / 1024.f), var = fmaxf(s2 * (1.f / 1024.f) - mean * mean, 0.f), rstd = rsqrtf(var + 1e-5f);
                vn[t][0] = (x[t][0] - mean) * rstd * gv[0] + bv[0]; vn[t][1] = (x[t][1] - mean) * rstd * gv[1] + bv[1]; }
#pragma unroll
            for (int e = 0; e < 2; ++e) { u32x4 o; o[0] = pk_bf16(vn[0][e], vn[1][e]); o[1] = pk_bf16(vn[2][e], vn[3][e]); o[2] = pk_bf16(vn[4][e], vn[5][e]); o[3] = pk_bf16(vn[6][e], vn[7][e]);
                if (samp) *(u32x4*)(P_VNTS + ((size_t)sb * 1024 + c + e) * 8) = o;
                else *(u32x4*)(P_VNT + (((size_t)(pb * 16 + (t0 >> 7)) * 16 + ((t0 & 127) >> 3)) * 1024 + c + e) * 8) = o; }
            if (samp) {
#pragma unroll
                for (int t = 0; t < 8; ++t) *(f32x2*)(p.out + O_CV + ((size_t)(l * 128 + sb) * 8 + t) * 1024 + c) = (f32x2){vn[t][0], vn[t][1]};
            }
        }
        if (samp) { for (int col = tid; col < DSH; col += 512) p.out[O_SHS + (size_t)(l * 128 + sb) * DSH + col] = bf2f(zr[(size_t)7 * NP + col]); }
        else if (t0 == 2040) { for (int col = tid; col < DSH; col += 512) p.out[O_SHP + (size_t)(l * 4 + pb) * DSH + col] = bf2f(zr[(size_t)7 * NP + col]); }
        __syncthreads();
    }
}

#define WAVE_SYNC() do { asm volatile("s_waitcnt lgkmcnt(0)" ::: "memory"); __builtin_amdgcn_wave_barrier(); } while (0)
__device__ __forceinline__ float dot4(const f32x4 a, const f32x4 b) { return a[0] * b[0] + a[1] * b[1] + a[2] * b[2] + a[3] * b[3]; }

__device__ void scan_prompt_unit(const Params& p, int l, int unit, int wv, int lane, LAS float* lw) {
    const int bh = unit >> 2, b = bh >> 4, h = bh & 15;
    const int rg = lane >> 4, kq = lane & 15;
    const int v0 = (unit & 3) * 16 + wv * 4 + rg;
    const float* recb = P_REC + ((size_t)(b * 2048) * 16 + h) * RECF;
    float* yb = P_YBUF + (size_t)(b * 2048) * 1024 + h * 64 + v0;
    constexpr size_t TS = 16 * RECF;
    LAS float* lv = lw + 16 * 5 * 64;
    LAS float* ly = lv + 64;
    f32x4 s = (f32x4){0.f, 0.f, 0.f, 0.f};
    u32x2 nxA[4][4], nxB[4][4]; f32x4 nwA[4], nwB[4]; float nvA, nvB;
#define SCAN_LOAD_BATCH(nx, nw, nv, tb_) do { \
        _Pragma("unroll") for (int j = 0; j < 4; ++j) { const float* rp = recb + (size_t)((tb_) + rg + 4 * j) * TS; \
            const u32x4 q0 = *(const u32x4*)(rp + kq * 8), q1 = *(const u32x4*)(rp + kq * 8 + 4);     \
            nx[j][0] = (u32x2){q0[0], q1[0]}; nx[j][1] = (u32x2){q0[1], q1[1]}; nx[j][2] = (u32x2){q0[2], q1[2]}; nx[j][3] = (u32x2){q0[3], q1[3]}; \
            const f32x2 w0 = *(const f32x2*)(rp + 128 + kq * 8), w1 = *(const f32x2*)(rp + 128 + kq * 8 + 4); nw[j] = (f32x4){w0[0], w0[1], w1[0], w1[1]}; } \
        nv = recb[(size_t)((tb_) + kq) * TS + 128 + (v0 >> 1) * 4 + 2 + (v0 & 1)]; } while (0)
#define BF4(u) ((f32x4){bflo((u)[0]), bfhi((u)[0]), bflo((u)[1]), bfhi((u)[1])})
#define SCAN_BATCH(nx, nw, nv, tb_) do { \
        WAVE_SYNC(); \
        _Pragma("unroll") for (int j = 0; j < 4; ++j) { LAS float* ls = lw + (rg + 4 * j) * 5 * 64 + kq * 4;     \
            *(LAS f32x4*)(ls) = BF4(nx[j][0]); *(LAS f32x4*)(ls + 64) = nw[j]; *(LAS f32x4*)(ls + 128) = BF4(nx[j][1]); *(LAS f32x4*)(ls + 192) = BF4(nx[j][2]); *(LAS f32x4*)(ls + 256) = BF4(nx[j][3]); } \
        lv[kq * 4 + rg] = nv; \
        WAVE_SYNC(); \
        if ((tb_) + 32 < 2048) SCAN_LOAD_BATCH(nx, nw, nv, (tb_) + 32); \
        f32x4 a4 = *(const LAS f32x4*)(lw + 3 * 64 + kq * 4); \
        float pa = dot4(s, a4), py = 0.f; \
        _Pragma("unroll") for (int q = 0; q < 16; ++q) { \
            const LAS float* lc = lw + q * 5 * 64 + kq * 4; \
            const f32x4 w4 = *(const LAS f32x4*)(lc + 64), k4 = *(const LAS f32x4*)(lc + 128), b4 = *(const LAS f32x4*)(lc + 256), r4 = *(const LAS f32x4*)(lc); \
            const float vv = lv[q * 4 + rg]; \
            f32x4 a4n = a4; \
            if (q < 15) a4n = *(const LAS f32x4*)(lc + 5 * 64 + 192); \
            if (q > 0) { red16x2(pa, py); ly[(q - 1) * 4 + rg] = py; } else pa = red16(pa); \
            s = s * w4 + vv * k4 + pa * b4; \
            py = dot4(s, r4); \
            if (q < 15) pa = dot4(s, a4n); \
            a4 = a4n; } \
        py = red16(py); ly[15 * 4 + rg] = py; \
        asm volatile("s_waitcnt lgkmcnt(0)" ::: "memory"); \
        yb[(size_t)((tb_) + kq) * 1024] = ly[kq * 4 + rg]; } while (0)
    SCAN_LOAD_BATCH(nxA, nwA, nvA, 0);
    SCAN_LOAD_BATCH(nxB, nwB, nvB, 16);
    for (int tb = 0; tb < 2048; tb += 32) {
        SCAN_BATCH(nxA, nwA, nvA, tb);
        SCAN_BATCH(nxB, nwB, nvB, tb + 16);
    }
#undef SCAN_BATCH
#undef SCAN_LOAD_BATCH
#undef BF4
    *(f32x4*)(p.out + O_WKVP + ((size_t)((l * 4 + b) * 16 + h) * 64 + v0) * 64 + kq * 4) = s;
}

__device__ void scan_sample_item(const Params& p, int l, int item, int lane, LAS float* lw) {
    const int b = item >> 4, h = item & 15;
    const int rg = lane >> 4, kq = lane & 15;
    const size_t sbase = (size_t)((l * 128 + b) * 16 + h) * 4096;
    const float* S0 = P_STATE_WKV + sbase;
    f32x4 s[16];
#pragma unroll
    for (int i = 0; i < 16; ++i) s[i] = *(const f32x4*)(S0 + (rg * 16 + i) * 64 + kq * 4);
    const float* recb = P_REC + ((size_t)(MP + b * 8) * 16 + h) * RECF;
    float nx[6];
#define SAMPLE_LOAD(rp_) do { const bf16_t* rb = (const bf16_t*)(rp_) + (lane >> 1) * 8 + (lane & 1); const float* rf = (rp_) + 128 + (lane >> 1) * 4 + (lane & 1); \
        nx[0] = bf2f(rb[0]); nx[2] = bf2f(rb[2]); nx[4] = bf2f(rb[4]); nx[5] = bf2f(rb[6]); nx[1] = rf[0]; nx[3] = rf[2]; } while (0)
    SAMPLE_LOAD(recb);
    for (int t = 0; t < 8; ++t) {
        WAVE_SYNC();
#pragma unroll
        for (int j = 0; j < 6; ++j) lw[j * 64 + lane] = nx[j];
        WAVE_SYNC();
        if (t < 7) SAMPLE_LOAD(recb + (size_t)(t + 1) * 16 * RECF);
        const f32x4 r4 = *(const LAS f32x4*)(lw + 0 * 64 + kq * 4), w4 = *(const LAS f32x4*)(lw + 1 * 64 + kq * 4), k4 = *(const LAS f32x4*)(lw + 2 * 64 + kq * 4),
                    a4 = *(const LAS f32x4*)(lw + 4 * 64 + kq * 4), b4 = *(const LAS f32x4*)(lw + 5 * 64 + kq * 4);
        float ysel = 0.f;
#pragma unroll
        for (int i4 = 0; i4 < 4; ++i4) {
            const f32x4 vv = *(const LAS f32x4*)(lw + 3 * 64 + rg * 16 + i4 * 4);
#pragma unroll
            for (int ii = 0; ii < 4; ++ii) { const int i = i4 * 4 + ii;
                const float sa = red16(dot4(s[i], a4));
                s[i] = s[i] * w4 + vv[ii] * k4 + sa * b4;
                const float y = red16(dot4(s[i], r4));
                ysel = (kq == i) ? y : ysel; }
        }
        P_YBUF[(size_t)(MP + b * 8 + t) * 1024 + h * 64 + rg * 16 + kq] = ysel;
    }
    float* So = p.out + O_WKVS + sbase;
#pragma unroll
    for (int i = 0; i < 16; ++i) *(f32x4*)(So + (rg * 16 + i) * 64 + kq * 4) = s[i];
}

__device__ void sgu_prompt_item(const Params& p, int l, int item, int lane) {
    const int slab = item & 7, g = (item >> 3) & 7, bc = item >> 6;
    const int fr = lane & 15, fq = lane >> 4;
    bf16x8 vf[4];
#pragma unroll
    for (int ks = 0; ks < 4; ++ks) vf[ks] = *(const bf16x8*)(P_VNT + (((size_t)bc * 16 + ks * 4 + fq) * 1024 + g * 128 + slab * 16 + fr) * 8);
    const float* Wg = P_SGU_W + (size_t)(l * 8 + g) * 16384;
    const float* bg = P_SGU_B + (size_t)(l * 8 + g) * 128;
    const int ch = g * 128 + slab * 16 + fq * 4;
#pragma unroll
    for (int tt = 0; tt < 8; ++tt) {
        f32x4 acc = (f32x4){0.f, 0.f, 0.f, 0.f};
        const int t = tt * 16 + fr;
#pragma unroll
        for (int ks = 0; ks <= tt / 2; ++ks) {
            const int s0 = ks * 32 + fq * 8;
            const f32x4 wa = *(const f32x4*)(Wg + t * 128 + s0), wb = *(const f32x4*)(Wg + t * 128 + s0 + 4);
            float wv[8] = {wa[0], wa[1], wa[2], wa[3], wb[0], wb[1], wb[2], wb[3]};
#pragma unroll
            for (int j = 0; j < 8; ++j) wv[j] = (s0 + j <= t) ? wv[j] : 0.f;
            u32x4 pk; pk[0] = pk_bf16(wv[0], wv[1]); pk[1] = pk_bf16(wv[2], wv[3]); pk[2] = pk_bf16(wv[4], wv[5]); pk[3] = pk_bf16(wv[6], wv[7]);
            bf16x8 wf; __builtin_memcpy(&wf, &pk, 16);
            acc = __builtin_amdgcn_mfma_f32_16x16x32_bf16(vf[ks], wf, acc, 0, 0, 0);
        }
        const size_t row = (size_t)bc * 128 + t;
        const float sbv = bg[t];
        const u32x2 uu = *(const u32x2*)(P_Z + row * NP + C_U + ch), gg = *(const u32x2*)(P_Z + row * NP + C_GG + ch);
        const float o0 = bflo(uu[0]) * (acc[0] + sbv) * siluf_(bflo(gg[0])), o1 = bfhi(uu[0]) * (acc[1] + sbv) * siluf_(bfhi(gg[0]));
        const float o2 = bflo(uu[1]) * (acc[2] + sbv) * siluf_(bflo(gg[1])), o3 = bfhi(uu[1]) * (acc[3] + sbv) * siluf_(bfhi(gg[1]));
        u32x2 o; o[0] = pk_bf16(o0, o1); o[1] = pk_bf16(o2, o3);
        *(u32x2*)(P_YAB + row * DM + 1024 + ch) = o;
    }
}

__device__ void sgu_sample_item(const Params& p, int l, int item, int lane) {
    const int b = item >> 4, ch = (item & 15) * 64 + lane, g = ch >> 7;
    const u32x4 vv = *(const u32x4*)(P_VNTS + ((size_t)b * 1024 + ch) * 8);
    float vn[8] = {bflo(vv[0]), bfhi(vv[0]), bflo(vv[1]), bfhi(vv[1]), bflo(vv[2]), bfhi(vv[2]), bflo(vv[3]), bfhi(vv[3])};
    const float* Wg = P_SGU_W + (size_t)(l * 8 + g) * 16384;
    const float* bg = P_SGU_B + (size_t)(l * 8 + g) * 128;
#pragma unroll
    for (int t = 0; t < 8; ++t) {
        float sacc = bg[t];
#pragma unroll
        for (int s = 0; s <= t; ++s) sacc += Wg[t * 128 + s] * vn[s];
        const size_t row = (size_t)MP + b * 8 + t;
        const float u = bf2f(P_Z[row * NP + C_U + ch]), gg = bf2f(P_Z[row * NP + C_GG + ch]);
        const float o = u * sacc * siluf_(gg);
        P_YAB[row * DM + 1024 + ch] = (bf16_t)(pk_bf16(o, 0.f) & 0xffffu);
    }
}

__device__ void phase_scan(const Params& p, int l) {
    const int tid = otid(), lane = tid & 63, wv = __builtin_amdgcn_readfirstlane(tid >> 6);
    LAS float* lw = (wv < 4) ? (LAS float*)smem_raw + wv * 6144 : (LAS float*)smem_raw + 24576 + (wv - 4) * 2048;
#ifndef REP_PR
#define REP_PR 1
#endif
#ifndef REP_IT
#define REP_IT 1
#endif
    if (wv < 4) {
      for (int rr = 0; rr < REP_PR; ++rr)
        for (int u0 = blockIdx.x; u0 < 256; u0 += gridDim.x) { const int unit = (gridDim.x == 256) ? ((u0 & 7) * 32 + (u0 >> 3)) : u0; scan_prompt_unit(p, l, unit, wv, lane, lw); }
    } else {
        const int nw = gridDim.x * 4;
      for (int rr = 0; rr < REP_IT; ++rr)
        for (int it = blockIdx.x * 4 + (wv - 4); it < 2048 + 4096 + 2048; it += nw) {
            if (it < 2048) scan_sample_item(p, l, it, lane, lw);
            else if (it < 6144) sgu_prompt_item(p, l, it - 2048, lane);
            else sgu_sample_item(p, l, it - 6144, lane);
        }
        if (l + 1 < DEPTH) phase_convert(p, l + 1, blockIdx.x * 4 + (wv - 4), nw);
    }
}

__device__ void phase_post(const Params& p, int l) {
    const int lane = otid() & 63, gw = blockIdx.x * 8 + (otid() >> 6), nw = gridDim.x * 8;
    const int hg = lane >> 4, kq = lane & 15;
    for (int it = gw; it < MT * 4; it += nw) {
        const int row = it >> 2, h = (it & 3) * 4 + hg, ch = h * 64 + kq * 4;
        const f32x4 y = *(const f32x4*)(P_YBUF + (size_t)row * 1024 + ch);
        const float* rc = P_REC + ((size_t)row * 16 + h) * RECF;
        const u32x2 p0 = *(const u32x2*)(rc + kq * 8), p1 = *(const u32x2*)(rc + kq * 8 + 4);
        const f32x2 va = *(const f32x2*)(rc + 128 + kq * 8 + 2), vb = *(const f32x2*)(rc + 128 + kq * 8 + 6);
        const f32x4 r4 = (f32x4){bflo(p0[0]), bfhi(p0[0]), bflo(p1[0]), bfhi(p1[0])}, k4 = (f32x4){bflo(p0[1]), bfhi(p0[1]), bflo(p1[1]), bfhi(p1[1])}, v4 = (f32x4){va[0], va[1], vb[0], vb[1]};
        const f32x4 rk = *(const f32x4*)(P_R_K + (size_t)l * 1024 + ch);
        const float mean = red16(y[0] + y[1] + y[2] + y[3]) * (1.f / 64.f);
        const f32x4 d = y - mean;
        const float var = red16(dot4(d, d)) * (1.f / 64.f);
        const float rs = rsqrtf(var + 64e-5f);
        const float srk = red16(r4[0] * k4[0] * rk[0] + r4[1] * k4[1] * rk[1] + r4[2] * k4[2] * rk[2] + r4[3] * k4[3] * rk[3]);
        const f32x4 lg = *(const f32x4*)(P_LNX_G + (size_t)l * 1024 + ch), lb = *(const f32x4*)(P_LNX_B + (size_t)l * 1024 + ch);
        const u32x2 gr = *(const u32x2*)(P_Z + (size_t)row * NP + C_GR + ch);
        const f32x4 yo = d * rs * lg + lb + srk * v4;
        u32x2 o; o[0] = pk_bf16(yo[0] * siluf_(bflo(gr[0])), yo[1] * siluf_(bfhi(gr[0]))); o[1] = pk_bf16(yo[2] * siluf_(bflo(gr[1])), yo[3] * siluf_(bfhi(gr[1])));
        *(u32x2*)(P_YAB + (size_t)row * DM + ch) = o;
    }
}


#define XB_TMO      128
#define XB_XCNT(j)  (256  + 64 * (j))
#define XB_XSUB(j)  (1280 + 64 * (j))
#define XB_XGEN(j)  (2304 + 64 * (j))
#define XB_TOP      3328
#define XB_TOPGEN   3392
#define XCD_BAR_WORDS 3456
#define XB_SPIN_CAP (1u << 20)
__device__ __forceinline__ unsigned xb_ld(unsigned* p)              { return __hip_atomic_load(p, __ATOMIC_RELAXED, __HIP_MEMORY_SCOPE_AGENT); }
__device__ __forceinline__ unsigned xb_add(unsigned* p, unsigned v) { return __hip_atomic_fetch_add(p, v, __ATOMIC_RELAXED, __HIP_MEMORY_SCOPE_AGENT); }
__device__ __forceinline__ unsigned xb_xcc_id() { return (unsigned)__builtin_amdgcn_s_getreg((3 << 11) | 20) & 0xFu; }
#define XB_SPIN(cond, bar) do { unsigned _sp = 0; while (cond) { __builtin_amdgcn_s_sleep(1); \
    if ((++_sp & 255u) == 0u) { if (xb_ld(&(bar)[XB_TMO])) break; if (_sp > XB_SPIN_CAP) { atomicAdd(&(bar)[XB_TMO], 1u); break; } } } } while (0)
struct XcdBarrier { unsigned* bar; unsigned x; volatile LAS unsigned* st; };
__device__ __forceinline__ XcdBarrier xcd_barrier_post(unsigned* bar, volatile LAS unsigned* st) {
    XcdBarrier b; b.bar = bar; b.x = xb_xcc_id(); b.st = st;
    if (threadIdx.x == 0) (void)xb_add(&bar[XB_XCNT(b.x)], 1u);
    return b;
}
__device__ __forceinline__ void xcd_barrier_complete(unsigned* bar, unsigned x, unsigned& nloc, unsigned& nx) {
    const unsigned G = gridDim.x * gridDim.y * gridDim.z;
    unsigned sum, cnt, mine, sp = 0u;
    for (;;) {
        sum = 0u; cnt = 0u; mine = 0u;
#pragma unroll
        for (unsigned j = 0; j < 16; ++j) { const unsigned c = xb_ld(&bar[XB_XCNT(j)]); sum += c; cnt += (c > 0u) ? 1u : 0u; mine = (j == x) ? c : mine; }
        if (sum == G) break;
        __builtin_amdgcn_s_sleep(1);
        if ((++sp & 255u) == 0u) { if (xb_ld(&bar[XB_TMO])) break; if (sp > XB_SPIN_CAP) { atomicAdd(&bar[XB_TMO], 1u); break; } }
    }
    nloc = mine > 0u ? mine : 1u; nx = cnt > 0u ? cnt : 1u;
}
__device__ __forceinline__ void xcd_barrier(const XcdBarrier& b) {
    asm volatile("s_waitcnt vmcnt(0)" ::: "memory");
    __syncthreads();
    if (threadIdx.x == 0) {
        unsigned* bar = b.bar;
        __builtin_amdgcn_s_waitcnt(0);
        unsigned nloc = b.st[0], nx = b.st[1];
        if (nloc == 0u) { xcd_barrier_complete(bar, b.x, nloc, nx); b.st[0] = nloc; b.st[1] = nx; }
        const unsigned old = xb_add(&bar[XB_XSUB(b.x)], 1u);
        const unsigned gen = old / nloc;
        if (old + 1u == (gen + 1u) * nloc) {
            __builtin_amdgcn_fence(__ATOMIC_RELEASE, "agent");
            asm volatile("s_waitcnt vmcnt(0)" ::: "memory");
            const unsigned og = xb_add(&bar[XB_TOP], 1u);
            const unsigned tg = og / nx;
            if (og + 1u == (tg + 1u) * nx) xb_add(&bar[XB_TOPGEN], 1u);
            else XB_SPIN(xb_ld(&bar[XB_TOPGEN]) == tg, bar);
            __builtin_amdgcn_fence(__ATOMIC_ACQUIRE, "agent");
            xb_add(&bar[XB_XGEN(b.x)], 1u);
            asm volatile("s_waitcnt vmcnt(0)" ::: "memory");
        } else {
            XB_SPIN(xb_ld(&bar[XB_XGEN(b.x)]) == gen, bar);
            __builtin_amdgcn_fence(__ATOMIC_ACQUIRE, "agent");
            asm volatile("s_waitcnt vmcnt(0)" ::: "memory");
        }
    }
    __syncthreads();
}

template <int ST> __device__ __forceinline__ void run_stage(const Params& p, int l) {
    LAS unsigned char* lds = (LAS unsigned char*)smem_raw;
    pg8::StaticOrder S;
    if (ST == 7) { { const int gw = blockIdx.x * 8 + (otid() >> 6), lane = otid() & 63;
                     if (gw < 128) { const int l2 = gw >> 5, m2 = (gw >> 4) & 1, u2 = gw & 15;
                         conv_unit((m2 ? P_A2 : P_W2) + (size_t)l2 * 64 * 1024, 64, 1024, 1024, (m2 ? P_A2T : P_W2T) + (size_t)l2 * 1024 * 64, 64, u2, lane); } }
                   { const f32x4* xs = (const f32x4*)P_X_SAMPLE; f32x4* hd = (f32x4*)(P_H + (size_t)MP * DM);
                     for (int i = blockIdx.x * 512 + otid(); i < MS * DM / 4; i += gridDim.x * 512) hd[i] = xs[i]; }
                   phase_convert(p, 0, blockIdx.x * 8 + (otid() >> 6), gridDim.x * 8); phase_rmsnorm(P_X_PROMPT, P_X_SAMPLE, P_NORM_G, P_XN, nullptr, nullptr, nullptr); }
    if (ST == 0) { pg8::Gemm g{P_XN, P_WINT + (size_t)l * NP * DM, MT, NP, DM}; S.init(MT, NP, DM, gridDim.x, blockIdx.x); EpiZ e{P_Z}; pg8::gemm_phase(lds, g, S, e); }
    if (ST == 1) phase_prep(p, l);
    if (ST == 2) phase_scan(p, l);
    if (ST == 3) phase_post(p, l);
    if (ST == 4) { pg8::Gemm g{P_YAB, P_PABT + (size_t)l * DM * DM, MT, DM, DM}; S.init(MT, DM, DM, gridDim.x, blockIdx.x, 1, MP / 256); S.tail_full = 1; EpiMerge e{P_Z, P_M, (unsigned*)(p.ws + WS_BAR) + RDY_W0}; pg8::gemm_phase(lds, g, S, e); }
    if (ST == 5) { pg8::Gemm g{P_M, P_WOT + (size_t)l * DM * DM, MT, DM, DM}; S.init(MT, DM, DM, gridDim.x, blockIdx.x, 0, MP / 256);
                   S.tail_shift = 64; S.ready = (unsigned*)(p.ws + WS_BAR) + RDY_W0; S.need = 64u * (unsigned)(l + 1);
                   EpiOut e{l == 0 ? P_X_PROMPT : P_H, P_H + (size_t)MP * DM, P_H, P_PART}; pg8::gemm_phase(lds, g, S, e); }
    if (ST == 6) { if (l < DEPTH - 1) phase_rmsnorm(P_H, P_H + (size_t)MP * DM, P_NORM_G + (size_t)(l + 1) * DM, P_XN, nullptr, P_PART, P_H + (size_t)MP * DM);
                   else phase_rmsnorm(P_H, P_H + (size_t)MP * DM, P_FINAL_G, nullptr, p.out + O_YP, P_PART, P_H + (size_t)MP * DM); }
}

#if MK_SINGLE
#ifndef REP0
#define REP0 1
#endif
#ifndef REP1
#define REP1 1
#endif
#ifndef REP2
#define REP2 1
#endif
#ifndef REP3
#define REP3 1
#endif
#ifndef REP4
#define REP4 1
#endif
#ifndef REP6
#define REP6 1
#endif
#ifndef REP7
#define REP7 1
#endif
__global__ void __launch_bounds__(512, 2) mega(Params p) {
    cg::grid_group grid = cg::this_grid();
    __shared__ uint4 xb_words;
    if (threadIdx.x == 0) xb_words = make_uint4(0u, 0u, 0u, 0u);
    __syncthreads();
    const XcdBarrier xb = xcd_barrier_post((unsigned*)(p.ws + WS_BAR), (volatile LAS unsigned*)&xb_words);
#define GSYNC() xcd_barrier(xb)
    for (int r = 0; r < REP7; ++r) { run_stage<7>(p, 0); grid.sync(); }
    for (int l = 0; l < DEPTH; ++l) {
        for (int r = 0; r < REP0; ++r) { run_stage<0>(p, l); GSYNC(); }
        for (int r = 0; r < REP1; ++r) { run_stage<1>(p, l); GSYNC(); }
        for (int r = 0; r < REP2; ++r) { run_stage<2>(p, l); GSYNC(); }
        for (int r = 0; r < REP3; ++r) { run_stage<3>(p, l); GSYNC(); }
        for (int r = 0; r < REP4; ++r) { run_stage<4>(p, l); }
        run_stage<5>(p, l); GSYNC();
        for (int r = 0; r < REP6; ++r) { run_stage<6>(p, l); if (l + 1 < DEPTH || r + 1 < REP6) GSYNC(); }
    }
}
#else
template <int ST> __global__ void __launch_bounds__(512, 2) stage_k(Params p, int l) { run_stage<ST>(p, l); }
#endif

template <class K> static void set_lds(K k, size_t bytes) { (void)hipFuncSetAttribute((const void*)k, hipFuncAttributeMaxDynamicSharedMemorySize, (int)bytes); }

extern "C" void kernel_launch(void* const* d_in, const int* in_sizes, int n_in, void* d_out, int out_size, void* d_ws, size_t ws_size, hipStream_t stream) {
    constexpr size_t kDynLds = 131072;
    static int grid_blocks = 0;
    if (!grid_blocks) {
        int dev = 0, cus = 0;
        (void)hipGetDevice(&dev);
        (void)hipDeviceGetAttribute(&cus, hipDeviceAttributeMultiprocessorCount, dev);
#if MK_SINGLE
        int per_cu = 0;
        set_lds(mega, kDynLds);
        (void)hipOccupancyMaxActiveBlocksPerMultiprocessor(&per_cu, mega, 512, kDynLds);
        if (per_cu < 1) fprintf(stderr, "occupancy query returned %d\n", per_cu);
#else
        set_lds(stage_k<0>, kDynLds); set_lds(stage_k<1>, kDynLds); set_lds(stage_k<2>, kDynLds); set_lds(stage_k<3>, kDynLds);
        set_lds(stage_k<4>, kDynLds); set_lds(stage_k<5>, kDynLds); set_lds(stage_k<6>, kDynLds); set_lds(stage_k<7>, kDynLds);
#endif
        grid_blocks = cus > 0 ? cus : 256;
    }
    Params p{};
    for (int i = 0; i < 24; ++i) p.in[i] = (const float*)d_in[i];
    p.out = (float*)d_out; p.ws = (char*)d_ws;
    if (ws_size < WS_END) fprintf(stderr, "workspace too small: %zu < %zu\n", ws_size, (size_t)WS_END);
#if MK_SINGLE
    (void)hipMemsetAsync(p.ws + WS_BAR, 0, (size_t)XCD_BAR_WORDS_C * 4, stream);
    void* args[] = {&p};
    hipError_t e = hipLaunchCooperativeKernel((void*)mega, dim3(grid_blocks), dim3(512), args, kDynLds, stream);
    if (e != hipSuccess) fprintf(stderr, "cooperative launch failed: %s (grid %d)\n", hipGetErrorString(e), grid_blocks);
#else
    const dim3 G(grid_blocks), B(512);
    hipLaunchKernelGGL(stage_k<7>, G, B, kDynLds, stream, p, 0);
    for (int l = 0; l < DEPTH; ++l) {
        hipLaunchKernelGGL(stage_k<0>, G, B, kDynLds, stream, p, l);
        hipLaunchKernelGGL(stage_k<1>, G, B, kDynLds, stream, p, l);
        hipLaunchKernelGGL(stage_k<2>, G, B, kDynLds, stream, p, l);
        hipLaunchKernelGGL(stage_k<3>, G, B, kDynLds, stream, p, l);
        hipLaunchKernelGGL(stage_k<4>, G, B, kDynLds, stream, p, l);
        hipLaunchKernelGGL(stage_k<5>, G, B, kDynLds, stream, p, l);
        hipLaunchKernelGGL(stage_k<6>, G, B, kDynLds, stream, p, l);
    }
#endif
}
```

```cpp
#include <hip/hip_runtime.h>
#include <hip/hip_cooperative_groups.h>
#include <cstdio>
namespace cg = cooperative_groups;

#ifndef MK_SINGLE
#define MK_SINGLE 1
#endif

#define LAS __attribute__((address_space(3)))
typedef unsigned short bf16_t;
typedef short bf16x8 __attribute__((ext_vector_type(8)));
typedef float f32x4 __attribute__((ext_vector_type(4)));
typedef float f32x2 __attribute__((ext_vector_type(2)));
typedef unsigned u32x4 __attribute__((ext_vector_type(4)));
typedef unsigned u32x2 __attribute__((ext_vector_type(2)));

constexpr int DM = 2048, DEPTH = 4;
constexpr int MP = 8192, MS = 1024, MT = 9216;
constexpr int DSH = 3200;
constexpr int NP = 11520;
constexpr int NIN = 11392;
constexpr int C_R = 0, C_K = 1024, C_V = 2048, C_WD = 3072, C_AD = 3136, C_GR = 3200, C_U = 4224, C_VG = 5248, C_GG = 6272, C_GA = 7296, C_GB = 9344;
constexpr size_t O_YP = 0, O_WKVP = 18874368, O_SHP = 19922944, O_WKVS = 19974144, O_SHS = 53528576, O_CV = 55166976;
constexpr int NPHASE = 1 + 7 * DEPTH;
constexpr int OT_PM0 = 28, OT_ROW0 = OT_PM0 * 256, OT_ROWS = MT - OT_ROW0;

constexpr int RDY_W0 = 3456 + 256;
constexpr int XCD_BAR_WORDS_C = RDY_W0 + 36 * 64;
struct Params { const float* in[24]; float* out; char* ws; };
constexpr size_t al256(size_t x) { return (x + 255) & ~(size_t)255; }
constexpr size_t WS_WINT = 0;
constexpr size_t WS_PABT = WS_WINT + al256((size_t)DEPTH * NP * DM * 2);
constexpr size_t WS_WOT = WS_PABT + al256((size_t)DEPTH * DM * DM * 2);
constexpr size_t WS_XN = WS_WOT + al256((size_t)DEPTH * DM * DM * 2);
constexpr size_t WS_Z = WS_XN + al256((size_t)MT * DM * 2);
constexpr size_t WS_VNT = WS_Z + al256((size_t)MT * NP * 2);
constexpr size_t WS_VNTS = WS_VNT + al256((size_t)64 * 1024 * 128 * 2);
constexpr size_t WS_YAB = WS_VNTS + al256((size_t)128 * 1024 * 8 * 2);
constexpr size_t WS_M = WS_YAB + al256((size_t)MT * DM * 2);
constexpr size_t WS_H = WS_M + al256((size_t)MT * DM * 2);
constexpr size_t WS_REC = WS_H + al256((size_t)MT * DM * 4);
constexpr int RECF = 256;
constexpr size_t WS_YBUF = WS_REC + al256((size_t)MT * 16 * RECF * 4);
constexpr size_t WS_PART = WS_YBUF + al256((size_t)MT * 1024 * 4);
constexpr size_t WS_W2T = WS_PART + al256((size_t)2 * OT_ROWS * DM * 4);
constexpr size_t WS_A2T = WS_W2T + al256((size_t)DEPTH * 1024 * 64 * 2);
constexpr size_t WS_BAR = WS_A2T + al256((size_t)DEPTH * 1024 * 64 * 2);
constexpr size_t WS_END = WS_BAR + al256((size_t)XCD_BAR_WORDS_C * 4);
#define P_X_PROMPT (p.in[0])
#define P_X_SAMPLE (p.in[1])
#define P_STATE_WKV (p.in[2])
#define P_STATE_SHIFT (p.in[3])
#define P_NORM_G (p.in[4])
#define P_W_IN (p.in[5])
#define P_SHIFT_MU (p.in[6])
#define P_W0 (p.in[7])
#define P_W2 (p.in[8])
#define P_A0 (p.in[9])
#define P_A2 (p.in[10])
#define P_K_K (p.in[11])
#define P_K_A (p.in[12])
#define P_R_K (p.in[13])
#define P_LNX_G (p.in[14])
#define P_LNX_B (p.in[15])
#define P_SGU_LN_G (p.in[16])
#define P_SGU_LN_B (p.in[17])
#define P_SGU_W (p.in[18])
#define P_SGU_B (p.in[19])
#define P_W_PROJ_A (p.in[20])
#define P_W_PROJ_B (p.in[21])
#define P_W_OUT (p.in[22])
#define P_FINAL_G (p.in[23])
#define P_WINT ((bf16_t*)(p.ws + WS_WINT))
#define P_PABT ((bf16_t*)(p.ws + WS_PABT))
#define P_WOT ((bf16_t*)(p.ws + WS_WOT))
#define P_XN ((bf16_t*)(p.ws + WS_XN))
#define P_Z ((bf16_t*)(p.ws + WS_Z))
#define P_VNT ((bf16_t*)(p.ws + WS_VNT))
#define P_VNTS ((bf16_t*)(p.ws + WS_VNTS))
#define P_YAB ((bf16_t*)(p.ws + WS_YAB))
#define P_M ((bf16_t*)(p.ws + WS_M))
#define P_H ((float*)(p.ws + WS_H))
#define P_REC ((float*)(p.ws + WS_REC))
#define P_YBUF ((float*)(p.ws + WS_YBUF))
#define P_PART ((float*)(p.ws + WS_PART))
#define P_W2T ((bf16_t*)(p.ws + WS_W2T))
#define P_A2T ((bf16_t*)(p.ws + WS_A2T))

extern __shared__ __attribute__((aligned(16))) unsigned char smem_raw[];

__device__ __forceinline__ int otid() { int t = threadIdx.x; asm volatile("" : "+v"(t)); return t; }
__device__ __forceinline__ float bf2f(bf16_t v) { return __uint_as_float(((unsigned)v) << 16); }
__device__ __forceinline__ float bflo(unsigned v) { return __uint_as_float(v << 16); }
__device__ __forceinline__ float bfhi(unsigned v) { return __uint_as_float(v & 0xffff0000u); }
__device__ __forceinline__ unsigned pk_bf16(float lo, float hi) { unsigned r; asm("v_cvt_pk_bf16_f32 %0, %1, %2" : "=v"(r) : "v"(lo), "v"(hi)); return r; }
template <int CTRL> __device__ __forceinline__ float dppf(float x) { return __int_as_float(__builtin_amdgcn_update_dpp(0, __float_as_int(x), CTRL, 0xF, 0xF, true)); }
__device__ __forceinline__ float red16(float x) { x += dppf<0xB1>(x); x += dppf<0x4E>(x); x += dppf<0x141>(x); x += dppf<0x140>(x); return x; }
__device__ __forceinline__ void red16x2(float& x, float& y) { x += dppf<0xB1>(x); y += dppf<0xB1>(y); x += dppf<0x4E>(x); y += dppf<0x4E>(y); x += dppf<0x141>(x); y += dppf<0x141>(y); x += dppf<0x140>(x); y += dppf<0x140>(y); }
__device__ __forceinline__ float red32(float x) { x = red16(x); x += __shfl_xor(x, 16); return x; }
__device__ __forceinline__ float red64(float x) { x = red16(x); x += __shfl_xor(x, 16); x += __shfl_xor(x, 32); return x; }
__device__ __forceinline__ float sigmoidf_(float x) { return __builtin_amdgcn_rcpf(1.f + __expf(-x)); }
__device__ __forceinline__ float tanhf_(float x) { const float e = __expf(2.f * fminf(fmaxf(x, -15.f), 15.f)); return 1.f - 2.f * __builtin_amdgcn_rcpf(1.f + e); }
__device__ __forceinline__ float siluf_(float x) { return x * __builtin_amdgcn_rcpf(1.f + __expf(-x)); }

namespace pg8 {
constexpr int TAILK = 2;
constexpr int BM = 256, BK = 64, HALF = 128, HTB = HALF * BK * 2, STAGE_BYTES = 8 * HTB, NXCD = 8, WGM = 8;
__device__ __forceinline__ int lds_byte(int r, int c) { const int st = (r >> 4) * 2 + (c >> 5), rr = r & 15, cc = c & 31, ob = rr * 64 + cc * 2; return st * 1024 + (ob ^ (((ob >> 9) & 1) << 5)); }
__device__ __forceinline__ void stage_rc(int b, int& R, int& C) { const int st = b / 1024, sb = b % 1024, swz = sb ^ (((sb >> 9) & 1) << 5); R = (st >> 1) * 16 + swz / 64; C = (st & 1) * 32 + (swz % 64) / 2; }
__device__ __forceinline__ int perm32(int rho) { const int n = rho >> 4, i = rho & 15; return 8 * (i >> 2) + 4 * n + (i & 3); }
struct Unit { int pm, pn, seg, nt, kofs; };
struct Gemm { const bf16_t* A; const bf16_t* Bt; int M, N, K; };
struct StaticOrder {
    int nM, nN, nwg, G, c;
    __device__ void init(int M, int N, int K, int G_, int c_, int split_ = 0, int tail_pm0_ = 0) { nM = M / BM; nN = N / BM; nwg = nM * nN; G = G_; c = c_; split = split_; ntk = K / BK; tail_pm0 = tail_pm0_;
        tail_full = 0; tail_shift = 0; rot = 0; tail_base = -1; ready = nullptr; need = 0u; }
    int split, ntk;
    int tail_pm0, tail_full, tail_shift, rot, tail_base;
    unsigned* ready; unsigned need;
    __device__ static void map(int wgid, int nM_, int nN_, int& pm, int& pn) {
        const int nw_ = nM_ * nN_; { const int q = nw_ / NXCD, r = nw_ % NXCD, xcd = wgid % NXCD, off = wgid / NXCD; wgid = (xcd < r ? xcd * (q + 1) : r * (q + 1) + (xcd - r) * q) + off; }
        const int nig = WGM * nN_, gid = wgid / nig, fm = gid * WGM, gsz = (nM_ - fm) < WGM ? (nM_ - fm) : WGM;
        pm = fm + ((wgid % nig) % gsz); pn = (wgid % nig) / gsz;
    }
    __device__ bool next(int i, Unit& u) const {
        const int sg = split ? (i & 1) : 0; if (split) i >>= 1;
        const long L = (long)i * G + (rot ? (c + G - rot) % G : c);
        if (tail_pm0 > 0) {
            const int nmain = tail_pm0 * nN, tb = tail_base >= 0 ? tail_base : nmain;
            if (L < nmain && (tail_base < 0 || L < tail_base)) { map((int)L, tail_pm0, nN, u.pm, u.pn); u.seg = sg; u.nt = split ? ntk / 2 : ntk; u.kofs = sg * u.nt; return true; }
            const long sidx = L - tb - tail_shift; if (sidx < 0) return false;
            if (tail_full) { if (sidx >= (long)(nM - tail_pm0) * nN) return false;
                u.pm = tail_pm0 + (int)sidx / nN; u.pn = (int)sidx % nN; u.seg = sg; u.nt = split ? ntk / 2 : ntk; u.kofs = sg * u.nt; return true; }
            if (sidx >= (long)(nM - tail_pm0) * nN * TAILK) return false;
            const int tt = (int)(sidx / TAILK), sl = (int)(sidx % TAILK); u.pm = tail_pm0 + tt / nN; u.pn = tt % nN; u.seg = 1 + sl; u.nt = ntk / TAILK; u.kofs = sl * (ntk / TAILK); return true;
        }
        if (L >= nwg) return false;
        map((int)L, nM, nN, u.pm, u.pn); u.seg = sg; u.nt = split ? ntk / 2 : ntk; u.kofs = sg * u.nt; return true;
    }
    __device__ __forceinline__ void a_ready(const Unit& u) const {
        if (ready == nullptr) return;
        if (threadIdx.x < 64) {
            unsigned polls = 0;
            while ((unsigned)__builtin_amdgcn_readfirstlane(__hip_atomic_load(ready + 64 * u.pm, __ATOMIC_RELAXED, __HIP_MEMORY_SCOPE_AGENT)) < need) { if (++polls > (1u << 22)) break; __builtin_amdgcn_s_sleep(2); }
            __builtin_amdgcn_fence(__ATOMIC_ACQUIRE, "agent");
            asm volatile("s_waitcnt vmcnt(0)" ::: "memory");
        }
        asm volatile("" ::: "memory"); __builtin_amdgcn_s_barrier(); asm volatile("" ::: "memory");
    }
};

template <class Epi, class Sched>
__device__ __forceinline__ void gemm_phase(LAS unsigned char* lds, const Gemm g, const Sched& S, const Epi& E) {
    const int tid = otid(), wid = __builtin_amdgcn_readfirstlane(tid >> 6), lane = tid & 63, wr = wid >> 2, wc = wid & 3, fr = lane & 15, fq = lane >> 4;
    const int ld = g.K;
    unsigned voffA[2], voffB[2];
#pragma unroll
    for (int i = 0; i < 2; ++i) { int R, C; stage_rc(tid * 16 + i * 8192, R, C); const int Rb = Epi::PERM ? ((R & ~31) + perm32(R & 31)) : R;
        voffA[i] = (unsigned)(R * ld + C) * 2u; voffB[i] = (unsigned)(Rb * ld + C) * 2u; }
    const size_t kstep = (size_t)(BK * 2);
    const size_t hstep = (size_t)HALF * ld * 2;
    const size_t tstep = 2 * hstep;
    const unsigned ldsw = (unsigned)wid * 1024u;
    const int aoff = lds_byte(wr * 64 + fr, fq * 8), boff = lds_byte(wc * 32 + fr, fq * 8);
#define PG8_SA(b, h) (((b) * 2 + (h)) * HTB)
#define PG8_SB(b, h) ((4 + (b) * 2 + (h)) * HTB)
#define PG8_STAGE(bufoff, gbase, voff) do { _Pragma("unroll") for (int _i = 0; _i < 2; ++_i) \
        __builtin_amdgcn_global_load_lds((const unsigned*)((const char*)(gbase) + (voff)[_i]), (LAS unsigned*)(lds + (bufoff) + ldsw + _i * 8192), 16, 0, 0); } while (0)
#define PG8_LDA(dst, b, h) do { _Pragma("unroll") for (int m = 0; m < 4; ++m) _Pragma("unroll") for (int k = 0; k < 2; ++k) dst[m][k] = *(const LAS bf16x8*)(lds + PG8_SA(b, h) + aoff + m * 2048 + k * 1024); } while (0)
#define PG8_LDB(dst, b, h) do { _Pragma("unroll") for (int n = 0; n < 2; ++n) _Pragma("unroll") for (int k = 0; k < 2; ++k) dst[n][k] = *(const LAS bf16x8*)(lds + PG8_SB(b, h) + boff + n * 2048 + k * 1024); } while (0)
#define PG8_MMA(ai, bj, At, Bt) do { __builtin_amdgcn_s_setprio(1); _Pragma("unroll") for (int m = 0; m < 4; ++m) _Pragma("unroll") for (int n = 0; n < 2; ++n) _Pragma("unroll") for (int k = 0; k < 2; ++k) \
        acc[ai][bj][m][n] = __builtin_amdgcn_mfma_f32_16x16x32_bf16(Bt[n][k], At[m][k], acc[ai][bj][m][n], 0, 0, 0); __builtin_amdgcn_s_setprio(0); } while (0)
#define PG8_WAIT_V(n) asm volatile("s_waitcnt vmcnt(" #n ")" ::: "memory")
#define PG8_WAIT_L(n) asm volatile("s_waitcnt lgkmcnt(" #n ")" ::: "memory")
#define PG8_BAR __builtin_amdgcn_s_barrier()
#define PG8_SCHED __builtin_amdgcn_sched_barrier(0)
    Unit cur, nxt; int ui = 0;
    if (!S.next(0, cur)) return;
    S.a_ready(cur);
    f32x4 acc[2][2][4][2];
#pragma unroll
    for (int a = 0; a < 2; ++a)
#pragma unroll
        for (int b = 0; b < 2; ++b)
#pragma unroll
            for (int m = 0; m < 4; ++m)
#pragma unroll
                for (int n = 0; n < 2; ++n) acc[a][b][m][n] = (f32x4){0.f, 0.f, 0.f, 0.f};
    bf16x8 At[4][2], B0[2][2], B1[2][2];
    const char* cA = (const char*)g.A + (size_t)cur.pm * tstep + (size_t)cur.kofs * kstep; const char* cB = (const char*)g.Bt + (size_t)cur.pn * tstep + (size_t)cur.kofs * kstep;
    PG8_STAGE(PG8_SB(0, 0), cB, voffB); PG8_STAGE(PG8_SA(0, 0), cA, voffA); PG8_STAGE(PG8_SB(0, 1), cB + hstep, voffB); PG8_STAGE(PG8_SA(0, 1), cA + hstep, voffA);
    if (wr == 1) PG8_BAR;
    PG8_WAIT_V(4); PG8_BAR;
    PG8_STAGE(PG8_SB(1, 0), cB + kstep, voffB); PG8_STAGE(PG8_SA(1, 0), cA + kstep, voffA); PG8_STAGE(PG8_SB(1, 1), cB + hstep + kstep, voffB);
    PG8_WAIT_V(6); PG8_BAR;
    for (;;) {
        const bool has_next = S.next(ui + 1, nxt);
        const char* nA = has_next ? (const char*)g.A + (size_t)nxt.pm * tstep + (size_t)nxt.kofs * kstep : cA; const char* nB = has_next ? (const char*)g.Bt + (size_t)nxt.pn * tstep + (size_t)nxt.kofs * kstep : cB;
        const int nt = cur.nt;
        for (int t = 0; t < nt; t += 2) {
            const bool last = (t == nt - 2);
            if (last && has_next) S.a_ready(nxt);
            const char* a1 = cA + (size_t)(t + 1) * kstep;
            const char* a2 = last ? nA : cA + (size_t)(t + 2) * kstep; const char* b2 = last ? nB : cB + (size_t)(t + 2) * kstep;
            const char* a3 = a2 + kstep; const char* b3 = b2 + kstep;
            PG8_LDB(B0, 0, 0); PG8_SCHED; PG8_LDA(At, 0, 0); PG8_STAGE(PG8_SA(1, 1), a1 + hstep, voffA);
            PG8_WAIT_L(8); PG8_BAR; PG8_WAIT_L(0); PG8_MMA(0, 0, At, B0); PG8_BAR; PG8_SCHED;
            PG8_LDB(B1, 0, 1); PG8_STAGE(PG8_SB(0, 0), b2, voffB);
            PG8_BAR; PG8_WAIT_L(0); PG8_MMA(0, 1, At, B1); PG8_BAR;
            PG8_LDA(At, 0, 1); PG8_STAGE(PG8_SA(0, 0), a2, voffA);
            PG8_BAR; PG8_WAIT_L(0); PG8_MMA(1, 0, At, B0); PG8_BAR; PG8_SCHED;
            PG8_STAGE(PG8_SB(0, 1), b2 + hstep, voffB);
            PG8_WAIT_V(6); PG8_BAR; PG8_MMA(1, 1, At, B1); PG8_BAR;
            PG8_LDB(B0, 1, 0); PG8_SCHED; PG8_LDA(At, 1, 0); PG8_STAGE(PG8_SA(0, 1), a2 + hstep, voffA);
            PG8_WAIT_L(8); PG8_BAR; PG8_WAIT_L(0); PG8_MMA(0, 0, At, B0); PG8_BAR; PG8_SCHED;
            PG8_LDB(B1, 1, 1); PG8_STAGE(PG8_SB(1, 0), b3, voffB);
            PG8_BAR; PG8_WAIT_L(0); PG8_MMA(0, 1, At, B1); PG8_BAR;
            PG8_LDA(At, 1, 1); PG8_STAGE(PG8_SA(1, 0), a3, voffA);
            PG8_BAR; PG8_WAIT_L(0); PG8_MMA(1, 0, At, B0); PG8_BAR; PG8_SCHED;
            PG8_STAGE(PG8_SB(1, 1), b3 + hstep, voffB);
            PG8_WAIT_V(6); PG8_BAR; PG8_MMA(1, 1, At, B1); PG8_BAR;
        }
        E(acc, cur, wr, wc, fr, fq);
        if (!has_next) break;
        if (!(Epi::SPLIT2 && cur.seg == 0))
#pragma unroll
        for (int a = 0; a < 2; ++a)
#pragma unroll
            for (int b = 0; b < 2; ++b)
#pragma unroll
                for (int m = 0; m < 4; ++m)
#pragma unroll
                    for (int n = 0; n < 2; ++n) acc[a][b][m][n] = (f32x4){0.f, 0.f, 0.f, 0.f};
        cur = nxt; cA = nA; cB = nB; ++ui;
    }
    PG8_WAIT_V(0);
    if (wr == 0) PG8_BAR;
    PG8_BAR;
#undef PG8_SA
#undef PG8_SB
#undef PG8_STAGE
#undef PG8_LDA
#undef PG8_LDB
#undef PG8_MMA
#undef PG8_WAIT_V
#undef PG8_WAIT_L
#undef PG8_BAR
#undef PG8_SCHED
}
}

struct EpiZ {
    static constexpr bool PERM = true, SPLIT2 = false;
    bf16_t* Z;
    __device__ __forceinline__ void operator()(f32x4 (&acc)[2][2][4][2], const pg8::Unit& u, int wr, int wc, int fr, int fq) const {
        const int row0 = u.pm * 256 + wr * 64 + fr, col0 = u.pn * 256 + wc * 32 + 8 * fq;
#pragma unroll
        for (int ai = 0; ai < 2; ++ai)
#pragma unroll
            for (int m = 0; m < 4; ++m) { bf16_t* rowp = Z + (size_t)(row0 + ai * 128 + m * 16) * NP + col0;
#pragma unroll
                for (int bj = 0; bj < 2; ++bj) { const f32x4 v0 = acc[ai][bj][m][0], v1 = acc[ai][bj][m][1];
                    u32x4 o; o[0] = pk_bf16(v0[0], v0[1]); o[1] = pk_bf16(v0[2], v0[3]); o[2] = pk_bf16(v1[0], v1[1]); o[3] = pk_bf16(v1[2], v1[3]);
                    *(u32x4*)(rowp + bj * 128) = o; } }
    }
};
struct EpiMerge {
    static constexpr bool PERM = true, SPLIT2 = true;
    const bf16_t* Z; bf16_t* Mo; unsigned* ready;
    __device__ __forceinline__ void mid(f32x4 (&acc)[2][2][4][2], const pg8::Unit& u, int wr, int wc, int fr, int fq) const {
        const int row0 = u.pm * 256 + wr * 64 + fr, col0 = u.pn * 256 + wc * 32 + 8 * fq;
#pragma unroll
        for (int ai = 0; ai < 2; ++ai)
#pragma unroll
            for (int m = 0; m < 4; ++m) { const bf16_t* zr = Z + (size_t)(row0 + ai * 128 + m * 16) * NP + col0;
#pragma unroll
                for (int bj = 0; bj < 2; ++bj) { const u32x4 ga = *(const u32x4*)(zr + C_GA + bj * 128), gb = *(const u32x4*)(zr + C_GB + bj * 128);
#pragma unroll
                    for (int q = 0; q < 4; ++q) { const float a0 = bflo(ga[q]), a1 = bfhi(ga[q]), b0 = bflo(gb[q]), b1 = bfhi(gb[q]);
                        const float r0 = (1.f + __expf(-b0)) * __builtin_amdgcn_rcpf(1.f + __expf(-a0)), r1 = (1.f + __expf(-b1)) * __builtin_amdgcn_rcpf(1.f + __expf(-a1));
                        acc[ai][bj][m][q >> 1][(q & 1) * 2] *= r0; acc[ai][bj][m][q >> 1][(q & 1) * 2 + 1] *= r1; } } }
    }
    __device__ __forceinline__ void fin(f32x4 (&acc)[2][2][4][2], const pg8::Unit& u, int wr, int wc, int fr, int fq) const {
        const int row0 = u.pm * 256 + wr * 64 + fr, col0 = u.pn * 256 + wc * 32 + 8 * fq;
        const __amdgpu_buffer_rsrc_t rs = __builtin_amdgcn_make_buffer_rsrc((void*)Mo, 0, MT * DM * 2, 0x00020000);
#pragma unroll
        for (int ai = 0; ai < 2; ++ai)
#pragma unroll
            for (int m = 0; m < 4; ++m) { const size_t r = (size_t)(row0 + ai * 128 + m * 16); const bf16_t* zr = Z + r * NP + col0; const unsigned mo = (unsigned)((r * DM + col0) * 2);
#pragma unroll
                for (int bj = 0; bj < 2; ++bj) { const u32x4 gb = *(const u32x4*)(zr + C_GB + bj * 128); u32x4 o;
#pragma unroll
                    for (int q = 0; q < 4; ++q) { const float s0 = sigmoidf_(bflo(gb[q])), s1 = sigmoidf_(bfhi(gb[q]));
                        o[q] = pk_bf16(acc[ai][bj][m][q >> 1][(q & 1) * 2] * s0, acc[ai][bj][m][q >> 1][(q & 1) * 2 + 1] * s1); }
                    __builtin_amdgcn_raw_buffer_store_b128(o, rs, mo + bj * 256, 0, 16); } }
        asm volatile("s_waitcnt vmcnt(0)" ::: "memory");
        if (fr == 0 && fq == 0) (void)__hip_atomic_fetch_add(ready + 64 * u.pm, 1u, __ATOMIC_RELAXED, __HIP_MEMORY_SCOPE_AGENT);
    }
    __device__ __forceinline__ void operator()(f32x4 (&acc)[2][2][4][2], const pg8::Unit& u, int wr, int wc, int fr, int fq) const {
        if (u.seg == 0) mid(acc, u, wr, wc, fr, fq); else fin(acc, u, wr, wc, fr, fq);
    }
};
struct EpiOut {
    static constexpr bool PERM = false, SPLIT2 = false;
    const float* hp; const float* hs; float* Ho; float* Part;
    __device__ __forceinline__ void operator()(f32x4 (&acc)[2][2][4][2], const pg8::Unit& u, int wr, int wc, int fr, int fq) const {
        const int row0 = u.pm * 256 + wr * 64 + fr, col0 = u.pn * 256 + wc * 32 + 4 * fq;
        if (u.seg) {
            float* pb = Part + ((size_t)(u.seg - 1) * OT_ROWS + (row0 - OT_ROW0)) * DM + col0;
#pragma unroll
            for (int ai = 0; ai < 2; ++ai)
#pragma unroll
                for (int m = 0; m < 4; ++m)
#pragma unroll
                    for (int bj = 0; bj < 2; ++bj)
#pragma unroll
                        for (int n = 0; n < 2; ++n) *(f32x4*)(pb + (size_t)(ai * 128 + m * 16) * DM + bj * 128 + n * 16) = acc[ai][bj][m][n];
            return;
        }
        const float* src = (u.pm < 32) ? hp + (size_t)row0 * DM : hs + (size_t)(row0 - MP) * DM;
#pragma unroll
        for (int ai = 0; ai < 2; ++ai)
#pragma unroll
            for (int m = 0; m < 4; ++m) { const size_t ro = (size_t)(ai * 128 + m * 16) * DM + col0; float* dst = Ho + (size_t)row0 * DM + ro;
#pragma unroll
                for (int bj = 0; bj < 2; ++bj)
#pragma unroll
                    for (int n = 0; n < 2; ++n) { const f32x4 o = *(const f32x4*)(src + ro + bj * 128 + n * 16) + acc[ai][bj][m][n]; *(f32x4*)(dst + bj * 128 + n * 16) = o; } }
    }
};

__device__ __forceinline__ void conv_unit(const float* __restrict__ W, int K, int N, int Npad, bf16_t* __restrict__ Wt, int ldt, int unit, int lane) {
    const int nnb = Npad >> 6; const int kb = unit / nnb, nb = unit - kb * nnb;
    const int n = nb * 64 + lane, k0 = kb * 64;
    bf16_t* dst = Wt + (size_t)n * ldt + k0;
    if (n < N) {
        const float* src = W + (size_t)k0 * N + n;
        float v[64];
#pragma unroll
        for (int j = 0; j < 64; ++j) v[j] = src[(size_t)j * N];
#pragma unroll
        for (int kk = 0; kk < 64; kk += 8) { u32x4 o; o[0] = pk_bf16(v[kk], v[kk + 1]); o[1] = pk_bf16(v[kk + 2], v[kk + 3]); o[2] = pk_bf16(v[kk + 4], v[kk + 5]); o[3] = pk_bf16(v[kk + 6], v[kk + 7]);
            *(u32x4*)(dst + kk) = o; }
    } else {
#pragma unroll
        for (int kk = 0; kk < 64; kk += 8) *(u32x4*)(dst + kk) = (u32x4){0u, 0u, 0u, 0u};
    }
}
__device__ void phase_convert(const Params& p, int l, int gw, int nw) {
    const int lane = otid() & 63;
    constexpr int U_IN = (NP / 64) * 32, U_P = 32 * 16, U_O = 32 * 32, U_L = U_IN + 2 * U_P + U_O;
    for (int u = gw; u < U_L; u += nw) {
        int r = u;
        if (r < U_IN) conv_unit(P_W_IN + (size_t)l * DM * NIN, DM, NIN, NP, P_WINT + (size_t)l * NP * DM, DM, r, lane);
        else if ((r -= U_IN) < U_P) conv_unit(P_W_PROJ_A + (size_t)l * 1024 * DM, 1024, DM, DM, P_PABT + (size_t)l * DM * DM, DM, r, lane);
        else if ((r -= U_P) < U_P) conv_unit(P_W_PROJ_B + (size_t)l * 1024 * DM, 1024, DM, DM, P_PABT + (size_t)l * DM * DM + 1024, DM, r, lane);
        else { r -= U_P; conv_unit(P_W_OUT + (size_t)l * DM * DM, DM, DM, DM, P_WOT + (size_t)l * DM * DM, DM, r, lane); }
    }
}

__device__ void phase_rmsnorm(const float* hp, const float* hs, const float* g, bf16_t* obf, float* of32, const float* part, float* hs_w) {
    const int lane = otid() & 63, gw = blockIdx.x * 8 + (otid() >> 6), nw = gridDim.x * 8;
    for (int row = gw; row < MT; row += nw) {
        const f32x4* x = (const f32x4*)(row < MP ? hp + (size_t)row * DM : hs + (size_t)(row - MP) * DM);
        f32x4 v[8]; float ss = 0.f;
#pragma unroll
        for (int i = 0; i < 8; ++i) v[i] = x[lane + 64 * i];
        if (part && row >= OT_ROW0) {
#pragma unroll
            for (int sl = 0; sl < pg8::TAILK; ++sl) { const f32x4* pp = (const f32x4*)(part + ((size_t)sl * OT_ROWS + (row - OT_ROW0)) * DM);
#pragma unroll
                for (int i = 0; i < 8; ++i) v[i] += pp[lane + 64 * i]; }
#pragma unroll
            for (int i = 0; i < 8; ++i) ((f32x4*)(hs_w + (size_t)row * DM))[lane + 64 * i] = v[i];
        }
#pragma unroll
        for (int i = 0; i < 8; ++i) ss += v[i][0] * v[i][0] + v[i][1] * v[i][1] + v[i][2] * v[i][2] + v[i][3] * v[i][3];
        ss = red64(ss);
        const float rstd = rsqrtf(ss * (1.f / DM) + 1e-6f);
#pragma unroll
        for (int i = 0; i < 8; ++i) { const f32x4 gg = ((const f32x4*)g)[lane + 64 * i]; const f32x4 o = v[i] * rstd * gg;
            if (obf) { u32x2 w; w[0] = pk_bf16(o[0], o[1]); w[1] = pk_bf16(o[2], o[3]); *(u32x2*)(obf + (size_t)row * DM + (lane + 64 * i) * 4) = w; }
            else *(f32x4*)(of32 + (size_t)row * DM + (lane + 64 * i) * 4) = o; }
    }
}

__device__ void phase_prep(const Params& p, int l) {
    LAS float* sm = (LAS float*)smem_raw;
    LAS bf16_t* twb = (LAS bf16_t*)sm;
    LAS bf16_t* adb = twb + 16 * 72;
    LAS float* red = sm + 1152;
    LAS float* lwla = sm + 2048;
    const int tid = otid(), lane = tid & 63, wv = tid >> 6;
    const int c = tid * 2;
    const float* mu = P_SHIFT_MU + l * DSH;
    for (int i = tid; i < 2 * 8 * 72 / 2; i += 512) { const int m_ = i / 288, r_ = i % 288; ((LAS unsigned*)(twb + m_ * 16 * 72 + 8 * 72))[r_] = 0u; }
    unsigned* qhead = (unsigned*)(p.ws + WS_BAR) + 3456 + 64 * l;
    LAS int* qslot = (LAS int*)(sm + 1300);
    for (;;) {
        if (tid == 0) *qslot = (int)__hip_atomic_fetch_add(qhead, 1u, __ATOMIC_RELAXED, __HIP_MEMORY_SCOPE_AGENT);
        __syncthreads();
        const int qi = *qslot;
        if (qi >= MT / 8) break;
        const int item = qi < MS / 8 ? MP / 8 + qi : qi - MS / 8;
        const int row0 = item * 8;
        const bool samp = row0 >= MP;
        const int sb = (row0 - MP) >> 3, pb = row0 >> 11, t0 = row0 & 2047;
        const bf16_t* zr = P_Z + (size_t)row0 * NP;
        const float* sprev = P_STATE_SHIFT + (size_t)(l * 128 + (samp ? sb : 0)) * DSH;
        const bool zprev = (!samp) && (t0 == 0);
        {
            const int j = tid & 127, col = C_WD + j, tp = tid >> 7;
            const float m_ = mu[col];
#pragma unroll
            for (int tt = 0; tt < 2; ++tt) { const int t = tp * 2 + tt;
                const float cur = bf2f(zr[(size_t)t * NP + col]);
                float prv;
                if (t == 0) prv = samp ? sprev[col] : (zprev ? 0.f : bf2f(*(zr + col - NP))); else prv = bf2f(zr[(size_t)(t - 1) * NP + col]);
                const float mix = cur + (prv - cur) * m_;
                if (j < 64) twb[t * 72 + j] = (bf16_t)(pk_bf16(tanhf_(mix), 0.f) & 0xffffu); else adb[t * 72 + j - 64] = (bf16_t)(pk_bf16(mix, 0.f) & 0xffffu); }
        }
        unsigned vgw[8];
#pragma unroll
        for (int t = 0; t < 8; ++t) vgw[t] = *(const unsigned*)(zr + (size_t)t * NP + C_VG + c);
        float rm[8][2], km[8][2], vm[8][2];
#pragma unroll
        for (int sec = 0; sec < 3; ++sec) { const int col = sec * 1024 + c;
            float p0, p1;
            if (samp) { const f32x2 s2 = *(const f32x2*)(sprev + col); p0 = s2[0]; p1 = s2[1]; }
            else if (zprev) { p0 = 0.f; p1 = 0.f; }
            else { const unsigned w = *(const unsigned*)(zr + col - NP); p0 = bflo(w); p1 = bfhi(w); }
            const f32x2 m2 = *(const f32x2*)(mu + col);
#pragma unroll
            for (int t = 0; t < 8; ++t) { const unsigned w = *(const unsigned*)(zr + (size_t)t * NP + col); const float c0 = bflo(w), c1 = bfhi(w);
                const float x0 = c0 + (p0 - c0) * m2[0], x1 = c1 + (p1 - c1) * m2[1];
                if (sec == 0) { rm[t][0] = x0; rm[t][1] = x1; } else if (sec == 1) { km[t][0] = x0; km[t][1] = x1; } else { vm[t][0] = x0; vm[t][1] = x1; }
                p0 = c0; p1 = c1; } }
        __syncthreads();
        {
            const int fr = lane & 15, fq = lane >> 4;
            bf16x8 aw[2], aa[2];
#pragma unroll
            for (int ks = 0; ks < 2; ++ks) { aw[ks] = *(const LAS bf16x8*)(twb + fr * 72 + ks * 32 + fq * 8); aa[ks] = *(const LAS bf16x8*)(adb + fr * 72 + ks * 32 + fq * 8); }
            const bf16_t* w2t = P_W2T + ((size_t)l * 1024 + wv * 128 + fr) * 64 + fq * 8;
            const bf16_t* a2t = P_A2T + ((size_t)l * 1024 + wv * 128 + fr) * 64 + fq * 8;
#pragma unroll
            for (int nt = 0; nt < 8; ++nt) {
                f32x4 dw = (f32x4){0.f, 0.f, 0.f, 0.f}, da = (f32x4){0.f, 0.f, 0.f, 0.f};
#pragma unroll
                for (int ks = 0; ks < 2; ++ks) { const bf16x8 bw = *(const bf16x8*)(w2t + nt * 16 * 64 + ks * 32), ba = *(const bf16x8*)(a2t + nt * 16 * 64 + ks * 32);
                    dw = __builtin_amdgcn_mfma_f32_16x16x32_bf16(aw[ks], bw, dw, 0, 0, 0); da = __builtin_amdgcn_mfma_f32_16x16x32_bf16(aa[ks], ba, da, 0, 0, 0); }
                if (fq < 2) { const int ch = wv * 128 + nt * 16 + fr;
#pragma unroll
                    for (int r = 0; r < 4; ++r) *(LAS f32x2*)(lwla + ((fq * 4 + r) * 1024 + ch) * 2) = (f32x2){dw[r], da[r]}; }
            }
        }
        __syncthreads();
        float lw[8][2], la[8][2];
        { const f32x2 w0v = *(const f32x2*)(P_W0 + l * 1024 + c), a0v = *(const f32x2*)(P_A0 + l * 1024 + c);
#pragma unroll
          for (int t = 0; t < 8; ++t) { const f32x4 v = *(const LAS f32x4*)(lwla + (t * 1024 + c) * 2);
              lw[t][0] = w0v[0] + v[0]; la[t][0] = a0v[0] + v[1]; lw[t][1] = w0v[1] + v[2]; la[t][1] = a0v[1] + v[3]; } }
        {
            const f32x2 kkv = *(const f32x2*)(P_K_K + l * 1024 + c), kav = *(const f32x2*)(P_K_A + l * 1024 + c);
            const int hh = c >> 6, cc = c & 63;
#pragma unroll
            for (int t = 0; t < 8; ++t) {
                float dec[2], ag[2], kk[2], kp[2];
#pragma unroll
                for (int e = 0; e < 2; ++e) { const float y = -lw[t][e]; const float sp = fmaxf(y, 0.f) + __logf(1.f + __expf(-fabsf(y)));
                    const float wl = -sp - 0.5f; dec[e] = __expf(-__expf(wl)); ag[e] = sigmoidf_(la[t][e]); kk[e] = km[t][e] * kkv[e]; kp[e] = km[t][e] * (1.f + (ag[e] - 1.f) * kav[e]); }
                const float ss = red32(kk[0] * kk[0] + kk[1] * kk[1]);
                const float inv = __builtin_amdgcn_rsqf(fmaxf(ss, 1e-24f));
                float* rc = P_REC + ((size_t)(row0 + t) * 16 + hh) * RECF;
                u32x4 pkd; pkd[0] = pk_bf16(rm[t][0], rm[t][1]); pkd[1] = pk_bf16(kp[0], kp[1]); pkd[2] = pk_bf16(-kk[0] * inv, -kk[1] * inv); pkd[3] = pk_bf16(kk[0] * inv * ag[0], kk[1] * inv * ag[1]);
                *(u32x4*)(rc + (cc >> 1) * 4) = pkd;
                *(f32x4*)(rc + 128 + (cc >> 1) * 4) = (f32x4){dec[0], dec[1], vm[t][0], vm[t][1]};
            }
        }
        {
            float x[8][2];
#pragma unroll
            for (int t = 0; t < 8; ++t) { x[t][0] = bflo(vgw[t]); x[t][1] = bfhi(vgw[t]); }
#pragma unroll
            for (int t = 0; t < 8; ++t) { const float s1 = red64(x[t][0] + x[t][1]), s2 = red64(x[t][0] * x[t][0] + x[t][1] * x[t][1]);
                if (lane == 0) { red[wv * 16 + t] = s1; red[wv * 16 + 8 + t] = s2; } }
            __syncthreads();
            const f32x2 gv = *(const f32x2*)(P_SGU_LN_G + l * 1024 + c), bv = *(const f32x2*)(P_SGU_LN_B + l * 1024 + c);
            float vn[8][2];
#pragma unroll
            for (int t = 0; t < 8; ++t) { float s1 = 0.f, s2 = 0.f;
#pragma unroll
                for (int w = 0; w < 8; ++w) { s1 += red[w * 16 + t]; s2 += red[w * 16 + 8 + t]; }
                const float mean = s1 * (1.f / 1024.f), var = fmaxf(s2 * (1.f / 1024.f) - mean * mean, 0.f), rstd = rsqrtf(var + 1e-5f);
                vn[t][0] = (x[t][0] - mean) * rstd * gv[0] + bv[0]; vn[t][1] = (x[t][1] - mean) * rstd * gv[1] + bv[1]; }
#pragma unroll
            for (int e = 0; e < 2; ++e) { u32x4 o; o[0] = pk_bf16(vn[0][e], vn[1][e]); o[1] = pk_bf16(vn[2][e], vn[3][e]); o[2] = pk_bf16(vn[4][e], vn[5][e]); o[3] = pk_bf16(vn[6][e], vn[7][e]);
                if (samp) *(u32x4*)(P_VNTS + ((size_t)sb * 1024 + c + e) * 8) = o;
                else *(u32x4*)(P_VNT + (((size_t)(pb * 16 + (t0 >> 7)) * 16 + ((t0 & 127) >> 3)) * 1024 + c + e) * 8) = o; }
            if (samp) {
#pragma unroll
                for (int t = 0; t < 8; ++t) *(f32x2*)(p.out + O_CV + ((size_t)(l * 128 + sb) * 8 + t) * 1024 + c) = (f32x2){vn[t][0], vn[t][1]};
            }
        }
        if (samp) { for (int col = tid; col < DSH; col += 512) p.out[O_SHS + (size_t)(l * 128 + sb) * DSH + col] = bf2f(zr[(size_t)7 * NP + col]); }
        else if (t0 == 2040) { for (int col = tid; col < DSH; col += 512) p.out[O_SHP + (size_t)(l * 4 + pb) * DSH + col] = bf2f(zr[(size_t)7 * NP + col]); }
        __syncthreads();
    }
}

#define WAVE_SYNC() do { asm volatile("s_waitcnt lgkmcnt(0)" ::: "memory"); __builtin_amdgcn_wave_barrier(); } while (0)
__device__ __forceinline__ float dot4(const f32x4 a, const f32x4 b) { return a[0] * b[0] + a[1] * b[1] + a[2] * b[2] + a[3] * b[3]; }

__device__ void scan_prompt_unit(const Params& p, int l, int unit, int wv, int lane, LAS float* lw) {
    const int bh = unit >> 2, b = bh >> 4, h = bh & 15;
    const int rg = lane >> 4, kq = lane & 15;
    const int v0 = (unit & 3) * 16 + wv * 4 + rg;
    const float* recb = P_REC + ((size_t)(b * 2048) * 16 + h) * RECF;
    float* yb = P_YBUF + (size_t)(b * 2048) * 1024 + h * 64 + v0;
    constexpr size_t TS = 16 * RECF;
    LAS float* lv = lw + 16 * 5 * 64;
    LAS float* ly = lv + 64;
    f32x4 s = (f32x4){0.f, 0.f, 0.f, 0.f};
    u32x2 nxA[4][4], nxB[4][4]; f32x4 nwA[4], nwB[4]; float nvA, nvB;
#define SCAN_LOAD_BATCH(nx, nw, nv, tb_) do { \
        _Pragma("unroll") for (int j = 0; j < 4; ++j) { const float* rp = recb + (size_t)((tb_) + rg + 4 * j) * TS; \
            const u32x4 q0 = *(const u32x4*)(rp + kq * 8), q1 = *(const u32x4*)(rp + kq * 8 + 4);     \
            nx[j][0] = (u32x2){q0[0], q1[0]}; nx[j][1] = (u32x2){q0[1], q1[1]}; nx[j][2] = (u32x2){q0[2], q1[2]}; nx[j][3] = (u32x2){q0[3], q1[3]}; \
            const f32x2 w0 = *(const f32x2*)(rp + 128 + kq * 8), w1 = *(const f32x2*)(rp + 128 + kq * 8 + 4); nw[j] = (f32x4){w0[0], w0[1], w1[0], w1[1]}; } \
        nv = recb[(size_t)((tb_) + kq) * TS + 128 + (v0 >> 1) * 4 + 2 + (v0 & 1)]; } while (0)
#define BF4(u) ((f32x4){bflo((u)[0]), bfhi((u)[0]), bflo((u)[1]), bfhi((u)[1])})
#define SCAN_BATCH(nx, nw, nv, tb_) do { \
        WAVE_SYNC(); \
        _Pragma("unroll") for (int j = 0; j < 4; ++j) { LAS float* ls = lw + (rg + 4 * j) * 5 * 64 + kq * 4;     \
            *(LAS f32x4*)(ls) = BF4(nx[j][0]); *(LAS f32x4*)(ls + 64) = nw[j]; *(LAS f32x4*)(ls + 128) = BF4(nx[j][1]); *(LAS f32x4*)(ls + 192) = BF4(nx[j][2]); *(LAS f32x4*)(ls + 256) = BF4(nx[j][3]); } \
        lv[kq * 4 + rg] = nv; \
        WAVE_SYNC(); \
        if ((tb_) + 32 < 2048) SCAN_LOAD_BATCH(nx, nw, nv, (tb_) + 32); \
        f32x4 a4 = *(const LAS f32x4*)(lw + 3 * 64 + kq * 4); \
        float pa = dot4(s, a4), py = 0.f; \
        _Pragma("unroll") for (int q = 0; q < 16; ++q) { \
            const LAS float* lc = lw + q * 5 * 64 + kq * 4; \
            const f32x4 w4 = *(const LAS f32x4*)(lc + 64), k4 = *(const LAS f32x4*)(lc + 128), b4 = *(const LAS f32x4*)(lc + 256), r4 = *(const LAS f32x4*)(lc); \
            const float vv = lv[q * 4 + rg]; \
            f32x4 a4n = a4; \
            if (q < 15) a4n = *(const LAS f32x4*)(lc + 5 * 64 + 192); \
            if (q > 0) { red16x2(pa, py); ly[(q - 1) * 4 + rg] = py; } else pa = red16(pa); \
            s = s * w4 + vv * k4 + pa * b4; \
            py = dot4(s, r4); \
            if (q < 15) pa = dot4(s, a4n); \
            a4 = a4n; } \
        py = red16(py); ly[15 * 4 + rg] = py; \
        asm volatile("s_waitcnt lgkmcnt(0)" ::: "memory"); \
        yb[(size_t)((tb_) + kq) * 1024] = ly[kq * 4 + rg]; } while (0)
    SCAN_LOAD_BATCH(nxA, nwA, nvA, 0);
    SCAN_LOAD_BATCH(nxB, nwB, nvB, 16);
    for (int tb = 0; tb < 2048; tb += 32) {
        SCAN_BATCH(nxA, nwA, nvA, tb);
        SCAN_BATCH(nxB, nwB, nvB, tb + 16);
    }
#undef SCAN_BATCH
#undef SCAN_LOAD_BATCH
#undef BF4
    *(f32x4*)(p.out + O_WKVP + ((size_t)((l * 4 + b) * 16 + h) * 64 + v0) * 64 + kq * 4) = s;
}

__device__ void scan_sample_item(const Params& p, int l, int item, int lane, LAS float* lw) {
    const int b = item >> 4, h = item & 15;
    const int rg = lane >> 4, kq = lane & 15;
    const size_t sbase = (size_t)((l * 128 + b) * 16 + h) * 4096;
    const float* S0 = P_STATE_WKV + sbase;
    f32x4 s[16];
#pragma unroll
    for (int i = 0; i < 16; ++i) s[i] = *(const f32x4*)(S0 + (rg * 16 + i) * 64 + kq * 4);
    const float* recb = P_REC + ((size_t)(MP + b * 8) * 16 + h) * RECF;
    float nx[6];
#define SAMPLE_LOAD(rp_) do { const bf16_t* rb = (const bf16_t*)(rp_) + (lane >> 1) * 8 + (lane & 1); const float* rf = (rp_) + 128 + (lane >> 1) * 4 + (lane & 1); \
        nx[0] = bf2f(rb[0]); nx[2] = bf2f(rb[2]); nx[4] = bf2f(rb[4]); nx[5] = bf2f(rb[6]); nx[1] = rf[0]; nx[3] = rf[2]; } while (0)
    SAMPLE_LOAD(recb);
    for (int t = 0; t < 8; ++t) {
        WAVE_SYNC();
#pragma unroll
        for (int j = 0; j < 6; ++j) lw[j * 64 + lane] = nx[j];
        WAVE_SYNC();
        if (t < 7) SAMPLE_LOAD(recb + (size_t)(t + 1) * 16 * RECF);
        const f32x4 r4 = *(const LAS f32x4*)(lw + 0 * 64 + kq * 4), w4 = *(const LAS f32x4*)(lw + 1 * 64 + kq * 4), k4 = *(const LAS f32x4*)(lw + 2 * 64 + kq * 4),
                    a4 = *(const LAS f32x4*)(lw + 4 * 64 + kq * 4), b4 = *(const LAS f32x4*)(lw + 5 * 64 + kq * 4);
        float ysel = 0.f;
#pragma unroll
        for (int i4 = 0; i4 < 4; ++i4) {
            const f32x4 vv = *(const LAS f32x4*)(lw + 3 * 64 + rg * 16 + i4 * 4);
#pragma unroll
            for (int ii = 0; ii < 4; ++ii) { const int i = i4 * 4 + ii;
                const float sa = red16(dot4(s[i], a4));
                s[i] = s[i] * w4 + vv[ii] * k4 + sa * b4;
                const float y = red16(dot4(s[i], r4));
                ysel = (kq == i) ? y : ysel; }
        }
        P_YBUF[(size_t)(MP + b * 8 + t) * 1024 + h * 64 + rg * 16 + kq] = ysel;
    }
    float* So = p.out + O_WKVS + sbase;
#pragma unroll
    for (int i = 0; i < 16; ++i) *(f32x4*)(So + (rg * 16 + i) * 64 + kq * 4) = s[i];
}

__device__ void sgu_prompt_item(const Params& p, int l, int item, int lane) {
    const int slab = item & 7, g = (item >> 3) & 7, bc = item >> 6;
    const int fr = lane & 15, fq = lane >> 4;
    bf16x8 vf[4];
#pragma unroll
    for (int ks = 0; ks < 4; ++ks) vf[ks] = *(const bf16x8*)(P_VNT + (((size_t)bc * 16 + ks * 4 + fq) * 1024 + g * 128 + slab * 16 + fr) * 8);
    const float* Wg = P_SGU_W + (size_t)(l * 8 + g) * 16384;
    const float* bg = P_SGU_B + (size_t)(l * 8 + g) * 128;
    const int ch = g * 128 + slab * 16 + fq * 4;
#pragma unroll
    for (int tt = 0; tt < 8; ++tt) {
        f32x4 acc = (f32x4){0.f, 0.f, 0.f, 0.f};
        const int t = tt * 16 + fr;
#pragma unroll
        for (int ks = 0; ks <= tt / 2; ++ks) {
            const int s0 = ks * 32 + fq * 8;
            const f32x4 wa = *(const f32x4*)(Wg + t * 128 + s0), wb = *(const f32x4*)(Wg + t * 128 + s0 + 4);
            float wv[8] = {wa[0], wa[1], wa[2], wa[3], wb[0], wb[1], wb[2], wb[3]};
#pragma unroll
            for (int j = 0; j < 8; ++j) wv[j] = (s0 + j <= t) ? wv[j] : 0.f;
            u32x4 pk; pk[0] = pk_bf16(wv[0], wv[1]); pk[1] = pk_bf16(wv[2], wv[3]); pk[2] = pk_bf16(wv[4], wv[5]); pk[3] = pk_bf16(wv[6], wv[7]);
            bf16x8 wf; __builtin_memcpy(&wf, &pk, 16);
            acc = __builtin_amdgcn_mfma_f32_16x16x32_bf16(vf[ks], wf, acc, 0, 0, 0);
        }
        const size_t row = (size_t)bc * 128 + t;
        const float sbv = bg[t];
        const u32x2 uu = *(const u32x2*)(P_Z + row * NP + C_U + ch), gg = *(const u32x2*)(P_Z + row * NP + C_GG + ch);
        const float o0 = bflo(uu[0]) * (acc[0] + sbv) * siluf_(bflo(gg[0])), o1 = bfhi(uu[0]) * (acc[1] + sbv) * siluf_(bfhi(gg[0]));
        const float o2 = bflo(uu[1]) * (acc[2] + sbv) * siluf_(bflo(gg[1])), o3 = bfhi(uu[1]) * (acc[3] + sbv) * siluf_(bfhi(gg[1]));
        u32x2 o; o[0] = pk_bf16(o0, o1); o[1] = pk_bf16(o2, o3);
        *(u32x2*)(P_YAB + row * DM + 1024 + ch) = o;
    }
}

__device__ void sgu_sample_item(const Params& p, int l, int item, int lane) {
    const int b = item >> 4, ch = (item & 15) * 64 + lane, g = ch >> 7;
    const u32x4 vv = *(const u32x4*)(P_VNTS + ((size_t)b * 1024 + ch) * 8);
    float vn[8] = {bflo(vv[0]), bfhi(vv[0]), bflo(vv[1]), bfhi(vv[1]), bflo(vv[2]), bfhi(vv[2]), bflo(vv[3]), bfhi(vv[3])};
    const float* Wg = P_SGU_W + (size_t)(l * 8 + g) * 16384;
    const float* bg = P_SGU_B + (size_t)(l * 8 + g) * 128;
#pragma unroll
    for (int t = 0; t < 8; ++t) {
        float sacc = bg[t];
#pragma unroll
        for (int s = 0; s <= t; ++s) sacc += Wg[t * 128 + s] * vn[s];
        const size_t row = (size_t)MP + b * 8 + t;
        const float u = bf2f(P_Z[row * NP + C_U + ch]), gg = bf2f(P_Z[row * NP + C_GG + ch]);
        const float o = u * sacc * siluf_(gg);
        P_YAB[row * DM + 1024 + ch] = (bf16_t)(pk_bf16(o, 0.f) & 0xffffu);
    }
}

__device__ void phase_scan(const Params& p, int l) {
    const int tid = otid(), lane = tid & 63, wv = __builtin_amdgcn_readfirstlane(tid >> 6);
    LAS float* lw = (wv < 4) ? (LAS float*)smem_raw + wv * 6144 : (LAS float*)smem_raw + 24576 + (wv - 4) * 2048;
#ifndef REP_PR
#define REP_PR 1
#endif
#ifndef REP_IT
#define REP_IT 1
#endif
    if (wv < 4) {
      for (int rr = 0; rr < REP_PR; ++rr)
        for (int u0 = blockIdx.x; u0 < 256; u0 += gridDim.x) { const int unit = (gridDim.x == 256) ? ((u0 & 7) * 32 + (u0 >> 3)) : u0; scan_prompt_unit(p, l, unit, wv, lane, lw); }
    } else {
        const int nw = gridDim.x * 4;
      for (int rr = 0; rr < REP_IT; ++rr)
        for (int it = blockIdx.x * 4 + (wv - 4); it < 2048 + 4096 + 2048; it += nw) {
            if (it < 2048) scan_sample_item(p, l, it, lane, lw);
            else if (it < 6144) sgu_prompt_item(p, l, it - 2048, lane);
            else sgu_sample_item(p, l, it - 6144, lane);
        }
        if (l + 1 < DEPTH) phase_convert(p, l + 1, blockIdx.x * 4 + (wv - 4), nw);
    }
}

__device__ void phase_post(const Params& p, int l) {
    const int lane = otid() & 63, gw = blockIdx.x * 8 + (otid() >> 6), nw = gridDim.x * 8;
    const int hg = lane >> 4, kq = lane & 15;
    for (int it = gw; it < MT * 4; it += nw) {
        const int row = it >> 2, h = (it & 3) * 4 + hg, ch = h * 64 + kq * 4;
        const f32x4 y = *(const f32x4*)(P_YBUF + (size_t)row * 1024 + ch);
        const float* rc = P_REC + ((size_t)row * 16 + h) * RECF;
        const u32x2 p0 = *(const u32x2*)(rc + kq * 8), p1 = *(const u32x2*)(rc + kq * 8 + 4);
        const f32x2 va = *(const f32x2*)(rc + 128 + kq * 8 + 2), vb = *(const f32x2*)(rc + 128 + kq * 8 + 6);
        const f32x4 r4 = (f32x4){bflo(p0[0]), bfhi(p0[0]), bflo(p1[0]), bfhi(p1[0])}, k4 = (f32x4){bflo(p0[1]), bfhi(p0[1]), bflo(p1[1]), bfhi(p1[1])}, v4 = (f32x4){va[0], va[1], vb[0], vb[1]};
        const f32x4 rk = *(const f32x4*)(P_R_K + (size_t)l * 1024 + ch);
        const float mean = red16(y[0] + y[1] + y[2] + y[3]) * (1.f / 64.f);
        const f32x4 d = y - mean;
        const float var = red16(dot4(d, d)) * (1.f / 64.f);
        const float rs = rsqrtf(var + 64e-5f);
        const float srk = red16(r4[0] * k4[0] * rk[0] + r4[1] * k4[1] * rk[1] + r4[2] * k4[2] * rk[2] + r4[3] * k4[3] * rk[3]);
        const f32x4 lg = *(const f32x4*)(P_LNX_G + (size_t)l * 1024 + ch), lb = *(const f32x4*)(P_LNX_B + (size_t)l * 1024 + ch);
        const u32x2 gr = *(const u32x2*)(P_Z + (size_t)row * NP + C_GR + ch);
        const f32x4 yo = d * rs * lg + lb + srk * v4;
        u32x2 o; o[0] = pk_bf16(yo[0] * siluf_(bflo(gr[0])), yo[1] * siluf_(bfhi(gr[0]))); o[1] = pk_bf16(yo[2] * siluf_(bflo(gr[1])), yo[3] * siluf_(bfhi(gr[1])));
        *(u32x2*)(P_YAB + (size_t)row * DM + ch) = o;
    }
}


#define XB_TMO      128
#define XB_XCNT(j)  (256  + 64 * (j))
#define XB_XSUB(j)  (1280 + 64 * (j))
#define XB_XGEN(j)  (2304 + 64 * (j))
#define XB_TOP      3328
#define XB_TOPGEN   3392
#define XCD_BAR_WORDS 3456
#define XB_SPIN_CAP (1u << 20)
__device__ __forceinline__ unsigned xb_ld(unsigned* p)              { return __hip_atomic_load(p, __ATOMIC_RELAXED, __HIP_MEMORY_SCOPE_AGENT); }
__device__ __forceinline__ unsigned xb_add(unsigned* p, unsigned v) { return __hip_atomic_fetch_add(p, v, __ATOMIC_RELAXED, __HIP_MEMORY_SCOPE_AGENT); }
__device__ __forceinline__ unsigned xb_xcc_id() { return (unsigned)__builtin_amdgcn_s_getreg((3 << 11) | 20) & 0xFu; }
#define XB_SPIN(cond, bar) do { unsigned _sp = 0; while (cond) { __builtin_amdgcn_s_sleep(1); \
    if ((++_sp & 255u) == 0u) { if (xb_ld(&(bar)[XB_TMO])) break; if (_sp > XB_SPIN_CAP) { atomicAdd(&(bar)[XB_TMO], 1u); break; } } } } while (0)
struct XcdBarrier { unsigned* bar; unsigned x; volatile LAS unsigned* st; };
__device__ __forceinline__ XcdBarrier xcd_barrier_post(unsigned* bar, volatile LAS unsigned* st) {
    XcdBarrier b; b.bar = bar; b.x = xb_xcc_id(); b.st = st;
    if (threadIdx.x == 0) (void)xb_add(&bar[XB_XCNT(b.x)], 1u);
    return b;
}
__device__ __forceinline__ void xcd_barrier_complete(unsigned* bar, unsigned x, unsigned& nloc, unsigned& nx) {
    const unsigned G = gridDim.x * gridDim.y * gridDim.z;
    unsigned sum, cnt, mine, sp = 0u;
    for (;;) {
        sum = 0u; cnt = 0u; mine = 0u;
#pragma unroll
        for (unsigned j = 0; j < 16; ++j) { const unsigned c = xb_ld(&bar[XB_XCNT(j)]); sum += c; cnt += (c > 0u) ? 1u : 0u; mine = (j == x) ? c : mine; }
        if (sum == G) break;
        __builtin_amdgcn_s_sleep(1);
        if ((++sp & 255u) == 0u) { if (xb_ld(&bar[XB_TMO])) break; if (sp > XB_SPIN_CAP) { atomicAdd(&bar[XB_TMO], 1u); break; } }
    }
    nloc = mine > 0u ? mine : 1u; nx = cnt > 0u ? cnt : 1u;
}
__device__ __forceinline__ void xcd_barrier(const XcdBarrier& b) {
    asm volatile("s_waitcnt vmcnt(0)" ::: "memory");
    __syncthreads();
    if (threadIdx.x == 0) {
        unsigned* bar = b.bar;
        __builtin_amdgcn_s_waitcnt(0);
        unsigned nloc = b.st[0], nx = b.st[1];
        if (nloc == 0u) { xcd_barrier_complete(bar, b.x, nloc, nx); b.st[0] = nloc; b.st[1] = nx; }
        const unsigned old = xb_add(&bar[XB_XSUB(b.x)], 1u);
        const unsigned gen = old / nloc;
        if (old + 1u == (gen + 1u) * nloc) {
            __builtin_amdgcn_fence(__ATOMIC_RELEASE, "agent");
            asm volatile("s_waitcnt vmcnt(0)" ::: "memory");
            const unsigned og = xb_add(&bar[XB_TOP], 1u);
            const unsigned tg = og / nx;
            if (og + 1u == (tg + 1u) * nx) xb_add(&bar[XB_TOPGEN], 1u);
            else XB_SPIN(xb_ld(&bar[XB_TOPGEN]) == tg, bar);
            __builtin_amdgcn_fence(__ATOMIC_ACQUIRE, "agent");
            xb_add(&bar[XB_XGEN(b.x)], 1u);
            asm volatile("s_waitcnt vmcnt(0)" ::: "memory");
        } else {
            XB_SPIN(xb_ld(&bar[XB_XGEN(b.x)]) == gen, bar);
            __builtin_amdgcn_fence(__ATOMIC_ACQUIRE, "agent");
            asm volatile("s_waitcnt vmcnt(0)" ::: "memory");
        }
    }
    __syncthreads();
}

template <int ST> __device__ __forceinline__ void run_stage(const Params& p, int l) {
    LAS unsigned char* lds = (LAS unsigned char*)smem_raw;
    pg8::StaticOrder S;
    if (ST == 7) { { const int gw = blockIdx.x * 8 + (otid() >> 6), lane = otid() & 63;
                     if (gw < 128) { const int l2 = gw >> 5, m2 = (gw >> 4) & 1, u2 = gw & 15;
                         conv_unit((m2 ? P_A2 : P_W2) + (size_t)l2 * 64 * 1024, 64, 1024, 1024, (m2 ? P_A2T : P_W2T) + (size_t)l2 * 1024 * 64, 64, u2, lane); } }
                   { const f32x4* xs = (const f32x4*)P_X_SAMPLE; f32x4* hd = (f32x4*)(P_H + (size_t)MP * DM);
                     for (int i = blockIdx.x * 512 + otid(); i < MS * DM / 4; i += gridDim.x * 512) hd[i] = xs[i];
                     const f32x4* xp = (const f32x4*)(P_X_PROMPT + (size_t)OT_ROW0 * DM); f32x4* hq = (f32x4*)(P_H + (size_t)OT_ROW0 * DM);
                     for (int i = blockIdx.x * 512 + otid(); i < (MP - OT_ROW0) * DM / 4; i += gridDim.x * 512) hq[i] = xp[i]; }
                   phase_convert(p, 0, blockIdx.x * 8 + (otid() >> 6), gridDim.x * 8); phase_rmsnorm(P_X_PROMPT, P_X_SAMPLE, P_NORM_G, P_XN, nullptr, nullptr, nullptr); }
    if (ST == 0) { pg8::Gemm g{P_XN, P_WINT + (size_t)l * NP * DM, MT, NP, DM}; S.init(MT, NP, DM, gridDim.x, blockIdx.x); EpiZ e{P_Z}; pg8::gemm_phase(lds, g, S, e); }
    if (ST == 1) phase_prep(p, l);
    if (ST == 2) phase_scan(p, l);
    if (ST == 3) phase_post(p, l);
    if (ST == 4) { pg8::Gemm g{P_YAB, P_PABT + (size_t)l * DM * DM, MT, DM, DM}; S.init(MT, DM, DM, gridDim.x, blockIdx.x, 1, MP / 256); S.tail_full = 1; EpiMerge e{P_Z, P_M, (unsigned*)(p.ws + WS_BAR) + RDY_W0}; pg8::gemm_phase(lds, g, S, e); }
    if (ST == 5) { pg8::Gemm g{P_M, P_WOT + (size_t)l * DM * DM, MT, DM, DM}; S.init(MT, DM, DM, gridDim.x, blockIdx.x, 0, OT_PM0);
                   S.rot = 32; S.tail_base = gridDim.x;
                   S.ready = (unsigned*)(p.ws + WS_BAR) + RDY_W0; S.need = 64u * (unsigned)(l + 1);
                   EpiOut e{l == 0 ? P_X_PROMPT : P_H, P_H + (size_t)MP * DM, P_H, P_PART}; pg8::gemm_phase(lds, g, S, e); }
    if (ST == 6) { if (l < DEPTH - 1) phase_rmsnorm(P_H, P_H + (size_t)MP * DM, P_NORM_G + (size_t)(l + 1) * DM, P_XN, nullptr, P_PART, P_H);
                   else phase_rmsnorm(P_H, P_H + (size_t)MP * DM, P_FINAL_G, nullptr, p.out + O_YP, P_PART, P_H); }
}

#if MK_SINGLE
#ifndef REP0
#define REP0 1
#endif
#ifndef REP1
#define REP1 1
#endif
#ifndef REP2
#define REP2 1
#endif
#ifndef REP3
#define REP3 1
#endif
#ifndef REP4
#define REP4 1
#endif
#ifndef REP6
#define REP6 1
#endif
#ifndef REP7
#define REP7 1
#endif
__global__ void __launch_bounds__(512, 2) mega(Params p) {
    cg::grid_group grid = cg::this_grid();
    __shared__ uint4 xb_words;
    if (threadIdx.x == 0) xb_words = make_uint4(0u, 0u, 0u, 0u);
    __syncthreads();
    const XcdBarrier xb = xcd_barrier_post((unsigned*)(p.ws + WS_BAR), (volatile LAS unsigned*)&xb_words);
#define GSYNC() xcd_barrier(xb)
    for (int r = 0; r < REP7; ++r) { run_stage<7>(p, 0); grid.sync(); }
    for (int l = 0; l < DEPTH; ++l) {
        for (int r = 0; r < REP0; ++r) { run_stage<0>(p, l); GSYNC(); }
        for (int r = 0; r < REP1; ++r) { run_stage<1>(p, l); GSYNC(); }
        for (int r = 0; r < REP2; ++r) { run_stage<2>(p, l); GSYNC(); }
        for (int r = 0; r < REP3; ++r) { run_stage<3>(p, l); GSYNC(); }
        for (int r = 0; r < REP4; ++r) { run_stage<4>(p, l); }
        run_stage<5>(p, l); GSYNC();
        for (int r = 0; r < REP6; ++r) { run_stage<6>(p, l); if (l + 1 < DEPTH || r + 1 < REP6) GSYNC(); }
    }
}
#else
template <int ST> __global__ void __launch_bounds__(512, 2) stage_k(Params p, int l) { run_stage<ST>(p, l); }
#endif

template <class K> static void set_lds(K k, size_t bytes) { (void)hipFuncSetAttribute((const void*)k, hipFuncAttributeMaxDynamicSharedMemorySize, (int)bytes); }

extern "C" void kernel_launch(void* const* d_in, const int* in_sizes, int n_in, void* d_out, int out_size, void* d_ws, size_t ws_size, hipStream_t stream) {
    constexpr size_t kDynLds = 131072;
    static int grid_blocks = 0;
    if (!grid_blocks) {
        int dev = 0, cus = 0;
        (void)hipGetDevice(&dev);
        (void)hipDeviceGetAttribute(&cus, hipDeviceAttributeMultiprocessorCount, dev);
#if MK_SINGLE
        int per_cu = 0;
        set_lds(mega, kDynLds);
        (void)hipOccupancyMaxActiveBlocksPerMultiprocessor(&per_cu, mega, 512, kDynLds);
        if (per_cu < 1) fprintf(stderr, "occupancy query returned %d\n", per_cu);
#else
        set_lds(stage_k<0>, kDynLds); set_lds(stage_k<1>, kDynLds); set_lds(stage_k<2>, kDynLds); set_lds(stage_k<3>, kDynLds);
        set_lds(stage_k<4>, kDynLds); set_lds(stage_k<5>, kDynLds); set_lds(stage_k<6>, kDynLds); set_lds(stage_k<7>, kDynLds);
#endif
        grid_blocks = cus > 0 ? cus : 256;
    }
    Params p{};
    for (int i = 0; i < 24; ++i) p.in[i] = (const float*)d_in[i];
    p.out = (float*)d_out; p.ws = (char*)d_ws;
    if (ws_size < WS_END) fprintf(stderr, "workspace too small: %zu < %zu\n", ws_size, (size_t)WS_END);
#if MK_SINGLE
    (void)hipMemsetAsync(p.ws + WS_BAR, 0, (size_t)XCD_BAR_WORDS_C * 4, stream);
    void* args[] = {&p};
    hipError_t e = hipLaunchCooperativeKernel((void*)mega, dim3(grid_blocks), dim3(512), args, kDynLds, stream);
    if (e != hipSuccess) fprintf(stderr, "cooperative launch failed: %s (grid %d)\n", hipGetErrorString(e), grid_blocks);
#else
    const dim3 G(grid_blocks), B(512);
    hipLaunchKernelGGL(stage_k<7>, G, B, kDynLds, stream, p, 0);
    for (int l = 0; l < DEPTH; ++l) {
        hipLaunchKernelGGL(stage_k<0>, G, B, kDynLds, stream, p, l);
        hipLaunchKernelGGL(stage_k<1>, G, B, kDynLds, stream, p, l);
        hipLaunchKernelGGL(stage_k<2>, G, B, kDynLds, stream, p, l);
        hipLaunchKernelGGL(stage_k<3>, G, B, kDynLds, stream, p, l);
        hipLaunchKernelGGL(stage_k<4>, G, B, kDynLds, stream, p, l);
        hipLaunchKernelGGL(stage_k<5>, G, B, kDynLds, stream, p, l);
        hipLaunchKernelGGL(stage_k<6>, G, B, kDynLds, stream, p, l);
    }
#endif
}
```

```cpp
#include <hip/hip_runtime.h>
#include <hip/hip_cooperative_groups.h>
#include <cstdio>
namespace cg = cooperative_groups;

#ifndef MK_SINGLE
#define MK_SINGLE 1
#endif

#define LAS __attribute__((address_space(3)))
typedef unsigned short bf16_t;
typedef short bf16x8 __attribute__((ext_vector_type(8)));
typedef float f32x4 __attribute__((ext_vector_type(4)));
typedef float f32x2 __attribute__((ext_vector_type(2)));
typedef unsigned u32x4 __attribute__((ext_vector_type(4)));
typedef unsigned u32x2 __attribute__((ext_vector_type(2)));

constexpr int DM = 2048, DEPTH = 4;
constexpr int MP = 8192, MS = 1024, MT = 9216;
constexpr int DSH = 3200;
constexpr int NP = 11520;
constexpr int NIN = 11392;
constexpr int C_R = 0, C_K = 1024, C_V = 2048, C_WD = 3072, C_AD = 3136, C_GR = 3200, C_U = 4224, C_VG = 5248, C_GG = 6272, C_GA = 7296, C_GB = 9344;
constexpr size_t O_YP = 0, O_WKVP = 18874368, O_SHP = 19922944, O_WKVS = 19974144, O_SHS = 53528576, O_CV = 55166976;
constexpr int NPHASE = 1 + 7 * DEPTH;
constexpr int OT_PM0 = 28, OT_ROW0 = OT_PM0 * 256, OT_ROWS = MT - OT_ROW0;

constexpr int RDY_W0 = 3456 + 256;
constexpr int ZD_W = RDY_W0 + 36 * 64;
constexpr int ZP_PN = 25;
constexpr int XCD_BAR_WORDS_C = ZD_W + 64;
struct Params { const float* in[24]; float* out; char* ws; };
constexpr size_t al256(size_t x) { return (x + 255) & ~(size_t)255; }
constexpr size_t WS_WINT = 0;
constexpr size_t WS_PABT = WS_WINT + al256((size_t)DEPTH * NP * DM * 2);
constexpr size_t WS_WOT = WS_PABT + al256((size_t)DEPTH * DM * DM * 2);
constexpr size_t WS_XN = WS_WOT + al256((size_t)DEPTH * DM * DM * 2);
constexpr size_t WS_Z = WS_XN + al256((size_t)MT * DM * 2);
constexpr size_t WS_VNT = WS_Z + al256((size_t)MT * NP * 2);
constexpr size_t WS_VNTS = WS_VNT + al256((size_t)64 * 1024 * 128 * 2);
constexpr size_t WS_YAB = WS_VNTS + al256((size_t)128 * 1024 * 8 * 2);
constexpr size_t WS_M = WS_YAB + al256((size_t)MT * DM * 2);
constexpr size_t WS_H = WS_M + al256((size_t)MT * DM * 2);
constexpr size_t WS_REC = WS_H + al256((size_t)MT * DM * 4);
constexpr int RECF = 256;
constexpr size_t WS_YBUF = WS_REC + al256((size_t)MT * 16 * RECF * 4);
constexpr size_t WS_PART = WS_YBUF + al256((size_t)MT * 1024 * 4);
constexpr size_t WS_W2T = WS_PART + al256((size_t)2 * OT_ROWS * DM * 4);
constexpr size_t WS_A2T = WS_W2T + al256((size_t)DEPTH * 1024 * 64 * 2);
constexpr size_t WS_BAR = WS_A2T + al256((size_t)DEPTH * 1024 * 64 * 2);
constexpr size_t WS_END = WS_BAR + al256((size_t)XCD_BAR_WORDS_C * 4);
#define P_X_PROMPT (p.in[0])
#define P_X_SAMPLE (p.in[1])
#define P_STATE_WKV (p.in[2])
#define P_STATE_SHIFT (p.in[3])
#define P_NORM_G (p.in[4])
#define P_W_IN (p.in[5])
#define P_SHIFT_MU (p.in[6])
#define P_W0 (p.in[7])
#define P_W2 (p.in[8])
#define P_A0 (p.in[9])
#define P_A2 (p.in[10])
#define P_K_K (p.in[11])
#define P_K_A (p.in[12])
#define P_R_K (p.in[13])
#define P_LNX_G (p.in[14])
#define P_LNX_B (p.in[15])
#define P_SGU_LN_G (p.in[16])
#define P_SGU_LN_B (p.in[17])
#define P_SGU_W (p.in[18])
#define P_SGU_B (p.in[19])
#define P_W_PROJ_A (p.in[20])
#define P_W_PROJ_B (p.in[21])
#define P_W_OUT (p.in[22])
#define P_FINAL_G (p.in[23])
#define P_WINT ((bf16_t*)(p.ws + WS_WINT))
#define P_PABT ((bf16_t*)(p.ws + WS_PABT))
#define P_WOT ((bf16_t*)(p.ws + WS_WOT))
#define P_XN ((bf16_t*)(p.ws + WS_XN))
#define P_Z ((bf16_t*)(p.ws + WS_Z))
#define P_VNT ((bf16_t*)(p.ws + WS_VNT))
#define P_VNTS ((bf16_t*)(p.ws + WS_VNTS))
#define P_YAB ((bf16_t*)(p.ws + WS_YAB))
#define P_M ((bf16_t*)(p.ws + WS_M))
#define P_H ((float*)(p.ws + WS_H))
#define P_REC ((float*)(p.ws + WS_REC))
#define P_YBUF ((float*)(p.ws + WS_YBUF))
#define P_PART ((float*)(p.ws + WS_PART))
#define P_W2T ((bf16_t*)(p.ws + WS_W2T))
#define P_A2T ((bf16_t*)(p.ws + WS_A2T))

extern __shared__ __attribute__((aligned(16))) unsigned char smem_raw[];

__device__ __forceinline__ int otid() { int t = threadIdx.x; asm volatile("" : "+v"(t)); return t; }
__device__ __forceinline__ float bf2f(bf16_t v) { return __uint_as_float(((unsigned)v) << 16); }
__device__ __forceinline__ float bflo(unsigned v) { return __uint_as_float(v << 16); }
__device__ __forceinline__ float bfhi(unsigned v) { return __uint_as_float(v & 0xffff0000u); }
__device__ __forceinline__ unsigned pk_bf16(float lo, float hi) { unsigned r; asm("v_cvt_pk_bf16_f32 %0, %1, %2" : "=v"(r) : "v"(lo), "v"(hi)); return r; }
template <int CTRL> __device__ __forceinline__ float dppf(float x) { return __int_as_float(__builtin_amdgcn_update_dpp(0, __float_as_int(x), CTRL, 0xF, 0xF, true)); }
__device__ __forceinline__ float red16(float x) { x += dppf<0xB1>(x); x += dppf<0x4E>(x); x += dppf<0x141>(x); x += dppf<0x140>(x); return x; }
__device__ __forceinline__ void red16x2(float& x, float& y) { x += dppf<0xB1>(x); y += dppf<0xB1>(y); x += dppf<0x4E>(x); y += dppf<0x4E>(y); x += dppf<0x141>(x); y += dppf<0x141>(y); x += dppf<0x140>(x); y += dppf<0x140>(y); }
__device__ __forceinline__ float red32(float x) { x = red16(x); x += __shfl_xor(x, 16); return x; }
__device__ __forceinline__ float red64(float x) { x = red16(x); x += __shfl_xor(x, 16); x += __shfl_xor(x, 32); return x; }
__device__ __forceinline__ float sigmoidf_(float x) { return __builtin_amdgcn_rcpf(1.f + __expf(-x)); }
__device__ __forceinline__ float tanhf_(float x) { const float e = __expf(2.f * fminf(fmaxf(x, -15.f), 15.f)); return 1.f - 2.f * __builtin_amdgcn_rcpf(1.f + e); }
__device__ __forceinline__ float siluf_(float x) { return x * __builtin_amdgcn_rcpf(1.f + __expf(-x)); }

namespace pg8 {
constexpr int TAILK = 2;
constexpr int BM = 256, BK = 64, HALF = 128, HTB = HALF * BK * 2, STAGE_BYTES = 8 * HTB, NXCD = 8, WGM = 8;
__device__ __forceinline__ int lds_byte(int r, int c) { const int st = (r >> 4) * 2 + (c >> 5), rr = r & 15, cc = c & 31, ob = rr * 64 + cc * 2; return st * 1024 + (ob ^ (((ob >> 9) & 1) << 5)); }
__device__ __forceinline__ void stage_rc(int b, int& R, int& C) { const int st = b / 1024, sb = b % 1024, swz = sb ^ (((sb >> 9) & 1) << 5); R = (st >> 1) * 16 + swz / 64; C = (st & 1) * 32 + (swz % 64) / 2; }
__device__ __forceinline__ int perm32(int rho) { const int n = rho >> 4, i = rho & 15; return 8 * (i >> 2) + 4 * n + (i & 3); }
struct Unit { int pm, pn, seg, nt, kofs; };
struct Gemm { const bf16_t* A; const bf16_t* Bt; int M, N, K; };
struct StaticOrder {
    int nM, nN, nwg, G, c;
    __device__ void init(int M, int N, int K, int G_, int c_, int split_ = 0, int tail_pm0_ = 0) { nM = M / BM; nN = N / BM; nwg = nM * nN; G = G_; c = c_; split = split_; ntk = K / BK; tail_pm0 = tail_pm0_;
        tail_full = 0; tail_shift = 0; rot = 0; tail_base = -1; ready = nullptr; need = 0u; }
    int split, ntk;
    int tail_pm0, tail_full, tail_shift, rot, tail_base;
    unsigned* ready; unsigned need;
    __device__ static void map(int wgid, int nM_, int nN_, int& pm, int& pn) {
        const int nw_ = nM_ * nN_; { const int q = nw_ / NXCD, r = nw_ % NXCD, xcd = wgid % NXCD, off = wgid / NXCD; wgid = (xcd < r ? xcd * (q + 1) : r * (q + 1) + (xcd - r) * q) + off; }
        const int nig = WGM * nN_, gid = wgid / nig, fm = gid * WGM, gsz = (nM_ - fm) < WGM ? (nM_ - fm) : WGM;
        pm = fm + ((wgid % nig) % gsz); pn = (wgid % nig) / gsz;
    }
    __device__ bool next(int i, Unit& u) const {
        const int sg = split ? (i & 1) : 0; if (split) i >>= 1;
        const long L = (long)i * G + (rot ? (c + G - rot) % G : c);
        if (tail_pm0 > 0) {
            const int nmain = tail_pm0 * nN, tb = tail_base >= 0 ? tail_base : nmain;
            if (L < nmain && (tail_base < 0 || L < tail_base)) { map((int)L, tail_pm0, nN, u.pm, u.pn); u.seg = sg; u.nt = split ? ntk / 2 : ntk; u.kofs = sg * u.nt; return true; }
            const long sidx = L - tb - tail_shift; if (sidx < 0) return false;
            if (tail_full) { if (sidx >= (long)(nM - tail_pm0) * nN) return false;
                u.pm = tail_pm0 + (int)sidx / nN; u.pn = (int)sidx % nN; u.seg = sg; u.nt = split ? ntk / 2 : ntk; u.kofs = sg * u.nt; return true; }
            if (sidx >= (long)(nM - tail_pm0) * nN * TAILK) return false;
            const int tt = (int)(sidx / TAILK), sl = (int)(sidx % TAILK); u.pm = tail_pm0 + tt / nN; u.pn = tt % nN; u.seg = 1 + sl; u.nt = ntk / TAILK; u.kofs = sl * (ntk / TAILK); return true;
        }
        if (L >= nwg) return false;
        map((int)L, nM, nN, u.pm, u.pn); u.seg = sg; u.nt = split ? ntk / 2 : ntk; u.kofs = sg * u.nt; return true;
    }
    __device__ __forceinline__ void a_ready(const Unit& u) const {
        if (ready == nullptr) return;
        if (threadIdx.x < 64) {
            unsigned polls = 0;
            while ((unsigned)__builtin_amdgcn_readfirstlane(__hip_atomic_load(ready + 64 * u.pm, __ATOMIC_RELAXED, __HIP_MEMORY_SCOPE_AGENT)) < need) { if (++polls > (1u << 22)) break; __builtin_amdgcn_s_sleep(2); }
            __builtin_amdgcn_fence(__ATOMIC_ACQUIRE, "agent");
            asm volatile("s_waitcnt vmcnt(0)" ::: "memory");
        }
        asm volatile("" ::: "memory"); __builtin_amdgcn_s_barrier(); asm volatile("" ::: "memory");
    }
};

struct ZOrder {
    int G, c, ntk;
    __device__ void init(int K, int G_, int c_) { G = G_; c = c_; ntk = K / BK; }
    __device__ bool next(int i, Unit& u) const {
        constexpr int nA = (MT / 256) * ZP_PN, nB = (MT / 256) * (NP / 256 - ZP_PN);
        const long L = (long)i * G + c; if (L >= nA + nB) return false;
        if (L < nA) StaticOrder::map((int)L, MT / 256, ZP_PN, u.pm, u.pn); else { StaticOrder::map((int)(L - nA), MT / 256, NP / 256 - ZP_PN, u.pm, u.pn); u.pn += ZP_PN; }
        u.seg = 0; u.nt = ntk; u.kofs = 0; return true;
    }
    __device__ __forceinline__ void a_ready(const Unit&) const {}
};

template <class Epi, class Sched>
__device__ __forceinline__ void gemm_phase(LAS unsigned char* lds, const Gemm g, const Sched& S, const Epi& E) {
    const int tid = otid(), wid = __builtin_amdgcn_readfirstlane(tid >> 6), lane = tid & 63, wr = wid >> 2, wc = wid & 3, fr = lane & 15, fq = lane >> 4;
    const int ld = g.K;
    unsigned voffA[2], voffB[2];
#pragma unroll
    for (int i = 0; i < 2; ++i) { int R, C; stage_rc(tid * 16 + i * 8192, R, C); const int Rb = Epi::PERM ? ((R & ~31) + perm32(R & 31)) : R;
        voffA[i] = (unsigned)(R * ld + C) * 2u; voffB[i] = (unsigned)(Rb * ld + C) * 2u; }
    const size_t kstep = (size_t)(BK * 2);
    const size_t hstep = (size_t)HALF * ld * 2;
    const size_t tstep = 2 * hstep;
    const unsigned ldsw = (unsigned)wid * 1024u;
    const int aoff = lds_byte(wr * 64 + fr, fq * 8), boff = lds_byte(wc * 32 + fr, fq * 8);
#define PG8_SA(b, h) (((b) * 2 + (h)) * HTB)
#define PG8_SB(b, h) ((4 + (b) * 2 + (h)) * HTB)
#define PG8_STAGE(bufoff, gbase, voff) do { _Pragma("unroll") for (int _i = 0; _i < 2; ++_i) \
        __builtin_amdgcn_global_load_lds((const unsigned*)((const char*)(gbase) + (voff)[_i]), (LAS unsigned*)(lds + (bufoff) + ldsw + _i * 8192), 16, 0, 0); } while (0)
#define PG8_LDA(dst, b, h) do { _Pragma("unroll") for (int m = 0; m < 4; ++m) _Pragma("unroll") for (int k = 0; k < 2; ++k) dst[m][k] = *(const LAS bf16x8*)(lds + PG8_SA(b, h) + aoff + m * 2048 + k * 1024); } while (0)
#define PG8_LDB(dst, b, h) do { _Pragma("unroll") for (int n = 0; n < 2; ++n) _Pragma("unroll") for (int k = 0; k < 2; ++k) dst[n][k] = *(const LAS bf16x8*)(lds + PG8_SB(b, h) + boff + n * 2048 + k * 1024); } while (0)
#define PG8_MMA(ai, bj, At, Bt) do { __builtin_amdgcn_s_setprio(1); _Pragma("unroll") for (int m = 0; m < 4; ++m) _Pragma("unroll") for (int n = 0; n < 2; ++n) _Pragma("unroll") for (int k = 0; k < 2; ++k) \
        acc[ai][bj][m][n] = __builtin_amdgcn_mfma_f32_16x16x32_bf16(Bt[n][k], At[m][k], acc[ai][bj][m][n], 0, 0, 0); __builtin_amdgcn_s_setprio(0); } while (0)
#define PG8_WAIT_V(n) asm volatile("s_waitcnt vmcnt(" #n ")" ::: "memory")
#define PG8_WAIT_L(n) asm volatile("s_waitcnt lgkmcnt(" #n ")" ::: "memory")
#define PG8_BAR __builtin_amdgcn_s_barrier()
#define PG8_SCHED __builtin_amdgcn_sched_barrier(0)
    Unit cur, nxt; int ui = 0;
    if (!S.next(0, cur)) return;
    S.a_ready(cur);
    f32x4 acc[2][2][4][2];
#pragma unroll
    for (int a = 0; a < 2; ++a)
#pragma unroll
        for (int b = 0; b < 2; ++b)
#pragma unroll
            for (int m = 0; m < 4; ++m)
#pragma unroll
                for (int n = 0; n < 2; ++n) acc[a][b][m][n] = (f32x4){0.f, 0.f, 0.f, 0.f};
    bf16x8 At[4][2], B0[2][2], B1[2][2];
    const char* cA = (const char*)g.A + (size_t)cur.pm * tstep + (size_t)cur.kofs * kstep; const char* cB = (const char*)g.Bt + (size_t)cur.pn * tstep + (size_t)cur.kofs * kstep;
    PG8_STAGE(PG8_SB(0, 0), cB, voffB); PG8_STAGE(PG8_SA(0, 0), cA, voffA); PG8_STAGE(PG8_SB(0, 1), cB + hstep, voffB); PG8_STAGE(PG8_SA(0, 1), cA + hstep, voffA);
    if (wr == 1) PG8_BAR;
    PG8_WAIT_V(4); PG8_BAR;
    PG8_STAGE(PG8_SB(1, 0), cB + kstep, voffB); PG8_STAGE(PG8_SA(1, 0), cA + kstep, voffA); PG8_STAGE(PG8_SB(1, 1), cB + hstep + kstep, voffB);
    PG8_WAIT_V(6); PG8_BAR;
    for (;;) {
        const bool has_next = S.next(ui + 1, nxt);
        const char* nA = has_next ? (const char*)g.A + (size_t)nxt.pm * tstep + (size_t)nxt.kofs * kstep : cA; const char* nB = has_next ? (const char*)g.Bt + (size_t)nxt.pn * tstep + (size_t)nxt.kofs * kstep : cB;
        const int nt = cur.nt;
        for (int t = 0; t < nt; t += 2) {
            const bool last = (t == nt - 2);
            if (last && has_next) S.a_ready(nxt);
            const char* a1 = cA + (size_t)(t + 1) * kstep;
            const char* a2 = last ? nA : cA + (size_t)(t + 2) * kstep; const char* b2 = last ? nB : cB + (size_t)(t + 2) * kstep;
            const char* a3 = a2 + kstep; const char* b3 = b2 + kstep;
            PG8_LDB(B0, 0, 0); PG8_SCHED; PG8_LDA(At, 0, 0); PG8_STAGE(PG8_SA(1, 1), a1 + hstep, voffA);
            PG8_WAIT_L(8); PG8_BAR; PG8_WAIT_L(0); PG8_MMA(0, 0, At, B0); PG8_BAR; PG8_SCHED;
            PG8_LDB(B1, 0, 1); PG8_STAGE(PG8_SB(0, 0), b2, voffB);
            PG8_BAR; PG8_WAIT_L(0); PG8_MMA(0, 1, At, B1); PG8_BAR;
            PG8_LDA(At, 0, 1); PG8_STAGE(PG8_SA(0, 0), a2, voffA);
            PG8_BAR; PG8_WAIT_L(0); PG8_MMA(1, 0, At, B0); PG8_BAR; PG8_SCHED;
            PG8_STAGE(PG8_SB(0, 1), b2 + hstep, voffB);
            PG8_WAIT_V(6); PG8_BAR; PG8_MMA(1, 1, At, B1); PG8_BAR;
            PG8_LDB(B0, 1, 0); PG8_SCHED; PG8_LDA(At, 1, 0); PG8_STAGE(PG8_SA(0, 1), a2 + hstep, voffA);
            PG8_WAIT_L(8); PG8_BAR; PG8_WAIT_L(0); PG8_MMA(0, 0, At, B0); PG8_BAR; PG8_SCHED;
            PG8_LDB(B1, 1, 1); PG8_STAGE(PG8_SB(1, 0), b3, voffB);
            PG8_BAR; PG8_WAIT_L(0); PG8_MMA(0, 1, At, B1); PG8_BAR;
            PG8_LDA(At, 1, 1); PG8_STAGE(PG8_SA(1, 0), a3, voffA);
            PG8_BAR; PG8_WAIT_L(0); PG8_MMA(1, 0, At, B0); PG8_BAR; PG8_SCHED;
            PG8_STAGE(PG8_SB(1, 1), b3 + hstep, voffB);
            PG8_WAIT_V(6); PG8_BAR; PG8_MMA(1, 1, At, B1); PG8_BAR;
        }
        E(acc, cur, wr, wc, fr, fq);
        if (!has_next) break;
        if (!(Epi::SPLIT2 && cur.seg == 0))
#pragma unroll
        for (int a = 0; a < 2; ++a)
#pragma unroll
            for (int b = 0; b < 2; ++b)
#pragma unroll
                for (int m = 0; m < 4; ++m)
#pragma unroll
                    for (int n = 0; n < 2; ++n) acc[a][b][m][n] = (f32x4){0.f, 0.f, 0.f, 0.f};
        cur = nxt; cA = nA; cB = nB; ++ui;
    }
    PG8_WAIT_V(0);
    if (wr == 0) PG8_BAR;
    PG8_BAR;
#undef PG8_SA
#undef PG8_SB
#undef PG8_STAGE
#undef PG8_LDA
#undef PG8_LDB
#undef PG8_MMA
#undef PG8_WAIT_V
#undef PG8_WAIT_L
#undef PG8_BAR
#undef PG8_SCHED
}
}

struct EpiZ {
    static constexpr bool PERM = true, SPLIT2 = false;
    bf16_t* Z; unsigned* zdone;
    __device__ __forceinline__ void operator()(f32x4 (&acc)[2][2][4][2], const pg8::Unit& u, int wr, int wc, int fr, int fq) const {
        const int row0 = u.pm * 256 + wr * 64 + fr, col0 = u.pn * 256 + wc * 32 + 8 * fq;
        if (u.pn < ZP_PN) {
            const __amdgpu_buffer_rsrc_t zrs = __builtin_amdgcn_make_buffer_rsrc((void*)Z, 0, MT * NP * 2, 0x00020000);
#pragma unroll
            for (int ai = 0; ai < 2; ++ai)
#pragma unroll
                for (int m = 0; m < 4; ++m) { const unsigned zo = (unsigned)(((size_t)(row0 + ai * 128 + m * 16) * NP + col0) * 2);
#pragma unroll
                    for (int bj = 0; bj < 2; ++bj) { const f32x4 v0 = acc[ai][bj][m][0], v1 = acc[ai][bj][m][1];
                        u32x4 o; o[0] = pk_bf16(v0[0], v0[1]); o[1] = pk_bf16(v0[2], v0[3]); o[2] = pk_bf16(v1[0], v1[1]); o[3] = pk_bf16(v1[2], v1[3]);
                        __builtin_amdgcn_raw_buffer_store_b128(o, zrs, zo + bj * 256, 0, 16); } }
            asm volatile("s_waitcnt vmcnt(0)" ::: "memory");
            if (fr == 0 && fq == 0) (void)__hip_atomic_fetch_add(zdone, 1u, __ATOMIC_RELAXED, __HIP_MEMORY_SCOPE_AGENT);
            return;
        }
#pragma unroll
        for (int ai = 0; ai < 2; ++ai)
#pragma unroll
            for (int m = 0; m < 4; ++m) { bf16_t* rowp = Z + (size_t)(row0 + ai * 128 + m * 16) * NP + col0;
#pragma unroll
                for (int bj = 0; bj < 2; ++bj) { const f32x4 v0 = acc[ai][bj][m][0], v1 = acc[ai][bj][m][1];
                    u32x4 o; o[0] = pk_bf16(v0[0], v0[1]); o[1] = pk_bf16(v0[2], v0[3]); o[2] = pk_bf16(v1[0], v1[1]); o[3] = pk_bf16(v1[2], v1[3]);
                    *(u32x4*)(rowp + bj * 128) = o; } }
    }
};
struct EpiMerge {
    static constexpr bool PERM = true, SPLIT2 = true;
    const bf16_t* Z; bf16_t* Mo; unsigned* ready;
    __device__ __forceinline__ void mid(f32x4 (&acc)[2][2][4][2], const pg8::Unit& u, int wr, int wc, int fr, int fq) const {
        const int row0 = u.pm * 256 + wr * 64 + fr, col0 = u.pn * 256 + wc * 32 + 8 * fq;
#pragma unroll
        for (int ai = 0; ai < 2; ++ai)
#pragma unroll
            for (int m = 0; m < 4; ++m) { const bf16_t* zr = Z + (size_t)(row0 + ai * 128 + m * 16) * NP + col0;
#pragma unroll
                for (int bj = 0; bj < 2; ++bj) { const u32x4 ga = *(const u32x4*)(zr + C_GA + bj * 128), gb = *(const u32x4*)(zr + C_GB + bj * 128);
#pragma unroll
                    for (int q = 0; q < 4; ++q) { const float a0 = bflo(ga[q]), a1 = bfhi(ga[q]), b0 = bflo(gb[q]), b1 = bfhi(gb[q]);
                        const float r0 = (1.f + __expf(-b0)) * __builtin_amdgcn_rcpf(1.f + __expf(-a0)), r1 = (1.f + __expf(-b1)) * __builtin_amdgcn_rcpf(1.f + __expf(-a1));
                        acc[ai][bj][m][q >> 1][(q & 1) * 2] *= r0; acc[ai][bj][m][q >> 1][(q & 1) * 2 + 1] *= r1; } } }
    }
    __device__ __forceinline__ void fin(f32x4 (&acc)[2][2][4][2], const pg8::Unit& u, int wr, int wc, int fr, int fq) const {
        const int row0 = u.pm * 256 + wr * 64 + fr, col0 = u.pn * 256 + wc * 32 + 8 * fq;
        const __amdgpu_buffer_rsrc_t rs = __builtin_amdgcn_make_buffer_rsrc((void*)Mo, 0, MT * DM * 2, 0x00020000);
#pragma unroll
        for (int ai = 0; ai < 2; ++ai)
#pragma unroll
            for (int m = 0; m < 4; ++m) { const size_t r = (size_t)(row0 + ai * 128 + m * 16); const bf16_t* zr = Z + r * NP + col0; const unsigned mo = (unsigned)((r * DM + col0) * 2);
#pragma unroll
                for (int bj = 0; bj < 2; ++bj) { const u32x4 gb = *(const u32x4*)(zr + C_GB + bj * 128); u32x4 o;
#pragma unroll
                    for (int q = 0; q < 4; ++q) { const float s0 = sigmoidf_(bflo(gb[q])), s1 = sigmoidf_(bfhi(gb[q]));
                        o[q] = pk_bf16(acc[ai][bj][m][q >> 1][(q & 1) * 2] * s0, acc[ai][bj][m][q >> 1][(q & 1) * 2 + 1] * s1); }
                    __builtin_amdgcn_raw_buffer_store_b128(o, rs, mo + bj * 256, 0, 16); } }
        asm volatile("s_waitcnt vmcnt(0)" ::: "memory");
        if (fr == 0 && fq == 0) (void)__hip_atomic_fetch_add(ready + 64 * u.pm, 1u, __ATOMIC_RELAXED, __HIP_MEMORY_SCOPE_AGENT);
    }
    __device__ __forceinline__ void operator()(f32x4 (&acc)[2][2][4][2], const pg8::Unit& u, int wr, int wc, int fr, int fq) const {
        if (u.seg == 0) mid(acc, u, wr, wc, fr, fq); else fin(acc, u, wr, wc, fr, fq);
    }
};
struct EpiOut {
    static constexpr bool PERM = false, SPLIT2 = false;
    const float* hp; const float* hs; float* Ho; float* Part;
    __device__ __forceinline__ void operator()(f32x4 (&acc)[2][2][4][2], const pg8::Unit& u, int wr, int wc, int fr, int fq) const {
        const int row0 = u.pm * 256 + wr * 64 + fr, col0 = u.pn * 256 + wc * 32 + 4 * fq;
        if (u.seg) {
            float* pb = Part + ((size_t)(u.seg - 1) * OT_ROWS + (row0 - OT_ROW0)) * DM + col0;
#pragma unroll
            for (int ai = 0; ai < 2; ++ai)
#pragma unroll
                for (int m = 0; m < 4; ++m)
#pragma unroll
                    for (int bj = 0; bj < 2; ++bj)
#pragma unroll
                        for (int n = 0; n < 2; ++n) *(f32x4*)(pb + (size_t)(ai * 128 + m * 16) * DM + bj * 128 + n * 16) = acc[ai][bj][m][n];
            return;
        }
        const float* src = (u.pm < 32) ? hp + (size_t)row0 * DM : hs + (size_t)(row0 - MP) * DM;
#pragma unroll
        for (int ai = 0; ai < 2; ++ai)
#pragma unroll
            for (int m = 0; m < 4; ++m) { const size_t ro = (size_t)(ai * 128 + m * 16) * DM + col0; float* dst = Ho + (size_t)row0 * DM + ro;
#pragma unroll
                for (int bj = 0; bj < 2; ++bj)
#pragma unroll
                    for (int n = 0; n < 2; ++n) { const f32x4 o = *(const f32x4*)(src + ro + bj * 128 + n * 16) + acc[ai][bj][m][n]; *(f32x4*)(dst + bj * 128 + n * 16) = o; } }
    }
};

__device__ __forceinline__ void conv_unit(const float* __restrict__ W, int K, int N, int Npad, bf16_t* __restrict__ Wt, int ldt, int unit, int lane) {
    const int nnb = Npad >> 6; const int kb = unit / nnb, nb = unit - kb * nnb;
    const int n = nb * 64 + lane, k0 = kb * 64;
    bf16_t* dst = Wt + (size_t)n * ldt + k0;
    if (n < N) {
        const float* src = W + (size_t)k0 * N + n;
        float v[64];
#pragma unroll
        for (int j = 0; j < 64; ++j) v[j] = src[(size_t)j * N];
#pragma unroll
        for (int kk = 0; kk < 64; kk += 8) { u32x4 o; o[0] = pk_bf16(v[kk], v[kk + 1]); o[1] = pk_bf16(v[kk + 2], v[kk + 3]); o[2] = pk_bf16(v[kk + 4], v[kk + 5]); o[3] = pk_bf16(v[kk + 6], v[kk + 7]);
            *(u32x4*)(dst + kk) = o; }
    } else {
#pragma unroll
        for (int kk = 0; kk < 64; kk += 8) *(u32x4*)(dst + kk) = (u32x4){0u, 0u, 0u, 0u};
    }
}
__device__ void phase_convert(const Params& p, int l, int gw, int nw) {
    const int lane = otid() & 63;
    constexpr int U_IN = (NP / 64) * 32, U_P = 32 * 16, U_O = 32 * 32, U_L = U_IN + 2 * U_P + U_O;
    for (int u = gw; u < U_L; u += nw) {
        int r = u;
        if (r < U_IN) conv_unit(P_W_IN + (size_t)l * DM * NIN, DM, NIN, NP, P_WINT + (size_t)l * NP * DM, DM, r, lane);
        else if ((r -= U_IN) < U_P) conv_unit(P_W_PROJ_A + (size_t)l * 1024 * DM, 1024, DM, DM, P_PABT + (size_t)l * DM * DM, DM, r, lane);
        else if ((r -= U_P) < U_P) conv_unit(P_W_PROJ_B + (size_t)l * 1024 * DM, 1024, DM, DM, P_PABT + (size_t)l * DM * DM + 1024, DM, r, lane);
        else { r -= U_P; conv_unit(P_W_OUT + (size_t)l * DM * DM, DM, DM, DM, P_WOT + (size_t)l * DM * DM, DM, r, lane); }
    }
}

__device__ void phase_rmsnorm(const float* hp, const float* hs, const float* g, bf16_t* obf, float* of32, const float* part, float* hs_w) {
    const int lane = otid() & 63, gw = blockIdx.x * 8 + (otid() >> 6), nw = gridDim.x * 8;
    for (int row = gw; row < MT; row += nw) {
        const f32x4* x = (const f32x4*)(row < MP ? hp + (size_t)row * DM : hs + (size_t)(row - MP) * DM);
        f32x4 v[8]; float ss = 0.f;
#pragma unroll
        for (int i = 0; i < 8; ++i) v[i] = x[lane + 64 * i];
        if (part && row >= OT_ROW0) {
#pragma unroll
            for (int sl = 0; sl < pg8::TAILK; ++sl) { const f32x4* pp = (const f32x4*)(part + ((size_t)sl * OT_ROWS + (row - OT_ROW0)) * DM);
#pragma unroll
                for (int i = 0; i < 8; ++i) v[i] += pp[lane + 64 * i]; }
#pragma unroll
            for (int i = 0; i < 8; ++i) ((f32x4*)(hs_w + (size_t)row * DM))[lane + 64 * i] = v[i];
        }
#pragma unroll
        for (int i = 0; i < 8; ++i) ss += v[i][0] * v[i][0] + v[i][1] * v[i][1] + v[i][2] * v[i][2] + v[i][3] * v[i][3];
        ss = red64(ss);
        const float rstd = rsqrtf(ss * (1.f / DM) + 1e-6f);
#pragma unroll
        for (int i = 0; i < 8; ++i) { const f32x4 gg = ((const f32x4*)g)[lane + 64 * i]; const f32x4 o = v[i] * rstd * gg;
            if (obf) { u32x2 w; w[0] = pk_bf16(o[0], o[1]); w[1] = pk_bf16(o[2], o[3]); *(u32x2*)(obf + (size_t)row * DM + (lane + 64 * i) * 4) = w; }
            else *(f32x4*)(of32 + (size_t)row * DM + (lane + 64 * i) * 4) = o; }
    }
}

__device__ void phase_prep(const Params& p, int l) {
    LAS float* sm = (LAS float*)smem_raw;
    LAS bf16_t* twb = (LAS bf16_t*)sm;
    LAS bf16_t* adb = twb + 16 * 72;
    LAS float* red = sm + 1152;
    LAS float* lwla = sm + 2048;
    const int tid = otid(), lane = tid & 63, wv = tid >> 6;
    const int c = tid * 2;
    const float* mu = P_SHIFT_MU + l * DSH;
    for (int i = tid; i < 2 * 8 * 72 / 2; i += 512) { const int m_ = i / 288, r_ = i % 288; ((LAS unsigned*)(twb + m_ * 16 * 72 + 8 * 72))[r_] = 0u; }
    {
        if (tid == 0) { const unsigned need = (unsigned)((MT / 256) * ZP_PN * 8) * (unsigned)(l + 1); unsigned* zd = (unsigned*)(p.ws + WS_BAR) + ZD_W; unsigned polls = 0;
            while (__hip_atomic_load(zd, __ATOMIC_RELAXED, __HIP_MEMORY_SCOPE_AGENT) < need) { if (++polls > (1u << 22)) break; __builtin_amdgcn_s_sleep(4); }
            __builtin_amdgcn_fence(__ATOMIC_ACQUIRE, "agent"); asm volatile("s_waitcnt vmcnt(0)" ::: "memory"); }
        __syncthreads();
    }
    unsigned* qhead = (unsigned*)(p.ws + WS_BAR) + 3456 + 64 * l;
    LAS int* qslot = (LAS int*)(sm + 1300);
    for (;;) {
        if (tid == 0) *qslot = (int)__hip_atomic_fetch_add(qhead, 1u, __ATOMIC_RELAXED, __HIP_MEMORY_SCOPE_AGENT);
        __syncthreads();
        const int qi = *qslot;
        if (qi >= MT / 8) break;
        const int item = qi < MS / 8 ? MP / 8 + qi : qi - MS / 8;
        const int row0 = item * 8;
        const bool samp = row0 >= MP;
        const int sb = (row0 - MP) >> 3, pb = row0 >> 11, t0 = row0 & 2047;
        const bf16_t* zr = P_Z + (size_t)row0 * NP;
        const float* sprev = P_STATE_SHIFT + (size_t)(l * 128 + (samp ? sb : 0)) * DSH;
        const bool zprev = (!samp) && (t0 == 0);
        {
            const int j = tid & 127, col = C_WD + j, tp = tid >> 7;
            const float m_ = mu[col];
#pragma unroll
            for (int tt = 0; tt < 2; ++tt) { const int t = tp * 2 + tt;
                const float cur = bf2f(zr[(size_t)t * NP + col]);
                float prv;
                if (t == 0) prv = samp ? sprev[col] : (zprev ? 0.f : bf2f(*(zr + col - NP))); else prv = bf2f(zr[(size_t)(t - 1) * NP + col]);
                const float mix = cur + (prv - cur) * m_;
                if (j < 64) twb[t * 72 + j] = (bf16_t)(pk_bf16(tanhf_(mix), 0.f) & 0xffffu); else adb[t * 72 + j - 64] = (bf16_t)(pk_bf16(mix, 0.f) & 0xffffu); }
        }
        unsigned vgw[8];
#pragma unroll
        for (int t = 0; t < 8; ++t) vgw[t] = *(const unsigned*)(zr + (size_t)t * NP + C_VG + c);
        float rm[8][2], km[8][2], vm[8][2];
#pragma unroll
        for (int sec = 0; sec < 3; ++sec) { const int col = sec * 1024 + c;
            float p0, p1;
            if (samp) { const f32x2 s2 = *(const f32x2*)(sprev + col); p0 = s2[0]; p1 = s2[1]; }
            else if (zprev) { p0 = 0.f; p1 = 0.f; }
            else { const unsigned w = *(const unsigned*)(zr + col - NP); p0 = bflo(w); p1 = bfhi(w); }
            const f32x2 m2 = *(const f32x2*)(mu + col);
#pragma unroll
            for (int t = 0; t < 8; ++t) { const unsigned w = *(const unsigned*)(zr + (size_t)t * NP + col); const float c0 = bflo(w), c1 = bfhi(w);
                const float x0 = c0 + (p0 - c0) * m2[0], x1 = c1 + (p1 - c1) * m2[1];
                if (sec == 0) { rm[t][0] = x0; rm[t][1] = x1; } else if (sec == 1) { km[t][0] = x0; km[t][1] = x1; } else { vm[t][0] = x0; vm[t][1] = x1; }
                p0 = c0; p1 = c1; } }
        __syncthreads();
        {
            const int fr = lane & 15, fq = lane >> 4;
            bf16x8 aw[2], aa[2];
#pragma unroll
            for (int ks = 0; ks < 2; ++ks) { aw[ks] = *(const LAS bf16x8*)(twb + fr * 72 + ks * 32 + fq * 8); aa[ks] = *(const LAS bf16x8*)(adb + fr * 72 + ks * 32 + fq * 8); }
            const bf16_t* w2t = P_W2T + ((size_t)l * 1024 + wv * 128 + fr) * 64 + fq * 8;
            const bf16_t* a2t = P_A2T + ((size_t)l * 1024 + wv * 128 + fr) * 64 + fq * 8;
#pragma unroll
            for (int nt = 0; nt < 8; ++nt) {
                f32x4 dw = (f32x4){0.f, 0.f, 0.f, 0.f}, da = (f32x4){0.f, 0.f, 0.f, 0.f};
#pragma unroll
                for (int ks = 0; ks < 2; ++ks) { const bf16x8 bw = *(const bf16x8*)(w2t + nt * 16 * 64 + ks * 32), ba = *(const bf16x8*)(a2t + nt * 16 * 64 + ks * 32);
                    dw = __builtin_amdgcn_mfma_f32_16x16x32_bf16(aw[ks], bw, dw, 0, 0, 0); da = __builtin_amdgcn_mfma_f32_16x16x32_bf16(aa[ks], ba, da, 0, 0, 0); }
                if (fq < 2) { const int ch = wv * 128 + nt * 16 + fr;
#pragma unroll
                    for (int r = 0; r < 4; ++r) *(LAS f32x2*)(lwla + ((fq * 4 + r) * 1024 + ch) * 2) = (f32x2){dw[r], da[r]}; }
            }
        }
        __syncthreads();
        float lw[8][2], la[8][2];
        { const f32x2 w0v = *(const f32x2*)(P_W0 + l * 1024 + c), a0v = *(const f32x2*)(P_A0 + l * 1024 + c);
#pragma unroll
          for (int t = 0; t < 8; ++t) { const f32x4 v = *(const LAS f32x4*)(lwla + (t * 1024 + c) * 2);
              lw[t][0] = w0v[0] + v[0]; la[t][0] = a0v[0] + v[1]; lw[t][1] = w0v[1] + v[2]; la[t][1] = a0v[1] + v[3]; } }
        {
            const f32x2 kkv = *(const f32x2*)(P_K_K + l * 1024 + c), kav = *(const f32x2*)(P_K_A + l * 1024 + c);
            const int hh = c >> 6, cc = c & 63;
#pragma unroll
            for (int t = 0; t < 8; ++t) {
                float dec[2], ag[2], kk[2], kp[2];
#pragma unroll
                for (int e = 0; e < 2; ++e) { const float y = -lw[t][e]; const float sp = fmaxf(y, 0.f) + __logf(1.f + __expf(-fabsf(y)));
                    const float wl = -sp - 0.5f; dec[e] = __expf(-__expf(wl)); ag[e] = sigmoidf_(la[t][e]); kk[e] = km[t][e] * kkv[e]; kp[e] = km[t][e] * (1.f + (ag[e] - 1.f) * kav[e]); }
                const float ss = red32(kk[0] * kk[0] + kk[1] * kk[1]);
                const float inv = __builtin_amdgcn_rsqf(fmaxf(ss, 1e-24f));
                float* rc = P_REC + ((size_t)(row0 + t) * 16 + hh) * RECF;
                u32x4 pkd; pkd[0] = pk_bf16(rm[t][0], rm[t][1]); pkd[1] = pk_bf16(kp[0], kp[1]); pkd[2] = pk_bf16(-kk[0] * inv, -kk[1] * inv); pkd[3] = pk_bf16(kk[0] * inv * ag[0], kk[1] * inv * ag[1]);
                *(u32x4*)(rc + (cc >> 1) * 4) = pkd;
                *(f32x4*)(rc + 128 + (cc >> 1) * 4) = (f32x4){dec[0], dec[1], vm[t][0], vm[t][1]};
            }
        }
        {
            float x[8][2];
#pragma unroll
            for (int t = 0; t < 8; ++t) { x[t][0] = bflo(vgw[t]); x[t][1] = bfhi(vgw[t]); }
#pragma unroll
            for (int t = 0; t < 8; ++t) { const float s1 = red64(x[t][0] + x[t][1]), s2 = red64(x[t][0] * x[t][0] + x[t][1] * x[t][1]);
                if (lane == 0) { red[wv * 16 + t] = s1; red[wv * 16 + 8 + t] = s2; } }
            __syncthreads();
            const f32x2 gv = *(const f32x2*)(P_SGU_LN_G + l * 1024 + c), bv = *(const f32x2*)(P_SGU_LN_B + l * 1024 + c);
            float vn[8][2];
#pragma unroll
            for (int t = 0; t < 8; ++t) { float s1 = 0.f, s2 = 0.f;
#pragma unroll
                for (int w = 0; w < 8; ++w) { s1 += red[w * 16 + t]; s2 += red[w * 16 + 8 + t]; }
                const float mean = s1 * (1.f / 1024.f), var = fmaxf(s2 * (1.f / 1024.f) - mean * mean, 0.f), rstd = rsqrtf(var + 1e-5f);
                vn[t][0] = (x[t][0] - mean) * rstd * gv[0] + bv[0]; vn[t][1] = (x[t][1] - mean) * rstd * gv[1] + bv[1]; }
#pragma unroll
            for (int e = 0; e < 2; ++e) { u32x4 o; o[0] = pk_bf16(vn[0][e], vn[1][e]); o[1] = pk_bf16(vn[2][e], vn[3][e]); o[2] = pk_bf16(vn[4][e], vn[5][e]); o[3] = pk_bf16(vn[6][e], vn[7][e]);
                if (samp) *(u32x4*)(P_VNTS + ((size_t)sb * 1024 + c + e) * 8) = o;
                else *(u32x4*)(P_VNT + (((size_t)(pb * 16 + (t0 >> 7)) * 16 + ((t0 & 127) >> 3)) * 1024 + c + e) * 8) = o; }
            if (samp) {
#pragma unroll
                for (int t = 0; t < 8; ++t) *(f32x2*)(p.out + O_CV + ((size_t)(l * 128 + sb) * 8 + t) * 1024 + c) = (f32x2){vn[t][0], vn[t][1]};
            }
        }
        if (samp) { for (int col = tid; col < DSH; col += 512) p.out[O_SHS + (size_t)(l * 128 + sb) * DSH + col] = bf2f(zr[(size_t)7 * NP + col]); }
        else if (t0 == 2040) { for (int col = tid; col < DSH; col += 512) p.out[O_SHP + (size_t)(l * 4 + pb) * DSH + col] = bf2f(zr[(size_t)7 * NP + col]); }
        __syncthreads();
    }
}

#define WAVE_SYNC() do { asm volatile("s_waitcnt lgkmcnt(0)" ::: "memory"); __builtin_amdgcn_wave_barrier(); } while (0)
__device__ __forceinline__ float dot4(const f32x4 a, const f32x4 b) { return a[0] * b[0] + a[1] * b[1] + a[2] * b[2] + a[3] * b[3]; }

__device__ void scan_prompt_unit(const Params& p, int l, int unit, int wv, int lane, LAS float* lw) {
    const int bh = unit >> 2, b = bh >> 4, h = bh & 15;
    const int rg = lane >> 4, kq = lane & 15;
    const int v0 = (unit & 3) * 16 + wv * 4 + rg;
    const float* recb = P_REC + ((size_t)(b * 2048) * 16 + h) * RECF;
    float* yb = P_YBUF + (size_t)(b * 2048) * 1024 + h * 64 + v0;
    constexpr size_t TS = 16 * RECF;
    LAS float* lv = lw + 16 * 5 * 64;
    LAS float* ly = lv + 64;
    f32x4 s = (f32x4){0.f, 0.f, 0.f, 0.f};
    u32x2 nxA[4][4], nxB[4][4]; f32x4 nwA[4], nwB[4]; float nvA, nvB;
#define SCAN_LOAD_BATCH(nx, nw, nv, tb_) do { \
        _Pragma("unroll") for (int j = 0; j < 4; ++j) { const float* rp = recb + (size_t)((tb_) + rg + 4 * j) * TS; \
            const u32x4 q0 = *(const u32x4*)(rp + kq * 8), q1 = *(const u32x4*)(rp + kq * 8 + 4);     \
            nx[j][0] = (u32x2){q0[0], q1[0]}; nx[j][1] = (u32x2){q0[1], q1[1]}; nx[j][2] = (u32x2){q0[2], q1[2]}; nx[j][3] = (u32x2){q0[3], q1[3]}; \
            const f32x2 w0 = *(const f32x2*)(rp + 128 + kq * 8), w1 = *(const f32x2*)(rp + 128 + kq * 8 + 4); nw[j] = (f32x4){w0[0], w0[1], w1[0], w1[1]}; } \
        nv = recb[(size_t)((tb_) + kq) * TS + 128 + (v0 >> 1) * 4 + 2 + (v0 & 1)]; } while (0)
#define BF4(u) ((f32x4){bflo((u)[0]), bfhi((u)[0]), bflo((u)[1]), bfhi((u)[1])})
#define SCAN_BATCH(nx, nw, nv, tb_) do { \
        WAVE_SYNC(); \
        _Pragma("unroll") for (int j = 0; j < 4; ++j) { LAS float* ls = lw + (rg + 4 * j) * 5 * 64 + kq * 4;     \
            *(LAS f32x4*)(ls) = BF4(nx[j][0]); *(LAS f32x4*)(ls + 64) = nw[j]; *(LAS f32x4*)(ls + 128) = BF4(nx[j][1]); *(LAS f32x4*)(ls + 192) = BF4(nx[j][2]); *(LAS f32x4*)(ls + 256) = BF4(nx[j][3]); } \
        lv[kq * 4 + rg] = nv; \
        WAVE_SYNC(); \
        if ((tb_) + 32 < 2048) SCAN_LOAD_BATCH(nx, nw, nv, (tb_) + 32); \
        f32x4 a4 = *(const LAS f32x4*)(lw + 3 * 64 + kq * 4); \
        float pa = dot4(s, a4), py = 0.f; \
        _Pragma("unroll") for (int q = 0; q < 16; ++q) { \
            const LAS float* lc = lw + q * 5 * 64 + kq * 4; \
            const f32x4 w4 = *(const LAS f32x4*)(lc + 64), k4 = *(const LAS f32x4*)(lc + 128), b4 = *(const LAS f32x4*)(lc + 256), r4 = *(const LAS f32x4*)(lc); \
            const float vv = lv[q * 4 + rg]; \
            f32x4 a4n = a4; \
            if (q < 15) a4n = *(const LAS f32x4*)(lc + 5 * 64 + 192); \
            if (q > 0) { red16x2(pa, py); ly[(q - 1) * 4 + rg] = py; } else pa = red16(pa); \
            s = s * w4 + vv * k4 + pa * b4; \
            py = dot4(s, r4); \
            if (q < 15) pa = dot4(s, a4n); \
            a4 = a4n; } \
        py = red16(py); ly[15 * 4 + rg] = py; \
        asm volatile("s_waitcnt lgkmcnt(0)" ::: "memory"); \
        yb[(size_t)((tb_) + kq) * 1024] = ly[kq * 4 + rg]; } while (0)
    SCAN_LOAD_BATCH(nxA, nwA, nvA, 0);
    SCAN_LOAD_BATCH(nxB, nwB, nvB, 16);
    for (int tb = 0; tb < 2048; tb += 32) {
        SCAN_BATCH(nxA, nwA, nvA, tb);
        SCAN_BATCH(nxB, nwB, nvB, tb + 16);
    }
#undef SCAN_BATCH
#undef SCAN_LOAD_BATCH
#undef BF4
    *(f32x4*)(p.out + O_WKVP + ((size_t)((l * 4 + b) * 16 + h) * 64 + v0) * 64 + kq * 4) = s;
}

__device__ void scan_sample_item(const Params& p, int l, int item, int lane, LAS float* lw) {
    const int b = item >> 4, h = item & 15;
    const int rg = lane >> 4, kq = lane & 15;
    const size_t sbase = (size_t)((l * 128 + b) * 16 + h) * 4096;
    const float* S0 = P_STATE_WKV + sbase;
    f32x4 s[16];
#pragma unroll
    for (int i = 0; i < 16; ++i) s[i] = *(const f32x4*)(S0 + (rg * 16 + i) * 64 + kq * 4);
    const float* recb = P_REC + ((size_t)(MP + b * 8) * 16 + h) * RECF;
    float nx[6];
#define SAMPLE_LOAD(rp_) do { const bf16_t* rb = (const bf16_t*)(rp_) + (lane >> 1) * 8 + (lane & 1); const float* rf = (rp_) + 128 + (lane >> 1) * 4 + (lane & 1); \
        nx[0] = bf2f(rb[0]); nx[2] = bf2f(rb[2]); nx[4] = bf2f(rb[4]); nx[5] = bf2f(rb[6]); nx[1] = rf[0]; nx[3] = rf[2]; } while (0)
    SAMPLE_LOAD(recb);
    for (int t = 0; t < 8; ++t) {
        WAVE_SYNC();
#pragma unroll
        for (int j = 0; j < 6; ++j) lw[j * 64 + lane] = nx[j];
        WAVE_SYNC();
        if (t < 7) SAMPLE_LOAD(recb + (size_t)(t + 1) * 16 * RECF);
        const f32x4 r4 = *(const LAS f32x4*)(lw + 0 * 64 + kq * 4), w4 = *(const LAS f32x4*)(lw + 1 * 64 + kq * 4), k4 = *(const LAS f32x4*)(lw + 2 * 64 + kq * 4),
                    a4 = *(const LAS f32x4*)(lw + 4 * 64 + kq * 4), b4 = *(const LAS f32x4*)(lw + 5 * 64 + kq * 4);
        float ysel = 0.f;
#pragma unroll
        for (int i4 = 0; i4 < 4; ++i4) {
            const f32x4 vv = *(const LAS f32x4*)(lw + 3 * 64 + rg * 16 + i4 * 4);
#pragma unroll
            for (int ii = 0; ii < 4; ++ii) { const int i = i4 * 4 + ii;
                const float sa = red16(dot4(s[i], a4));
                s[i] = s[i] * w4 + vv[ii] * k4 + sa * b4;
                const float y = red16(dot4(s[i], r4));
                ysel = (kq == i) ? y : ysel; }
        }
        P_YBUF[(size_t)(MP + b * 8 + t) * 1024 + h * 64 + rg * 16 + kq] = ysel;
    }
    float* So = p.out + O_WKVS + sbase;
#pragma unroll
    for (int i = 0; i < 16; ++i) *(f32x4*)(So + (rg * 16 + i) * 64 + kq * 4) = s[i];
}

__device__ void sgu_prompt_item(const Params& p, int l, int item, int lane) {
    const int slab = item & 7, g = (item >> 3) & 7, bc = item >> 6;
    const int fr = lane & 15, fq = lane >> 4;
    bf16x8 vf[4];
#pragma unroll
    for (int ks = 0; ks < 4; ++ks) vf[ks] = *(const bf16x8*)(P_VNT + (((size_t)bc * 16 + ks * 4 + fq) * 1024 + g * 128 + slab * 16 + fr) * 8);
    const float* Wg = P_SGU_W + (size_t)(l * 8 + g) * 16384;
    const float* bg = P_SGU_B + (size_t)(l * 8 + g) * 128;
    const int ch = g * 128 + slab * 16 + fq * 4;
#pragma unroll
    for (int tt = 0; tt < 8; ++tt) {
        f32x4 acc = (f32x4){0.f, 0.f, 0.f, 0.f};
        const int t = tt * 16 + fr;
#pragma unroll
        for (int ks = 0; ks <= tt / 2; ++ks) {
            const int s0 = ks * 32 + fq * 8;
            const f32x4 wa = *(const f32x4*)(Wg + t * 128 + s0), wb = *(const f32x4*)(Wg + t * 128 + s0 + 4);
            float wv[8] = {wa[0], wa[1], wa[2], wa[3], wb[0], wb[1], wb[2], wb[3]};
#pragma unroll
            for (int j = 0; j < 8; ++j) wv[j] = (s0 + j <= t) ? wv[j] : 0.f;
            u32x4 pk; pk[0] = pk_bf16(wv[0], wv[1]); pk[1] = pk_bf16(wv[2], wv[3]); pk[2] = pk_bf16(wv[4], wv[5]); pk[3] = pk_bf16(wv[6], wv[7]);
            bf16x8 wf; __builtin_memcpy(&wf, &pk, 16);
            acc = __builtin_amdgcn_mfma_f32_16x16x32_bf16(vf[ks], wf, acc, 0, 0, 0);
        }
        const size_t row = (size_t)bc * 128 + t;
        const float sbv = bg[t];
        const u32x2 uu = *(const u32x2*)(P_Z + row * NP + C_U + ch), gg = *(const u32x2*)(P_Z + row * NP + C_GG + ch);
        const float o0 = bflo(uu[0]) * (acc[0] + sbv) * siluf_(bflo(gg[0])), o1 = bfhi(uu[0]) * (acc[1] + sbv) * siluf_(bfhi(gg[0]));
        const float o2 = bflo(uu[1]) * (acc[2] + sbv) * siluf_(bflo(gg[1])), o3 = bfhi(uu[1]) * (acc[3] + sbv) * siluf_(bfhi(gg[1]));
        u32x2 o; o[0] = pk_bf16(o0, o1); o[1] = pk_bf16(o2, o3);
        *(u32x2*)(P_YAB + row * DM + 1024 + ch) = o;
    }
}

__device__ void sgu_sample_item(const Params& p, int l, int item, int lane) {
    const int b = item >> 4, ch = (item & 15) * 64 + lane, g = ch >> 7;
    const u32x4 vv = *(const u32x4*)(P_VNTS + ((size_t)b * 1024 + ch) * 8);
    float vn[8] = {bflo(vv[0]), bfhi(vv[0]), bflo(vv[1]), bfhi(vv[1]), bflo(vv[2]), bfhi(vv[2]), bflo(vv[3]), bfhi(vv[3])};
    const float* Wg = P_SGU_W + (size_t)(l * 8 + g) * 16384;
    const float* bg = P_SGU_B + (size_t)(l * 8 + g) * 128;
#pragma unroll
    for (int t = 0; t < 8; ++t) {
        float sacc = bg[t];
#pragma unroll
        for (int s = 0; s <= t; ++s) sacc += Wg[t * 128 + s] * vn[s];
        const size_t row = (size_t)MP + b * 8 + t;
        const float u = bf2f(P_Z[row * NP + C_U + ch]), gg = bf2f(P_Z[row * NP + C_GG + ch]);
        const float o = u * sacc * siluf_(gg);
        P_YAB[row * DM + 1024 + ch] = (bf16_t)(pk_bf16(o, 0.f) & 0xffffu);
    }
}

__device__ void phase_scan(const Params& p, int l) {
    const int tid = otid(), lane = tid & 63, wv = __builtin_amdgcn_readfirstlane(tid >> 6);
    LAS float* lw = (wv < 4) ? (LAS float*)smem_raw + wv * 6144 : (LAS float*)smem_raw + 24576 + (wv - 4) * 2048;
#ifndef REP_PR
#define REP_PR 1
#endif
#ifndef REP_IT
#define REP_IT 1
#endif
    if (wv < 4) {
      for (int rr = 0; rr < REP_PR; ++rr)
        for (int u0 = blockIdx.x; u0 < 256; u0 += gridDim.x) { const int unit = (gridDim.x == 256) ? ((u0 & 7) * 32 + (u0 >> 3)) : u0; scan_prompt_unit(p, l, unit, wv, lane, lw); }
    } else {
        const int nw = gridDim.x * 4;
      for (int rr = 0; rr < REP_IT; ++rr)
        for (int it = blockIdx.x * 4 + (wv - 4); it < 2048 + 4096 + 2048; it += nw) {
            if (it < 2048) scan_sample_item(p, l, it, lane, lw);
            else if (it < 6144) sgu_prompt_item(p, l, it - 2048, lane);
            else sgu_sample_item(p, l, it - 6144, lane);
        }
        if (l + 1 < DEPTH) phase_convert(p, l + 1, blockIdx.x * 4 + (wv - 4), nw);
    }
}

__device__ void phase_post(const Params& p, int l) {
    const int lane = otid() & 63, gw = blockIdx.x * 8 + (otid() >> 6), nw = gridDim.x * 8;
    const int hg = lane >> 4, kq = lane & 15;
    for (int it = gw; it < MT * 4; it += nw) {
        const int row = it >> 2, h = (it & 3) * 4 + hg, ch = h * 64 + kq * 4;
        const f32x4 y = *(const f32x4*)(P_YBUF + (size_t)row * 1024 + ch);
        const float* rc = P_REC + ((size_t)row * 16 + h) * RECF;
        const u32x2 p0 = *(const u32x2*)(rc + kq * 8), p1 = *(const u32x2*)(rc + kq * 8 + 4);
        const f32x2 va = *(const f32x2*)(rc + 128 + kq * 8 + 2), vb = *(const f32x2*)(rc + 128 + kq * 8 + 6);
        const f32x4 r4 = (f32x4){bflo(p0[0]), bfhi(p0[0]), bflo(p1[0]), bfhi(p1[0])}, k4 = (f32x4){bflo(p0[1]), bfhi(p0[1]), bflo(p1[1]), bfhi(p1[1])}, v4 = (f32x4){va[0], va[1], vb[0], vb[1]};
        const f32x4 rk = *(const f32x4*)(P_R_K + (size_t)l * 1024 + ch);
        const float mean = red16(y[0] + y[1] + y[2] + y[3]) * (1.f / 64.f);
        const f32x4 d = y - mean;
        const float var = red16(dot4(d, d)) * (1.f / 64.f);
        const float rs = rsqrtf(var + 64e-5f);
        const float srk = red16(r4[0] * k4[0] * rk[0] + r4[1] * k4[1] * rk[1] + r4[2] * k4[2] * rk[2] + r4[3] * k4[3] * rk[3]);
        const f32x4 lg = *(const f32x4*)(P_LNX_G + (size_t)l * 1024 + ch), lb = *(const f32x4*)(P_LNX_B + (size_t)l * 1024 + ch);
        const u32x2 gr = *(const u32x2*)(P_Z + (size_t)row * NP + C_GR + ch);
        const f32x4 yo = d * rs * lg + lb + srk * v4;
        u32x2 o; o[0] = pk_bf16(yo[0] * siluf_(bflo(gr[0])), yo[1] * siluf_(bfhi(gr[0]))); o[1] = pk_bf16(yo[2] * siluf_(bflo(gr[1])), yo[3] * siluf_(bfhi(gr[1])));
        *(u32x2*)(P_YAB + (size_t)row * DM + ch) = o;
    }
}


#define XB_TMO      128
#define XB_XCNT(j)  (256  + 64 * (j))
#define XB_XSUB(j)  (1280 + 64 * (j))
#define XB_XGEN(j)  (2304 + 64 * (j))
#define XB_TOP      3328
#define XB_TOPGEN   3392
#define XCD_BAR_WORDS 3456
#define XB_SPIN_CAP (1u << 20)
__device__ __forceinline__ unsigned xb_ld(unsigned* p)              { return __hip_atomic_load(p, __ATOMIC_RELAXED, __HIP_MEMORY_SCOPE_AGENT); }
__device__ __forceinline__ unsigned xb_add(unsigned* p, unsigned v) { return __hip_atomic_fetch_add(p, v, __ATOMIC_RELAXED, __HIP_MEMORY_SCOPE_AGENT); }
__device__ __forceinline__ unsigned xb_xcc_id() { return (unsigned)__builtin_amdgcn_s_getreg((3 << 11) | 20) & 0xFu; }
#define XB_SPIN(cond, bar) do { unsigned _sp = 0; while (cond) { __builtin_amdgcn_s_sleep(1); \
    if ((++_sp & 255u) == 0u) { if (xb_ld(&(bar)[XB_TMO])) break; if (_sp > XB_SPIN_CAP) { atomicAdd(&(bar)[XB_TMO], 1u); break; } } } } while (0)
struct XcdBarrier { unsigned* bar; unsigned x; volatile LAS unsigned* st; };
__device__ __forceinline__ XcdBarrier xcd_barrier_post(unsigned* bar, volatile LAS unsigned* st) {
    XcdBarrier b; b.bar = bar; b.x = xb_xcc_id(); b.st = st;
    if (threadIdx.x == 0) (void)xb_add(&bar[XB_XCNT(b.x)], 1u);
    return b;
}
__device__ __forceinline__ void xcd_barrier_complete(unsigned* bar, unsigned x, unsigned& nloc, unsigned& nx) {
    const unsigned G = gridDim.x * gridDim.y * gridDim.z;
    unsigned sum, cnt, mine, sp = 0u;
    for (;;) {
        sum = 0u; cnt = 0u; mine = 0u;
#pragma unroll
        for (unsigned j = 0; j < 16; ++j) { const unsigned c = xb_ld(&bar[XB_XCNT(j)]); sum += c; cnt += (c > 0u) ? 1u : 0u; mine = (j == x) ? c : mine; }
        if (sum == G) break;
        __builtin_amdgcn_s_sleep(1);
        if ((++sp & 255u) == 0u) { if (xb_ld(&bar[XB_TMO])) break; if (sp > XB_SPIN_CAP) { atomicAdd(&bar[XB_TMO], 1u); break; } }
    }
    nloc = mine > 0u ? mine : 1u; nx = cnt > 0u ? cnt : 1u;
}
__device__ __forceinline__ void xcd_barrier(const XcdBarrier& b) {
    asm volatile("s_waitcnt vmcnt(0)" ::: "memory");
    __syncthreads();
    if (threadIdx.x == 0) {
        unsigned* bar = b.bar;
        __builtin_amdgcn_s_waitcnt(0);
        unsigned nloc = b.st[0], nx = b.st[1];
        if (nloc == 0u) { xcd_barrier_complete(bar, b.x, nloc, nx); b.st[0] = nloc; b.st[1] = nx; }
        const unsigned old = xb_add(&bar[XB_XSUB(b.x)], 1u);
        const unsigned gen = old / nloc;
        if (old + 1u == (gen + 1u) * nloc) {
            __builtin_amdgcn_fence(__ATOMIC_RELEASE, "agent");
            asm volatile("s_waitcnt vmcnt(0)" ::: "memory");
            const unsigned og = xb_add(&bar[XB_TOP], 1u);
            const unsigned tg = og / nx;
            if (og + 1u == (tg + 1u) * nx) xb_add(&bar[XB_TOPGEN], 1u);
            else XB_SPIN(xb_ld(&bar[XB_TOPGEN]) == tg, bar);
            __builtin_amdgcn_fence(__ATOMIC_ACQUIRE, "agent");
            xb_add(&bar[XB_XGEN(b.x)], 1u);
            asm volatile("s_waitcnt vmcnt(0)" ::: "memory");
        } else {
            XB_SPIN(xb_ld(&bar[XB_XGEN(b.x)]) == gen, bar);
            __builtin_amdgcn_fence(__ATOMIC_ACQUIRE, "agent");
            asm volatile("s_waitcnt vmcnt(0)" ::: "memory");
        }
    }
    __syncthreads();
}

template <int ST> __device__ __forceinline__ void run_stage(const Params& p, int l) {
    LAS unsigned char* lds = (LAS unsigned char*)smem_raw;
    pg8::StaticOrder S;
    if (ST == 7) { { const int gw = blockIdx.x * 8 + (otid() >> 6), lane = otid() & 63;
                     if (gw < 128) { const int l2 = gw >> 5, m2 = (gw >> 4) & 1, u2 = gw & 15;
                         conv_unit((m2 ? P_A2 : P_W2) + (size_t)l2 * 64 * 1024, 64, 1024, 1024, (m2 ? P_A2T : P_W2T) + (size_t)l2 * 1024 * 64, 64, u2, lane); } }
                   { const f32x4* xs = (const f32x4*)P_X_SAMPLE; f32x4* hd = (f32x4*)(P_H + (size_t)MP * DM);
                     for (int i = blockIdx.x * 512 + otid(); i < MS * DM / 4; i += gridDim.x * 512) hd[i] = xs[i];
                     const f32x4* xp = (const f32x4*)(P_X_PROMPT + (size_t)OT_ROW0 * DM); f32x4* hq = (f32x4*)(P_H + (size_t)OT_ROW0 * DM);
                     for (int i = blockIdx.x * 512 + otid(); i < (MP - OT_ROW0) * DM / 4; i += gridDim.x * 512) hq[i] = xp[i]; }
                   phase_convert(p, 0, blockIdx.x * 8 + (otid() >> 6), gridDim.x * 8); phase_rmsnorm(P_X_PROMPT, P_X_SAMPLE, P_NORM_G, P_XN, nullptr, nullptr, nullptr); }
    if (ST == 0) { pg8::Gemm g{P_XN, P_WINT + (size_t)l * NP * DM, MT, NP, DM}; pg8::ZOrder SZ; SZ.init(DM, gridDim.x, blockIdx.x); EpiZ e{P_Z, (unsigned*)(p.ws + WS_BAR) + ZD_W}; pg8::gemm_phase(lds, g, SZ, e); }
    if (ST == 1) phase_prep(p, l);
    if (ST == 2) phase_scan(p, l);
    if (ST == 3) phase_post(p, l);
    if (ST == 4) { pg8::Gemm g{P_YAB, P_PABT + (size_t)l * DM * DM, MT, DM, DM}; S.init(MT, DM, DM, gridDim.x, blockIdx.x, 1, MP / 256); S.tail_full = 1; EpiMerge e{P_Z, P_M, (unsigned*)(p.ws + WS_BAR) + RDY_W0}; pg8::gemm_phase(lds, g, S, e); }
    if (ST == 5) { pg8::Gemm g{P_M, P_WOT + (size_t)l * DM * DM, MT, DM, DM}; S.init(MT, DM, DM, gridDim.x, blockIdx.x, 0, OT_PM0);
                   S.rot = 32; S.tail_base = gridDim.x;
                   S.ready = (unsigned*)(p.ws + WS_BAR) + RDY_W0; S.need = 64u * (unsigned)(l + 1);
                   EpiOut e{l == 0 ? P_X_PROMPT : P_H, P_H + (size_t)MP * DM, P_H, P_PART}; pg8::gemm_phase(lds, g, S, e); }
    if (ST == 6) { if (l < DEPTH - 1) phase_rmsnorm(P_H, P_H + (size_t)MP * DM, P_NORM_G + (size_t)(l + 1) * DM, P_XN, nullptr, P_PART, P_H);
                   else phase_rmsnorm(P_H, P_H + (size_t)MP * DM, P_FINAL_G, nullptr, p.out + O_YP, P_PART, P_H); }
}

#if MK_SINGLE
#ifndef REP0
#define REP0 1
#endif
#ifndef REP1
#define REP1 1
#endif
#ifndef REP2
#define REP2 1
#endif
#ifndef REP3
#define REP3 1
#endif
#ifndef REP4
#define REP4 1
#endif
#ifndef REP6
#define REP6 1
#endif
#ifndef REP7
#define REP7 1
#endif
__global__ void __launch_bounds__(512, 2) mega(Params p) {
    cg::grid_group grid = cg::this_grid();
    __shared__ uint4 xb_words;
    if (threadIdx.x == 0) xb_words = make_uint4(0u, 0u, 0u, 0u);
    __syncthreads();
    const XcdBarrier xb = xcd_barrier_post((unsigned*)(p.ws + WS_BAR), (volatile LAS unsigned*)&xb_words);
#define GSYNC() xcd_barrier(xb)
    for (int r = 0; r < REP7; ++r) { run_stage<7>(p, 0); grid.sync(); }
    for (int l = 0; l < DEPTH; ++l) {
        for (int r = 0; r < REP0; ++r) { run_stage<0>(p, l); }
        for (int r = 0; r < REP1; ++r) { run_stage<1>(p, l); GSYNC(); }
        for (int r = 0; r < REP2; ++r) { run_stage<2>(p, l); GSYNC(); }
        for (int r = 0; r < REP3; ++r) { run_stage<3>(p, l); GSYNC(); }
        for (int r = 0; r < REP4; ++r) { run_stage<4>(p, l); }
        run_stage<5>(p, l); GSYNC();
        for (int r = 0; r < REP6; ++r) { run_stage<6>(p, l); if (l + 1 < DEPTH || r + 1 < REP6) GSYNC(); }
    }
}
#else
template <int ST> __global__ void __launch_bounds__(512, 2) stage_k(Params p, int l) { run_stage<ST>(p, l); }
#endif

template <class K> static void set_lds(K k, size_t bytes) { (void)hipFuncSetAttribute((const void*)k, hipFuncAttributeMaxDynamicSharedMemorySize, (int)bytes); }

extern "C" void kernel_launch(void* const* d_in, const int* in_sizes, int n_in, void* d_out, int out_size, void* d_ws, size_t ws_size, hipStream_t stream) {
    constexpr size_t kDynLds = 131072;
    static int grid_blocks = 0;
    if (!grid_blocks) {
        int dev = 0, cus = 0;
        (void)hipGetDevice(&dev);
        (void)hipDeviceGetAttribute(&cus, hipDeviceAttributeMultiprocessorCount, dev);
#if MK_SINGLE
        int per_cu = 0;
        set_lds(mega, kDynLds);
        (void)hipOccupancyMaxActiveBlocksPerMultiprocessor(&per_cu, mega, 512, kDynLds);
        if (per_cu < 1) fprintf(stderr, "occupancy query returned %d\n", per_cu);
#else
        set_lds(stage_k<0>, kDynLds); set_lds(stage_k<1>, kDynLds); set_lds(stage_k<2>, kDynLds); set_lds(stage_k<3>, kDynLds);
        set_lds(stage_k<4>, kDynLds); set_lds(stage_k<5>, kDynLds); set_lds(stage_k<6>, kDynLds); set_lds(stage_k<7>, kDynLds);
#endif
        grid_blocks = cus > 0 ? cus : 256;
    }
    Params p{};
    for (int i = 0; i < 24; ++i) p.in[i] = (const float*)d_in[i];
    p.out = (float*)d_out; p.ws = (char*)d_ws;
    if (ws_size < WS_END) fprintf(stderr, "workspace too small: %zu < %zu\n", ws_size, (size_t)WS_END);
#if MK_SINGLE
    (void)hipMemsetAsync(p.ws + WS_BAR, 0, (size_t)XCD_BAR_WORDS_C * 4, stream);
    void* args[] = {&p};
    hipError_t e = hipLaunchCooperativeKernel((void*)mega, dim3(grid_blocks), dim3(512), args, kDynLds, stream);
    if (e != hipSuccess) fprintf(stderr, "cooperative launch failed: %s (grid %d)\n", hipGetErrorString(e), grid_blocks);
#else
    const dim3 G(grid_blocks), B(512);
    hipLaunchKernelGGL(stage_k<7>, G, B, kDynLds, stream, p, 0);
    for (int l = 0; l < DEPTH; ++l) {
        hipLaunchKernelGGL(stage_k<0>, G, B, kDynLds, stream, p, l);
        hipLaunchKernelGGL(stage_k<1>, G, B, kDynLds, stream, p, l);
        hipLaunchKernelGGL(stage_k<2>, G, B, kDynLds, stream, p, l);
        hipLaunchKernelGGL(stage_k<3>, G, B, kDynLds, stream, p, l);
        hipLaunchKernelGGL(stage_k<4>, G, B, kDynLds, stream, p, l);
        hipLaunchKernelGGL(stage_k<5>, G, B, kDynLds, stream, p, l);
        hipLaunchKernelGGL(stage_k<6>, G, B, kDynLds, stream, p, l);
    }
#endif
}
```
